# Optimizing an MI355X kernel written in HIP

```python
import math
import jax, jax.numpy as jnp
from jax import lax
import numpy as np

D_MODEL = 1024
BATCH = 4
SEQ = 4096
DEPTH = 1

EPS = 1e-6
MEM_LEN = 256
SSM_WIDTH = D_MODEL // 2
SSM_GROUP = 16
SSM_GROUPS = SSM_WIDTH // SSM_GROUP
SSM_STATE = 64
SGU_WIDTH = D_MODEL // 2
SGU_HEADS = 4
SGU_HEAD_DIM = SGU_WIDTH // SGU_HEADS
CHUNK = 128
XA_HEADS = 4
XA_HEAD_DIM = 128
XA_WIDTH = XA_HEADS * XA_HEAD_DIM
N_BRANCHES = 3
BRANCH_WIDTH = 512
IN_COLS = SSM_WIDTH + 2 * SGU_WIDTH + XA_WIDTH
N_GROUPS = 8
EXPERTS_PER_GROUP = 8
N_EXPERTS = N_GROUPS * EXPERTS_PER_GROUP
TOP_K = 2
D_FF_EXPERT = D_MODEL // 2
MOE_BLOCK = 128

kernel_name = "hybrid_s5_gmlp_memxattn_hmoe"


def rmsnorm(x, g):
    xf = x.astype(jnp.float32)
    y = xf * lax.rsqrt(jnp.mean(xf * xf, axis=-1, keepdims=True) + EPS)
    return (y * g.astype(jnp.float32)).astype(x.dtype)


def s5_ssm(u, lam_re, lam_im, log_dt, b_re, b_im, c_re, c_im, d_skip):
    f32 = jnp.float32
    bsz, s, _ = u.shape
    uf = u.astype(f32).reshape(bsz, s, SSM_GROUPS, SSM_GROUP)
    lam = lax.complex(lam_re.astype(f32), lam_im.astype(f32))
    dt = jnp.exp(log_dt.astype(f32))[:, None]
    lam_bar = jnp.exp(lam * dt)
    b = lax.complex(b_re.astype(f32), b_im.astype(f32))
    b_bar = ((lam_bar - 1.0) / lam)[..., None] * b
    bu = lax.complex(jnp.einsum('bsgh,gph->bsgp', uf, jnp.real(b_bar)),
                     jnp.einsum('bsgh,gph->bsgp', uf, jnp.imag(b_bar)))
    a = jnp.broadcast_to(lam_bar, bu.shape)

    def combine(left, right):
        a_l, x_l = left
        a_r, x_r = right
        return a_r * a_l, a_r * x_l + x_r

    _, states = lax.associative_scan(combine, (a, bu), axis=1)
    y = (jnp.einsum('bsgp,ghp->bsgh', jnp.real(states), c_re.astype(f32))
         - jnp.einsum('bsgp,ghp->bsgh', jnp.imag(states), c_im.astype(f32)))
    y = y + d_skip.astype(f32).reshape(SSM_GROUPS, SSM_GROUP) * uf
    return y.reshape(bsz, s, SSM_WIDTH).astype(u.dtype)


def spatial_gating(u, v, g_sgu, w_spatial, b_spatial):
    bsz, s, _ = v.shape
    v = rmsnorm(v, g_sgu)
    vc = v.reshape(bsz, s // CHUNK, CHUNK, SGU_HEADS, SGU_HEAD_DIM)
    mask = jnp.tril(jnp.ones((CHUNK, CHUNK), dtype=bool))
    w = jnp.where(mask, w_spatial, jnp.zeros_like(w_spatial))
    sv = jnp.einsum('hts,bcshd->bcthd', w, vc) + b_spatial.T[None, None, :, :, None]
    return u * sv.reshape(bsz, s, SGU_WIDTH)


def memory_cross_attention(q, mem_n, w_kv):
    bsz, s, _ = q.shape
    k, v = jnp.split(mem_n @ w_kv, 2, axis=-1)
    qh = q.reshape(bsz, s, XA_HEADS, XA_HEAD_DIM)
    kh = k.reshape(bsz, -1, XA_HEADS, XA_HEAD_DIM)
    vh = v.reshape(bsz, -1, XA_HEADS, XA_HEAD_DIM)
    scores = jnp.einsum('bshd,bmhd->bhsm', qh, kh).astype(jnp.float32) * (XA_HEAD_DIM ** -0.5)
    p = jax.nn.softmax(scores, axis=-1).astype(vh.dtype)
    o = jnp.einsum('bhsm,bmhd->bshd', p, vh)
    return o.reshape(bsz, s, XA_WIDTH)


def hybrid_mixer(h, mem, g_mix, g_mem, w_in, w_gate, b_gate, lam_re, lam_im, log_dt,
                 b_re, b_im, c_re, c_im, d_skip, w_glu, b_glu, g_sgu, w_spatial, b_spatial,
                 w_kv, w_branch, w_out):
    bsz, s, d = h.shape
    n = rmsnorm(h, g_mix)
    proj = n @ w_in
    x_ssm = proj[..., :SSM_WIDTH]
    uv = jax.nn.gelu(proj[..., SSM_WIDTH:SSM_WIDTH + 2 * SGU_WIDTH])
    q = proj[..., SSM_WIDTH + 2 * SGU_WIDTH:]
    y_s = jax.nn.gelu(s5_ssm(x_ssm, lam_re, lam_im, log_dt, b_re, b_im, c_re, c_im, d_skip))
    glu_a, glu_b = jnp.split(y_s @ w_glu + b_glu, 2, axis=-1)
    y_a = glu_a * jax.nn.sigmoid(glu_b)
    u, v = jnp.split(uv, 2, axis=-1)
    y_b = spatial_gating(u, v, g_sgu, w_spatial, b_spatial)
    y_c = memory_cross_attention(q, rmsnorm(mem, g_mem), w_kv)
    ys = jnp.stack([y_a, y_b, y_c], axis=2)
    br = jnp.einsum('bsic,icd->bsid', ys, w_branch)
    gates = jax.nn.sigmoid(n @ w_gate + b_gate).reshape(bsz, s, N_BRANCHES, d)
    merged = jnp.sum(gates * br, axis=2)
    return merged @ w_out


def hierarchical_moe(x, w_group, b_group, w_router, b_router, w1, w3, w2):
    bsz, s, d = x.shape
    t = bsz * s
    xf = x.reshape(t, d)
    group_logits = (xf @ w_group).astype(jnp.float32) + b_group.astype(jnp.float32)
    group_probs = jax.nn.softmax(group_logits, axis=-1)
    g_idx = jnp.argmax(group_logits, axis=-1)
    g_w = jnp.take_along_axis(group_probs, g_idx[:, None], axis=-1)[:, 0]
    all_logits = ((xf @ w_router).astype(jnp.float32) + b_router.astype(jnp.float32))
    all_logits = all_logits.reshape(t, N_GROUPS, EXPERTS_PER_GROUP)
    e_logits = jnp.take_along_axis(all_logits, g_idx[:, None, None], axis=1)[:, 0]
    top_vals, top_loc = lax.top_k(e_logits, TOP_K)
    e_w = jax.nn.softmax(top_vals, axis=-1)
    expert_ids = g_idx[:, None] * EXPERTS_PER_GROUP + top_loc
    weights = g_w[:, None] * e_w

    flat_e = expert_ids.reshape(-1)
    flat_tok = jnp.repeat(jnp.arange(t), TOP_K)
    flat_w = weights.reshape(-1)
    order = jnp.argsort(flat_e)
    sorted_e = flat_e[order]
    sorted_tok = flat_tok[order]
    sorted_w = flat_w[order]
    counts = jnp.bincount(flat_e, length=N_EXPERTS)
    padded = (counts + MOE_BLOCK - 1) // MOE_BLOCK * MOE_BLOCK
    start = jnp.cumsum(counts) - counts
    block_end = jnp.cumsum(padded)
    pstart = block_end - padded
    dest = pstart[sorted_e] + (jnp.arange(t * TOP_K) - start[sorted_e])
    n_blocks = -(-(t * TOP_K) // MOE_BLOCK) + N_EXPERTS
    buf = jnp.zeros((n_blocks * MOE_BLOCK, d), x.dtype).at[dest].set(xf[sorted_tok])
    block_expert = jnp.searchsorted(block_end, jnp.arange(n_blocks) * MOE_BLOCK, side='right')
    block_expert = jnp.minimum(block_expert, N_EXPERTS - 1)

    def expert_block(args):
        xb, e = args
        return (jax.nn.silu(xb @ w1[e]) * (xb @ w3[e])) @ w2[e]

    yb = lax.map(expert_block, (buf.reshape(n_blocks, MOE_BLOCK, d), block_expert))
    y_sorted = yb.reshape(-1, d)[dest] * sorted_w[:, None].astype(x.dtype)
    y = jnp.zeros((t, d), x.dtype).at[sorted_tok].add(y_sorted)
    return y.reshape(bsz, s, d)


def setup_inputs(seed: int = 0) -> dict:
    key = jax.random.key(seed)
    ks = iter(jax.random.split(key, 32))
    L = DEPTH
    f32 = jnp.float32

    def nrm(shape, scale):
        return jax.random.normal(next(ks), shape, f32) * scale

    def gain(shape):
        return 1.0 + nrm(shape, 0.01)

    x = nrm((BATCH, SEQ, D_MODEL), 1.0)
    mem = nrm((BATCH, MEM_LEN, D_MODEL), 1.0)
    g_mix = gain((L, D_MODEL))
    g_mem = gain((L, D_MODEL))
    w_in = nrm((L, D_MODEL, IN_COLS), D_MODEL ** -0.5)
    w_gate = nrm((L, D_MODEL, N_BRANCHES * D_MODEL), D_MODEL ** -0.5)
    b_gate = nrm((L, N_BRANCHES * D_MODEL), 0.01)
    lam_re = -0.5 + nrm((L, SSM_GROUPS, SSM_STATE), 0.01)
    lam_im = (jnp.pi * jnp.arange(SSM_STATE, dtype=f32))[None, None, :] + nrm((L, SSM_GROUPS, SSM_STATE), 0.01)
    log_dt = jax.random.uniform(next(ks), (L, SSM_GROUPS), f32, minval=math.log(1e-3), maxval=math.log(1e-1))
    b_re = nrm((L, SSM_GROUPS, SSM_STATE, SSM_GROUP), (2 * SSM_GROUP) ** -0.5)
    b_im = nrm((L, SSM_GROUPS, SSM_STATE, SSM_GROUP), (2 * SSM_GROUP) ** -0.5)
    c_re = nrm((L, SSM_GROUPS, SSM_GROUP, SSM_STATE), (2 * SSM_STATE) ** -0.5)
    c_im = nrm((L, SSM_GROUPS, SSM_GROUP, SSM_STATE), (2 * SSM_STATE) ** -0.5)
    d_skip = nrm((L, SSM_WIDTH), 1.0)
    w_glu = nrm((L, SSM_WIDTH, 2 * SSM_WIDTH), SSM_WIDTH ** -0.5)
    b_glu = nrm((L, 2 * SSM_WIDTH), 0.01)
    g_sgu = gain((L, SGU_WIDTH))
    w_spatial = nrm((L, SGU_HEADS, CHUNK, CHUNK), 0.5 * CHUNK ** -0.5)
    b_spatial = gain((L, SGU_HEADS, CHUNK))
    w_kv = nrm((L, D_MODEL, 2 * XA_WIDTH), D_MODEL ** -0.5)
    w_branch = nrm((L, N_BRANCHES, BRANCH_WIDTH, D_MODEL), BRANCH_WIDTH ** -0.5)
    w_out = nrm((L, D_MODEL, D_MODEL), D_MODEL ** -0.5)
    g_ffn = gain((L, D_MODEL))
    w_group = nrm((L, D_MODEL, N_GROUPS), D_MODEL ** -0.5)
    b_group = nrm((L, N_GROUPS), 0.01)
    w_router = nrm((L, D_MODEL, N_EXPERTS), D_MODEL ** -0.5)
    b_router = nrm((L, N_EXPERTS), 0.01)
    w1 = nrm((L, N_EXPERTS, D_MODEL, D_FF_EXPERT), D_MODEL ** -0.5)
    w3 = nrm((L, N_EXPERTS, D_MODEL, D_FF_EXPERT), D_MODEL ** -0.5)
    w2 = nrm((L, N_EXPERTS, D_FF_EXPERT, D_MODEL), D_FF_EXPERT ** -0.5)
    g_final = gain((D_MODEL,))
    return {"x": x, "mem": mem, "g_mix": g_mix, "g_mem": g_mem, "w_in": w_in,
            "w_gate": w_gate, "b_gate": b_gate, "lam_re": lam_re, "lam_im": lam_im,
            "log_dt": log_dt, "b_re": b_re, "b_im": b_im, "c_re": c_re, "c_im": c_im,
            "d_skip": d_skip, "w_glu": w_glu, "b_glu": b_glu, "g_sgu": g_sgu,
            "w_spatial": w_spatial, "b_spatial": b_spatial, "w_kv": w_kv,
            "w_branch": w_branch, "w_out": w_out, "g_ffn": g_ffn, "w_group": w_group,
            "b_group": b_group, "w_router": w_router, "b_router": b_router,
            "w1": w1, "w3": w3, "w2": w2, "g_final": g_final}


def reference(x, mem, g_mix, g_mem, w_in, w_gate, b_gate, lam_re, lam_im, log_dt, b_re, b_im,
              c_re, c_im, d_skip, w_glu, b_glu, g_sgu, w_spatial, b_spatial, w_kv, w_branch,
              w_out, g_ffn, w_group, b_group, w_router, b_router, w1, w3, w2, g_final):
    h = x
    for l in range(DEPTH):
        h = h + hybrid_mixer(h, mem, g_mix[l], g_mem[l], w_in[l], w_gate[l], b_gate[l],
                             lam_re[l], lam_im[l], log_dt[l], b_re[l], b_im[l], c_re[l],
                             c_im[l], d_skip[l], w_glu[l], b_glu[l], g_sgu[l], w_spatial[l],
                             b_spatial[l], w_kv[l], w_branch[l], w_out[l])
        h = h + hierarchical_moe(rmsnorm(h, g_ffn[l]), w_group[l], b_group[l], w_router[l],
                                 b_router[l], w1[l], w3[l], w2[l])
    return rmsnorm(h, g_final)
```

```cpp
#include <hip/hip_runtime.h>
#include <cstdio>
#include <cstdint>

constexpr int BATCH = 4, SEQ = 4096, DM = 1024, T = BATCH * SEQ;
constexpr int MEML = 256, MROWS = BATCH * MEML;
constexpr int SSMW = 512, SG = 16, NG = 32, NP = 64;
constexpr int SGUW = 512, SH = 4, SHD = 128, CHUNK = 128;
constexpr int XH = 4, XD = 128, XW = 512;
constexpr int INC = 2048;
constexpr int NGRP = 8, EPG = 8, NE = 64, DFF = 512;
constexpr float EPS = 1e-6f;
constexpr int SCH = 128;
constexpr int NSC = SEQ / SCH;

__device__ __forceinline__ float gelu_f(float x) {
    const float k0 = 0.7978845608028654f, k1 = 0.044715f;
    float u = k0 * (x + k1 * x * x * x);
    return 0.5f * x * (1.f + tanhf(u));
}
__device__ __forceinline__ float sigmoid_f(float x) { return 1.f / (1.f + expf(-x)); }

struct GemmP {
    const float* A; int lda; const int* gather;
    const float* B; int ldb; long strideB;
    const int* rowStart; const int* rowCount;
    int M, N, K;
    int mode; float* C; int ldc; const float* bias; const float* aux; int ldaux; int accum;
};

__device__ __forceinline__ void epi_apply(const GemmP& p, int row, int col, float v) {
    float* c = p.C + (size_t)row * p.ldc + col;
    switch (p.mode) {
        case 0: *c = v + (p.bias ? p.bias[col] : 0.f); break;
        case 1: *c = (col >= 512 && col < 1536) ? gelu_f(v) : v; break;
        case 2: { float g = sigmoid_f(v + p.bias[col]); float b = p.aux[(size_t)row * p.ldaux + col]; float prev = p.accum ? *c : 0.f; *c = prev + g * b; } break;
        case 3: *c = p.aux[(size_t)row * p.ldaux + col] + v; break;
        case 4: { float a = *c; *c = (a * sigmoid_f(a)) * v; } break;
        default: break;
    }
}

__global__ void __launch_bounds__(256) sgemm_kernel(GemmP p) {
    __shared__ float As[16][68];
    __shared__ float Bs[16][68];
    const int tid = threadIdx.x, tx = tid & 15, ty = tid >> 4;
    int r0 = 0, M = p.M; const float* B = p.B;
    if (p.rowStart) { const int z = blockIdx.z; r0 = p.rowStart[z]; M = p.rowCount[z]; B += (size_t)z * p.strideB; }
    const int n0 = blockIdx.x * 64;
    for (int rt = blockIdx.y; rt * 64 < M; rt += gridDim.y) {
        const int m0 = rt * 64;
        float acc[4][4];
#pragma unroll
        for (int i = 0; i < 4; ++i)
#pragma unroll
            for (int j = 0; j < 4; ++j) acc[i][j] = 0.f;
        const int ar = tid >> 2, ak = (tid & 3) * 4;
        const int arow = m0 + ar;
        const bool avalid = arow < M;
        long asrc = 0;
        if (avalid) asrc = (long)(p.gather ? p.gather[r0 + arow] : (r0 + arow)) * p.lda;
        const int bk = tid >> 4, bn = (tid & 15) * 4;
        for (int k0 = 0; k0 < p.K; k0 += 16) {
            float4 av = make_float4(0.f, 0.f, 0.f, 0.f);
            if (avalid) av = *(const float4*)(p.A + asrc + k0 + ak);
            float4 bv = *(const float4*)(B + (size_t)(k0 + bk) * p.ldb + n0 + bn);
            __syncthreads();
            As[ak + 0][ar] = av.x; As[ak + 1][ar] = av.y; As[ak + 2][ar] = av.z; As[ak + 3][ar] = av.w;
            *(float4*)&Bs[bk][bn] = bv;
            __syncthreads();
#pragma unroll
            for (int k = 0; k < 16; ++k) {
                float4 a = *(const float4*)&As[k][ty * 4];
                float4 b = *(const float4*)&Bs[k][tx * 4];
                float aa[4] = {a.x, a.y, a.z, a.w}, bb[4] = {b.x, b.y, b.z, b.w};
#pragma unroll
                for (int i = 0; i < 4; ++i)
#pragma unroll
                    for (int j = 0; j < 4; ++j) acc[i][j] = fmaf(aa[i], bb[j], acc[i][j]);
            }
        }
#pragma unroll
        for (int i = 0; i < 4; ++i) {
            const int row = m0 + ty * 4 + i;
            if (row < M) {
#pragma unroll
                for (int j = 0; j < 4; ++j) epi_apply(p, r0 + row, n0 + tx * 4 + j, acc[i][j]);
            }
        }
        __syncthreads();
    }
}

template <int PER>
__global__ void __launch_bounds__(256) rmsnorm_kernel(const float* in, int ldin, const float* g, float* out, int ldout) {
    __shared__ float red[4];
    constexpr int D = PER * 256;
    const int row = blockIdx.x, tid = threadIdx.x;
    const float* x = in + (size_t)row * ldin;
    float v[PER]; float s = 0.f;
#pragma unroll
    for (int j = 0; j < PER; ++j) { v[j] = x[tid + 256 * j]; s += v[j] * v[j]; }
    for (int o = 32; o > 0; o >>= 1) s += __shfl_xor(s, o);
    if ((tid & 63) == 0) red[tid >> 6] = s;
    __syncthreads();
    const float tot = red[0] + red[1] + red[2] + red[3];
    const float rs = rsqrtf(tot / (float)D + EPS);
#pragma unroll
    for (int j = 0; j < PER; ++j) out[(size_t)row * ldout + tid + 256 * j] = v[j] * rs * g[tid + 256 * j];
}

struct SsmP {
    const float* proj;
    const float *lam_re, *lam_im, *log_dt, *b_re, *b_im, *c_re, *c_im, *d_skip;
    float* xend;
    float* xin;
    float* ys;
};

__device__ __forceinline__ void ssm_coeffs(const SsmP& p, int g, int pp, float& lr, float& li, float (&bbr)[16], float (&bbi)[16]) {
    const float are = p.lam_re[g * NP + pp], aim = p.lam_im[g * NP + pp];
    const float dt = expf(p.log_dt[g]);
    const float e = expf(are * dt);
    lr = e * cosf(aim * dt); li = e * sinf(aim * dt);
    const float nr = lr - 1.f, ni = li;
    const float den = are * are + aim * aim;
    const float fr = (nr * are + ni * aim) / den, fi = (ni * are - nr * aim) / den;
#pragma unroll
    for (int h = 0; h < 16; ++h) {
        const float br = p.b_re[(g * NP + pp) * SG + h], bi = p.b_im[(g * NP + pp) * SG + h];
        bbr[h] = fr * br - fi * bi; bbi[h] = fr * bi + fi * br;
    }
}

__global__ void __launch_bounds__(64) ssm_pass1(SsmP p) {
    const int pp = threadIdx.x;
    const int g = blockIdx.x % NG, c = (blockIdx.x / NG) % NSC, b = blockIdx.x / (NG * NSC);
    float lr, li, bbr[16], bbi[16];
    ssm_coeffs(p, g, pp, lr, li, bbr, bbi);
    float xr = 0.f, xi = 0.f;
    const float* u = p.proj + (size_t)(b * SEQ + c * SCH) * INC + g * SG;
    for (int t = 0; t < SCH; ++t) {
        float ur = 0.f, ui = 0.f;
#pragma unroll
        for (int h = 0; h < 16; ++h) { const float uv = u[(size_t)t * INC + h]; ur = fmaf(bbr[h], uv, ur); ui = fmaf(bbi[h], uv, ui); }
        const float nr = lr * xr - li * xi + ur, ni = lr * xi + li * xr + ui;
        xr = nr; xi = ni;
    }
    float* o = p.xend + ((size_t)((b * NSC + c) * NG + g) * NP + pp) * 2;
    o[0] = xr; o[1] = xi;
}

__global__ void __launch_bounds__(64) ssm_carry(SsmP p) {
    const int pp = threadIdx.x, g = blockIdx.x % NG, b = blockIdx.x / NG;
    const float are = p.lam_re[g * NP + pp], aim = p.lam_im[g * NP + pp];
    const float dt = expf(p.log_dt[g]);
    const float e = expf(are * dt * (float)SCH);
    const float ang = aim * dt;
    const double angL = (double)ang * (double)SCH;
    const float Lr = e * (float)cos(angL), Li = e * (float)sin(angL);
    float cr = 0.f, ci = 0.f;
    for (int c = 0; c < NSC; ++c) {
        const size_t idx = ((size_t)((b * NSC + c) * NG + g) * NP + pp) * 2;
        p.xin[idx] = cr; p.xin[idx + 1] = ci;
        const float er = p.xend[idx], ei = p.xend[idx + 1];
        const float nr = Lr * cr - Li * ci + er, ni = Lr * ci + Li * cr + ei;
        cr = nr; ci = ni;
    }
}

__global__ void __launch_bounds__(64) ssm_pass2(SsmP p) {
    __shared__ float sre[64], sim[64];
    const int pp = threadIdx.x;
    const int g = blockIdx.x % NG, c = (blockIdx.x / NG) % NSC, b = blockIdx.x / (NG * NSC);
    float lr, li, bbr[16], bbi[16];
    ssm_coeffs(p, g, pp, lr, li, bbr, bbi);
    const size_t idx = ((size_t)((b * NSC + c) * NG + g) * NP + pp) * 2;
    float xr = p.xin[idx], xi = p.xin[idx + 1];
    const int h = pp & 15, q = pp >> 4;
    float cre[16], cim[16];
#pragma unroll
    for (int j = 0; j < 16; ++j) { cre[j] = p.c_re[(g * SG + h) * NP + q * 16 + j]; cim[j] = p.c_im[(g * SG + h) * NP + q * 16 + j]; }
    const float dsk = p.d_skip[g * SG + h];
    const float* u = p.proj + (size_t)(b * SEQ + c * SCH) * INC + g * SG;
    for (int t = 0; t < SCH; ++t) {
        float ur = 0.f, ui = 0.f;
#pragma unroll
        for (int hh = 0; hh < 16; ++hh) { const float uv = u[(size_t)t * INC + hh]; ur = fmaf(bbr[hh], uv, ur); ui = fmaf(bbi[hh], uv, ui); }
        const float nr = lr * xr - li * xi + ur, ni = lr * xi + li * xr + ui;
        xr = nr; xi = ni;
        sre[pp] = xr; sim[pp] = xi;
        __syncthreads();
        float s = 0.f;
#pragma unroll
        for (int j = 0; j < 16; ++j) s += sre[q * 16 + j] * cre[j] - sim[q * 16 + j] * cim[j];
        s += __shfl_xor(s, 16); s += __shfl_xor(s, 32);
        if (q == 0) {
            const float y = s + dsk * u[(size_t)t * INC + h];
            p.ys[(size_t)(b * SEQ + c * SCH + t) * SSMW + g * SG + h] = gelu_f(y);
        }
        __syncthreads();
    }
}

__global__ void glu_kernel(const float* glu, float* cat) {
    const size_t i = (size_t)blockIdx.x * 256 + threadIdx.x;
    const size_t row = i / 512; const int col = (int)(i % 512);
    const float a = glu[row * 1024 + col], b = glu[row * 1024 + 512 + col];
    cat[row * 1536 + col] = a * sigmoid_f(b);
}

__global__ void __launch_bounds__(128) spatial_kernel(const float* proj, const float* vn, const float* w_sp, const float* b_sp, float* cat) {
    const int d = threadIdx.x;
    const int t = blockIdx.x % CHUNK, h = (blockIdx.x / CHUNK) % SH, bc = blockIdx.x / (CHUNK * SH);
    const size_t row0 = (size_t)bc * CHUNK;
    const float* w = w_sp + ((size_t)h * CHUNK + t) * CHUNK;
    float s = 0.f;
    for (int ss = 0; ss <= t; ++ss) s = fmaf(w[ss], vn[(row0 + ss) * SGUW + h * SHD + d], s);
    s += b_sp[h * CHUNK + t];
    const float u = proj[(row0 + t) * INC + 512 + h * SHD + d];
    cat[(row0 + t) * 1536 + 512 + h * SHD + d] = u * s;
}

__global__ void __launch_bounds__(256) attn_kernel(const float* proj, const float* kv, float* cat) {
    __shared__ float sq[128]; __shared__ float sp[256]; __shared__ float red[4];
    const int tid = threadIdx.x; const int h = blockIdx.x % XH; const int tok = blockIdx.x / XH; const int b = tok / SEQ;
    if (tid < 128) sq[tid] = proj[(size_t)tok * INC + 1536 + h * XD + tid];
    __syncthreads();
    const float* kr = kv + (size_t)(b * MEML + tid) * 1024 + h * XD;
    float s = 0.f;
    for (int d = 0; d < 128; ++d) s = fmaf(sq[d], kr[d], s);
    s *= 0.08838834764831845f;
    float m = s;
    for (int o = 32; o > 0; o >>= 1) m = fmaxf(m, __shfl_xor(m, o));
    if ((tid & 63) == 0) red[tid >> 6] = m;
    __syncthreads();
    m = fmaxf(fmaxf(red[0], red[1]), fmaxf(red[2], red[3]));
    __syncthreads();
    const float e = expf(s - m);
    sp[tid] = e;
    float l = e;
    for (int o = 32; o > 0; o >>= 1) l += __shfl_xor(l, o);
    if ((tid & 63) == 0) red[tid >> 6] = l;
    __syncthreads();
    l = red[0] + red[1] + red[2] + red[3];
    if (tid < 128) {
        float o = 0.f;
        const float* vr = kv + (size_t)(b * MEML) * 1024 + 512 + h * XD + tid;
        for (int mm = 0; mm < 256; ++mm) o = fmaf(sp[mm], vr[(size_t)mm * 1024], o);
        cat[(size_t)tok * 1536 + 1024 + h * XD + tid] = o / l;
    }
}

struct RouteP {
    const float* h; const float* g_ffn; const float *w_group, *b_group, *w_router, *b_router;
    float* xf; int* eid; float* ew; int* counts;
};
__global__ void __launch_bounds__(128) route_kernel(RouteP p) {
    __shared__ float sx[1024]; __shared__ float red[2]; __shared__ float lg[72];
    const int tok = blockIdx.x, tid = threadIdx.x;
    const float* hr = p.h + (size_t)tok * DM;
    float s = 0.f;
    for (int j = tid; j < DM; j += 128) { const float v = hr[j]; sx[j] = v; s += v * v; }
    for (int o = 32; o > 0; o >>= 1) s += __shfl_xor(s, o);
    if ((tid & 63) == 0) red[tid >> 6] = s;
    __syncthreads();
    const float rs = rsqrtf((red[0] + red[1]) / (float)DM + EPS);
    __syncthreads();
    for (int j = tid; j < DM; j += 128) { const float v = sx[j] * rs * p.g_ffn[j]; sx[j] = v; p.xf[(size_t)tok * DM + j] = v; }
    __syncthreads();
    if (tid < 72) {
        float a = 0.f;
        if (tid < 64) { for (int i = 0; i < DM; ++i) a = fmaf(sx[i], p.w_router[i * NE + tid], a); a += p.b_router[tid]; lg[8 + tid] = a; }
        else { const int g = tid - 64; for (int i = 0; i < DM; ++i) a = fmaf(sx[i], p.w_group[i * NGRP + g], a); a += p.b_group[g]; lg[g] = a; }
    }
    __syncthreads();
    if (tid == 0) {
        int gi = 0; float gm = lg[0];
        for (int g = 1; g < 8; ++g) if (lg[g] > gm) { gm = lg[g]; gi = g; }
        float den = 0.f; for (int g = 0; g < 8; ++g) den += expf(lg[g] - gm);
        const float gw = 1.f / den;
        const float* el = lg + 8 + gi * 8;
        int i0 = 0; float v0 = el[0];
        for (int e = 1; e < 8; ++e) if (el[e] > v0) { v0 = el[e]; i0 = e; }
        int i1 = -1; float v1 = -3.0e38f;
        for (int e = 0; e < 8; ++e) if (e != i0 && el[e] > v1) { v1 = el[e]; i1 = e; }
        const float w0 = 1.f / (1.f + expf(v1 - v0)), w1 = 1.f - w0;
        const int e0 = gi * 8 + i0, e1 = gi * 8 + i1;
        p.eid[tok * 2] = e0; p.eid[tok * 2 + 1] = e1;
        p.ew[tok * 2] = gw * w0; p.ew[tok * 2 + 1] = gw * w1;
        atomicAdd(&p.counts[e0], 1); atomicAdd(&p.counts[e1], 1);
    }
}
__global__ void offsets_kernel(const int* counts, int* rowStart, int* cursor) {
    if (threadIdx.x == 0) { int a = 0; for (int e = 0; e < NE; ++e) { rowStart[e] = a; a += counts[e]; cursor[e] = 0; } }
}
__global__ void scatter_kernel(const int* eid, const int* rowStart, int* cursor, int* srcTok, int* posOf) {
    const int i = blockIdx.x * 256 + threadIdx.x;
    if (i >= T * 2) return;
    const int e = eid[i];
    const int pos = rowStart[e] + atomicAdd(&cursor[e], 1);
    srcTok[pos] = i >> 1; posOf[i] = pos;
}
__global__ void __launch_bounds__(256) final_kernel(const float* h, const float* Y, const int* posOf, const float* ew, const float* g, float* out) {
    __shared__ float red[4];
    const int tok = blockIdx.x, tid = threadIdx.x;
    const int p0 = posOf[tok * 2], p1 = posOf[tok * 2 + 1];
    const float w0 = ew[tok * 2], w1 = ew[tok * 2 + 1];
    float v[4]; float s = 0.f;
#pragma unroll
    for (int j = 0; j < 4; ++j) {
        const int c = tid + 256 * j;
        v[j] = h[(size_t)tok * DM + c] + (w0 * Y[(size_t)p0 * DM + c] + w1 * Y[(size_t)p1 * DM + c]);
        s += v[j] * v[j];
    }
    for (int o = 32; o > 0; o >>= 1) s += __shfl_xor(s, o);
    if ((tid & 63) == 0) red[tid >> 6] = s;
    __syncthreads();
    const float rs = rsqrtf((red[0] + red[1] + red[2] + red[3]) / (float)DM + EPS);
#pragma unroll
    for (int j = 0; j < 4; ++j) { const int c = tid + 256 * j; out[(size_t)tok * DM + c] = v[j] * rs * g[c]; }
}

static void launch_gemm(hipStream_t st, GemmP p, int gy, int gz) {
    dim3 grid(p.N / 64, gy, gz);
    hipLaunchKernelGGL(sgemm_kernel, grid, dim3(256), 0, st, p);
}

extern "C" void kernel_launch(void* const* d_in, const int* in_sizes, int n_in, void* d_out, int out_size, void* d_ws, size_t ws_size, hipStream_t stream) {
    const float* x = (const float*)d_in[0];       const float* mem = (const float*)d_in[1];
    const float* g_mix = (const float*)d_in[2];   const float* g_mem = (const float*)d_in[3];
    const float* w_in = (const float*)d_in[4];    const float* w_gate = (const float*)d_in[5];
    const float* b_gate = (const float*)d_in[6];  const float* lam_re = (const float*)d_in[7];
    const float* lam_im = (const float*)d_in[8];  const float* log_dt = (const float*)d_in[9];
    const float* b_re = (const float*)d_in[10];   const float* b_im = (const float*)d_in[11];
    const float* c_re = (const float*)d_in[12];   const float* c_im = (const float*)d_in[13];
    const float* d_skip = (const float*)d_in[14]; const float* w_glu = (const float*)d_in[15];
    const float* b_glu = (const float*)d_in[16];  const float* g_sgu = (const float*)d_in[17];
    const float* w_spatial = (const float*)d_in[18]; const float* b_spatial = (const float*)d_in[19];
    const float* w_kv = (const float*)d_in[20];   const float* w_branch = (const float*)d_in[21];
    const float* w_out = (const float*)d_in[22];  const float* g_ffn = (const float*)d_in[23];
    const float* w_group = (const float*)d_in[24]; const float* b_group = (const float*)d_in[25];
    const float* w_router = (const float*)d_in[26]; const float* b_router = (const float*)d_in[27];
    const float* w1 = (const float*)d_in[28];     const float* w3 = (const float*)d_in[29];
    const float* w2 = (const float*)d_in[30];     const float* g_final = (const float*)d_in[31];
    float* out = (float*)d_out;

    const size_t MiB = 1u << 20;
    char* ws = (char*)d_ws;
    int*   ctl   = (int*)(ws);
    float* bufN  = (float*)(ws + 1 * MiB);
    float* bufP  = (float*)(ws + 65 * MiB);
    float* bufC  = (float*)(ws + 193 * MiB);
    float* bufY  = (float*)(ws + 289 * MiB);
    float* bufG  = (float*)(ws + 353 * MiB);
    float* bufKV = (float*)(ws + 417 * MiB);
    float* bufMN = (float*)(ws + 421 * MiB);
    float* xend  = (float*)(ws + 425 * MiB);
    float* xin   = (float*)(ws + 428 * MiB);
    int*   eid   = (int*)(ws + 431 * MiB);
    float* ewt   = (float*)(ws + 432 * MiB);
    int*   srcTok= (int*)(ws + 433 * MiB);
    int*   posOf = (int*)(ws + 434 * MiB);
    if (ws_size < 436 * MiB) { fprintf(stderr, "ws too small: %zu\n", ws_size); return; }
    int* counts = ctl; int* rowStart = ctl + 64; int* cursor = ctl + 128;

    hipMemsetAsync(ctl, 0, 1024, stream);

    hipLaunchKernelGGL(rmsnorm_kernel<4>, dim3(T), dim3(256), 0, stream, x, DM, g_mix, bufN, DM);
    hipLaunchKernelGGL(rmsnorm_kernel<4>, dim3(MROWS), dim3(256), 0, stream, mem, DM, g_mem, bufMN, DM);
    { GemmP p{}; p.A = bufN; p.lda = DM; p.B = w_in; p.ldb = INC; p.M = T; p.N = INC; p.K = DM; p.mode = 1; p.C = bufP; p.ldc = INC; launch_gemm(stream, p, 256, 1); }
    { GemmP p{}; p.A = bufMN; p.lda = DM; p.B = w_kv; p.ldb = 1024; p.M = MROWS; p.N = 1024; p.K = DM; p.mode = 0; p.C = bufKV; p.ldc = 1024; launch_gemm(stream, p, 16, 1); }
    { SsmP sp{bufP, lam_re, lam_im, log_dt, b_re, b_im, c_re, c_im, d_skip, xend, xin, bufY};
      hipLaunchKernelGGL(ssm_pass1, dim3(BATCH * NSC * NG), dim3(64), 0, stream, sp);
      hipLaunchKernelGGL(ssm_carry, dim3(BATCH * NG), dim3(64), 0, stream, sp);
      hipLaunchKernelGGL(ssm_pass2, dim3(BATCH * NSC * NG), dim3(64), 0, stream, sp); }
    { GemmP p{}; p.A = bufY; p.lda = SSMW; p.B = w_glu; p.ldb = 1024; p.M = T; p.N = 1024; p.K = SSMW; p.mode = 0; p.bias = b_glu; p.C = bufG; p.ldc = 1024; launch_gemm(stream, p, 256, 1); }
    hipLaunchKernelGGL(glu_kernel, dim3(T * 512 / 256), dim3(256), 0, stream, bufG, bufC);
    hipLaunchKernelGGL(rmsnorm_kernel<2>, dim3(T), dim3(256), 0, stream, bufP + 1024, INC, g_sgu, bufG, SGUW);
    hipLaunchKernelGGL(spatial_kernel, dim3(BATCH * (SEQ / CHUNK) * SH * CHUNK), dim3(128), 0, stream, bufP, bufG, w_spatial, b_spatial, bufC);
    hipLaunchKernelGGL(attn_kernel, dim3(T * XH), dim3(256), 0, stream, bufP, bufKV, bufC);
    float* bufBr = bufP; float* bufM = bufP + (size_t)T * DM;
    for (int i = 0; i < 3; ++i) {
        { GemmP p{}; p.A = bufC + i * 512; p.lda = 1536; p.B = w_branch + (size_t)i * 512 * DM; p.ldb = DM; p.M = T; p.N = DM; p.K = 512; p.mode = 0; p.C = bufBr; p.ldc = DM; launch_gemm(stream, p, 256, 1); }
        { GemmP p{}; p.A = bufN; p.lda = DM; p.B = w_gate + i * DM; p.ldb = 3 * DM; p.M = T; p.N = DM; p.K = DM; p.mode = 2; p.bias = b_gate + i * DM; p.aux = bufBr; p.ldaux = DM; p.accum = (i > 0); p.C = bufM; p.ldc = DM; launch_gemm(stream, p, 256, 1); }
    }
    { GemmP p{}; p.A = bufM; p.lda = DM; p.B = w_out; p.ldb = DM; p.M = T; p.N = DM; p.K = DM; p.mode = 3; p.aux = x; p.ldaux = DM; p.C = bufN; p.ldc = DM; launch_gemm(stream, p, 256, 1); }
    float* bufXF = bufC;
    { RouteP rp{bufN, g_ffn, w_group, b_group, w_router, b_router, bufXF, eid, ewt, counts};
      hipLaunchKernelGGL(route_kernel, dim3(T), dim3(128), 0, stream, rp); }
    hipLaunchKernelGGL(offsets_kernel, dim3(1), dim3(64), 0, stream, counts, rowStart, cursor);
    hipLaunchKernelGGL(scatter_kernel, dim3(T * 2 / 256), dim3(256), 0, stream, eid, rowStart, cursor, srcTok, posOf);
    float* bufH = bufY;
    float* bufYo = bufP;
    { GemmP p{}; p.A = bufXF; p.lda = DM; p.gather = srcTok; p.B = w1; p.ldb = DFF; p.strideB = (long)DM * DFF; p.rowStart = rowStart; p.rowCount = counts; p.M = 0; p.N = DFF; p.K = DM; p.mode = 0; p.C = bufH; p.ldc = DFF; launch_gemm(stream, p, 16, NE); }
    { GemmP p{}; p.A = bufXF; p.lda = DM; p.gather = srcTok; p.B = w3; p.ldb = DFF; p.strideB = (long)DM * DFF; p.rowStart = rowStart; p.rowCount = counts; p.M = 0; p.N = DFF; p.K = DM; p.mode = 4; p.C = bufH; p.ldc = DFF; launch_gemm(stream, p, 16, NE); }
    { GemmP p{}; p.A = bufH; p.lda = DFF; p.B = w2; p.ldb = DM; p.strideB = (long)DFF * DM; p.rowStart = rowStart; p.rowCount = counts; p.M = 0; p.N = DM; p.K = DFF; p.mode = 0; p.C = bufYo; p.ldc = DM; launch_gemm(stream, p, 16, NE); }
    hipLaunchKernelGGL(final_kernel, dim3(T), dim3(256), 0, stream, bufN, bufYo, posOf, ewt, g_final, out);
}
```

```cpp
#include <hip/hip_runtime.h>
#include <cstdio>
#include <cstdint>

constexpr int BATCH = 4, SEQ = 4096, DM = 1024, T = BATCH * SEQ;
constexpr int MEML = 256, MROWS = BATCH * MEML;
constexpr int SSMW = 512, SG = 16, NG = 32, NP = 64;
constexpr int SGUW = 512, SH = 4, SHD = 128, CHUNK = 128;
constexpr int XH = 4, XD = 128, XW = 512;
constexpr int INC = 2048;
constexpr int NGRP = 8, EPG = 8, NE = 64, DFF = 512;
constexpr float EPS = 1e-6f;
constexpr int SCH = 128;
constexpr int NSC = SEQ / SCH;

#define LAS __attribute__((address_space(3)))
#define GAS __attribute__((address_space(1)))
typedef _Float16 half_t;
typedef _Float16 f16x8 __attribute__((ext_vector_type(8)));
typedef _Float16 f16x4 __attribute__((ext_vector_type(4)));
typedef _Float16 f16x2 __attribute__((ext_vector_type(2)));
typedef float f32x4 __attribute__((ext_vector_type(4)));
typedef float f32x2 __attribute__((ext_vector_type(2)));
typedef unsigned u32x4 __attribute__((ext_vector_type(4)));
typedef unsigned u32x2 __attribute__((ext_vector_type(2)));

__device__ __forceinline__ unsigned pk_h2(float lo, float hi) { f16x2 v; v.x = (_Float16)lo; v.y = (_Float16)hi; return __builtin_bit_cast(unsigned, v); }
__device__ __forceinline__ float fast_sigmoid(float x) { return __builtin_amdgcn_rcpf(1.f + __builtin_amdgcn_exp2f(-1.4426950408889634f * x)); }
__device__ __forceinline__ float fast_gelu(float x) {
    const float u = 0.7978845608028654f * (x + 0.044715f * x * x * x);
    return x * __builtin_amdgcn_rcpf(1.f + __builtin_amdgcn_exp2f(-2.885390081777927f * u));
}

namespace pg {
constexpr int BM = 256, BK = 64, HALF = 128, HTB = HALF * BK * 2, STAGE_BYTES = 8 * HTB, NXCD = 8, WGM = 8;

__host__ __device__ __forceinline__ int lds_byte(int r, int c) { const int st = (r >> 4) * 2 + (c >> 5), rr = r & 15, cc = c & 31, ob = rr * 64 + cc * 2; return st * 1024 + (ob ^ (((ob >> 9) & 1) << 5)); }
__host__ __device__ __forceinline__ void stage_rc(int b, int& R, int& C) { const int st = b / 1024, sb = b % 1024, swz = sb ^ (((sb >> 9) & 1) << 5); R = (st >> 1) * 16 + swz / 64; C = (st & 1) * 32 + (swz % 64) / 2; }
__host__ __device__ __forceinline__ int perm32(int rho) { const int n = rho >> 4, i = rho & 15; return 8 * (i >> 2) + 4 * n + (i & 3); }

struct Unit { const char* A; const char* B; int pm, pn, aux; };

struct OrderMN {
    int nM, nN, nwg, G, c; const char* A; const char* B; size_t tA, tB;
    __device__ void init(int M, int N, int G_, int c_, const void* A_, size_t lda, const void* B_, size_t ldb) { nM = M / BM; nN = N / BM; nwg = nM * nN; G = G_; c = c_; A = (const char*)A_; B = (const char*)B_; tA = (size_t)BM * lda * 2; tB = (size_t)BM * ldb * 2; }
    __device__ bool next(int i, Unit& u) const {
        const long L = (long)i * G + c; if (L >= nwg) return false;
        int wgid = (int)L; { const int q = nwg / NXCD, r = nwg % NXCD, xcd = wgid % NXCD, off = wgid / NXCD; wgid = (xcd < r ? xcd * (q + 1) : r * (q + 1) + (xcd - r) * q) + off; }
        const int nig = WGM * nN, gid = wgid / nig, fm = gid * WGM, gsz = (nM - fm) < WGM ? (nM - fm) : WGM;
        u.pm = fm + ((wgid % nig) % gsz); u.pn = (wgid % nig) / gsz; u.aux = 0;
        u.A = A + (size_t)u.pm * tA; u.B = B + (size_t)u.pn * tB; return true;
    }
};

template <class Epi, class Sched, bool ALIGN_EPI, bool SP2>
__device__ __forceinline__ void gemm_phase(LAS unsigned char* lds, const int lda, const int ldb, const int nt, const Sched& S, const Epi& E) {
    const int tid = threadIdx.x, wid = __builtin_amdgcn_readfirstlane(tid >> 6), lane = tid & 63, wr = wid >> 2, wc = wid & 3, fr = lane & 15, fq = lane >> 4;
    unsigned voffA[2], voffB[2];
#pragma unroll
    for (int i = 0; i < 2; ++i) { int R, C; stage_rc(tid * 16 + i * 8192, R, C); const int Rb = Epi::PERM ? ((R & ~31) + perm32(R & 31)) : R;
        voffA[i] = (unsigned)(R * lda + C) * 2u; voffB[i] = (unsigned)(Rb * ldb + C) * 2u; }
    const size_t kstep = (size_t)(BK * 2);
    const size_t hstepA = (size_t)HALF * lda * 2, hstepB = (size_t)HALF * ldb * 2;
    const unsigned ldsw = (unsigned)wid * 1024u;
    const int aoff = lds_byte(wr * 64 + fr, fq * 8), boff = lds_byte(wc * 32 + fr, fq * 8);
#define PG_SA(b, h) (((b) * 2 + (h)) * HTB)
#define PG_SB(b, h) ((4 + (b) * 2 + (h)) * HTB)
#define PG_STAGE(bufoff, gbase, voff) do { _Pragma("unroll") for (int _i = 0; _i < 2; ++_i) \
        __builtin_amdgcn_global_load_lds((const unsigned*)((const char*)(gbase) + (voff)[_i]), (LAS unsigned*)(lds + (bufoff) + ldsw + _i * 8192), 16, 0, 0); } while (0)
#define PG_LDA(dst, b, h) do { _Pragma("unroll") for (int m = 0; m < 4; ++m) _Pragma("unroll") for (int k = 0; k < 2; ++k) dst[m][k] = *(const LAS f16x8*)(lds + PG_SA(b, h) + aoff + m * 2048 + k * 1024); } while (0)
#define PG_LDB(dst, b, h) do { _Pragma("unroll") for (int n = 0; n < 2; ++n) _Pragma("unroll") for (int k = 0; k < 2; ++k) dst[n][k] = *(const LAS f16x8*)(lds + PG_SB(b, h) + boff + n * 2048 + k * 1024); } while (0)
#define PG_MMA(ai, bj, At, Bt) do { __builtin_amdgcn_s_setprio(1); _Pragma("unroll") for (int m = 0; m < 4; ++m) _Pragma("unroll") for (int n = 0; n < 2; ++n) _Pragma("unroll") for (int k = 0; k < 2; ++k) \
        acc[ai][bj][m][n] = __builtin_amdgcn_mfma_f32_16x16x32_f16(Bt[n][k], At[m][k], acc[ai][bj][m][n], 0, 0, 0); __builtin_amdgcn_s_setprio(0); } while (0)
#define PG_WAIT_V(n) asm volatile("s_waitcnt vmcnt(" #n ")" ::: "memory")
#define PG_WAIT_L(n) asm volatile("s_waitcnt lgkmcnt(" #n ")" ::: "memory")
#define PG_BAR __builtin_amdgcn_s_barrier()
#define PG_SCHED __builtin_amdgcn_sched_barrier(0)
    Unit cur, nxt; int ui = 0;
    if (!S.next(0, cur)) return;
    f32x4 acc[2][2][4][2];
#pragma unroll
    for (int a = 0; a < 2; ++a)
#pragma unroll
        for (int b = 0; b < 2; ++b)
#pragma unroll
            for (int m = 0; m < 4; ++m)
#pragma unroll
                for (int n = 0; n < 2; ++n) acc[a][b][m][n] = (f32x4){0.f, 0.f, 0.f, 0.f};
    f16x8 At[4][2], B0[2][2], B1[2][2];
    const char* cA = cur.A; const char* cB = cur.B;
    if constexpr (SP2) {
        PG_STAGE(PG_SB(0, 0), cB, voffB); PG_STAGE(PG_SB(0, 1), cB + hstepB, voffB); PG_STAGE(PG_SA(0, 0), cA, voffA); PG_STAGE(PG_SA(0, 1), cA + hstepA, voffA);
        if (wr == 1) PG_BAR;
        PG_WAIT_V(2); PG_BAR;
        PG_STAGE(PG_SB(1, 0), cB + kstep, voffB); PG_STAGE(PG_SA(1, 0), cA + kstep, voffA); PG_STAGE(PG_SB(1, 1), cB + hstepB + kstep, voffB);
        PG_WAIT_V(6); PG_BAR;
    } else {
        PG_STAGE(PG_SB(0, 0), cB, voffB); PG_STAGE(PG_SA(0, 0), cA, voffA); PG_STAGE(PG_SB(0, 1), cB + hstepB, voffB); PG_STAGE(PG_SA(0, 1), cA + hstepA, voffA);
        if (wr == 1) PG_BAR;
        PG_WAIT_V(4); PG_BAR;
        PG_STAGE(PG_SB(1, 0), cB + kstep, voffB); PG_STAGE(PG_SA(1, 0), cA + kstep, voffA); PG_STAGE(PG_SB(1, 1), cB + hstepB + kstep, voffB);
        PG_WAIT_V(6); PG_BAR;
    }
    for (;;) {
        const bool has_next = S.next(ui + 1, nxt);
        const char* nA = has_next ? nxt.A : cA; const char* nB = has_next ? nxt.B : cB;
        for (int t = 0; t < nt; t += 2) {
            const bool last = (t == nt - 2);
            const char* a1 = cA + (size_t)(t + 1) * kstep;
            const char* a2 = last ? nA : cA + (size_t)(t + 2) * kstep; const char* b2 = last ? nB : cB + (size_t)(t + 2) * kstep;
            const char* a3 = a2 + kstep; const char* b3 = b2 + kstep;
            if constexpr (SP2) {
            PG_LDB(B0, 0, 0); PG_LDB(B1, 0, 1); PG_SCHED; PG_LDA(At, 0, 0); PG_STAGE(PG_SA(1, 1), a1 + hstepA, voffA);
            PG_WAIT_V(8); PG_WAIT_L(0); PG_BAR; PG_MMA(0, 0, At, B0); PG_MMA(0, 1, At, B1); PG_BAR; PG_SCHED;
            PG_LDA(At, 0, 1); PG_STAGE(PG_SB(0, 0), b2, voffB); PG_STAGE(PG_SB(0, 1), b2 + hstepB, voffB); PG_STAGE(PG_SA(0, 0), a2, voffA);
            PG_WAIT_V(8); PG_WAIT_L(0); PG_BAR; PG_MMA(1, 0, At, B0); PG_MMA(1, 1, At, B1); PG_BAR; PG_SCHED;
            PG_LDB(B0, 1, 0); PG_LDB(B1, 1, 1); PG_SCHED; PG_LDA(At, 1, 0); PG_STAGE(PG_SA(0, 1), a2 + hstepA, voffA);
            PG_WAIT_V(8); PG_WAIT_L(0); PG_BAR; PG_MMA(0, 0, At, B0); PG_MMA(0, 1, At, B1); PG_BAR; PG_SCHED;
            PG_LDA(At, 1, 1); PG_STAGE(PG_SB(1, 0), b3, voffB); PG_STAGE(PG_SB(1, 1), b3 + hstepB, voffB); PG_STAGE(PG_SA(1, 0), a3, voffA);
            PG_WAIT_V(8); PG_WAIT_L(0); PG_BAR; PG_MMA(1, 0, At, B0); PG_MMA(1, 1, At, B1); PG_BAR; PG_SCHED;
            } else {
            PG_LDB(B0, 0, 0); PG_SCHED; PG_LDA(At, 0, 0); PG_STAGE(PG_SA(1, 1), a1 + hstepA, voffA);
            PG_WAIT_L(8); PG_BAR; PG_WAIT_L(0); PG_MMA(0, 0, At, B0); PG_BAR; PG_SCHED;
            PG_LDB(B1, 0, 1); PG_STAGE(PG_SB(0, 0), b2, voffB);
            PG_BAR; PG_WAIT_L(0); PG_MMA(0, 1, At, B1); PG_BAR;
            PG_LDA(At, 0, 1); PG_STAGE(PG_SA(0, 0), a2, voffA);
            PG_BAR; PG_WAIT_L(0); PG_MMA(1, 0, At, B0); PG_BAR; PG_SCHED;
            PG_STAGE(PG_SB(0, 1), b2 + hstepB, voffB);
            PG_WAIT_V(6); PG_BAR; PG_MMA(1, 1, At, B1); PG_BAR;
            PG_LDB(B0, 1, 0); PG_SCHED; PG_LDA(At, 1, 0); PG_STAGE(PG_SA(0, 1), a2 + hstepA, voffA);
            PG_WAIT_L(8); PG_BAR; PG_WAIT_L(0); PG_MMA(0, 0, At, B0); PG_BAR; PG_SCHED;
            PG_LDB(B1, 1, 1); PG_STAGE(PG_SB(1, 0), b3, voffB);
            PG_BAR; PG_WAIT_L(0); PG_MMA(0, 1, At, B1); PG_BAR;
            PG_LDA(At, 1, 1); PG_STAGE(PG_SA(1, 0), a3, voffA);
            PG_BAR; PG_WAIT_L(0); PG_MMA(1, 0, At, B0); PG_BAR; PG_SCHED;
            PG_STAGE(PG_SB(1, 1), b3 + hstepB, voffB);
            PG_WAIT_V(6); PG_BAR; PG_MMA(1, 1, At, B1); PG_BAR;
            }
        }
        if constexpr (ALIGN_EPI) { if (wr == 0) PG_BAR; }
        E(acc, cur, wr, wc, fr, fq);
        if (!has_next) break;
#pragma unroll
        for (int a = 0; a < 2; ++a)
#pragma unroll
            for (int b = 0; b < 2; ++b)
#pragma unroll
                for (int m = 0; m < 4; ++m)
#pragma unroll
                    for (int n = 0; n < 2; ++n) acc[a][b][m][n] = (f32x4){0.f, 0.f, 0.f, 0.f};
        cur = nxt; cA = nA; cB = nB; ++ui;
        if constexpr (ALIGN_EPI) { if (wr == 1) PG_BAR; }
    }
    PG_WAIT_V(0);
    if constexpr (!ALIGN_EPI) { if (wr == 0) PG_BAR; }
    PG_BAR;
#undef PG_SA
#undef PG_SB
#undef PG_STAGE
#undef PG_LDA
#undef PG_LDB
#undef PG_MMA
#undef PG_WAIT_V
#undef PG_WAIT_L
#undef PG_BAR
#undef PG_SCHED
}

struct EpiProj {
    static constexpr bool PERM = true;
    half_t* O; int ldc;
    __device__ __forceinline__ void operator()(const f32x4 (&acc)[2][2][4][2], const Unit& u, int wr, int wc, int fr, int fq) const {
        const int row0 = u.pm * BM + wr * 64 + fr, col0 = u.pn * BM + wc * 32 + 8 * fq;
        const bool act = (u.pn >= 2 && u.pn < 6);
#pragma unroll
        for (int ai = 0; ai < 2; ++ai)
#pragma unroll
            for (int m = 0; m < 4; ++m) { half_t* rowp = O + (size_t)(row0 + ai * HALF + m * 16) * ldc + col0;
#pragma unroll
                for (int bj = 0; bj < 2; ++bj) { f32x4 v0 = acc[ai][bj][m][0], v1 = acc[ai][bj][m][1];
                    if (act) {
#pragma unroll
                        for (int j = 0; j < 4; ++j) { v0[j] = fast_gelu(v0[j]); v1[j] = fast_gelu(v1[j]); } }
                    u32x4 w; w.x = pk_h2(v0[0], v0[1]); w.y = pk_h2(v0[2], v0[3]); w.z = pk_h2(v1[0], v1[1]); w.w = pk_h2(v1[2], v1[3]);
                    *(u32x4*)(rowp + bj * HALF) = w; } }
    }
};

struct EpiGlu {
    static constexpr bool PERM = true;
    half_t* O; int ldc; const float* bias;
    __device__ __forceinline__ void operator()(const f32x4 (&acc)[2][2][4][2], const Unit& u, int wr, int wc, int fr, int fq) const {
        const int row0 = u.pm * BM + wr * 64 + fr, col0 = u.pn * HALF + wc * 32 + 8 * fq;
        const f32x4 ba0 = *(const f32x4*)(bias + col0), ba1 = *(const f32x4*)(bias + col0 + 4), bb0 = *(const f32x4*)(bias + 512 + col0), bb1 = *(const f32x4*)(bias + 512 + col0 + 4);
#pragma unroll
        for (int ai = 0; ai < 2; ++ai)
#pragma unroll
            for (int m = 0; m < 4; ++m) {
                const f32x4 a0 = acc[ai][0][m][0] + ba0, a1 = acc[ai][0][m][1] + ba1, b0 = acc[ai][1][m][0] + bb0, b1 = acc[ai][1][m][1] + bb1;
                u32x4 w; w.x = pk_h2(a0[0] * fast_sigmoid(b0[0]), a0[1] * fast_sigmoid(b0[1])); w.y = pk_h2(a0[2] * fast_sigmoid(b0[2]), a0[3] * fast_sigmoid(b0[3]));
                w.z = pk_h2(a1[0] * fast_sigmoid(b1[0]), a1[1] * fast_sigmoid(b1[1])); w.w = pk_h2(a1[2] * fast_sigmoid(b1[2]), a1[3] * fast_sigmoid(b1[3]));
                *(u32x4*)(O + (size_t)(row0 + ai * HALF + m * 16) * ldc + col0) = w; }
    }
};
struct EpiGate {
    static constexpr bool PERM = true;
    half_t* O; int ldc; const float* bias;
    __device__ __forceinline__ void operator()(const f32x4 (&acc)[2][2][4][2], const Unit& u, int wr, int wc, int fr, int fq) const {
        const int row0 = u.pm * BM + wr * 64 + fr, col0 = u.pn * BM + wc * 32 + 8 * fq;
        f32x4 bv[2][2];
#pragma unroll
        for (int bj = 0; bj < 2; ++bj)
#pragma unroll
            for (int n = 0; n < 2; ++n) bv[bj][n] = *(const f32x4*)(bias + col0 + bj * HALF + 4 * n);
#pragma unroll
        for (int ai = 0; ai < 2; ++ai)
#pragma unroll
            for (int m = 0; m < 4; ++m) { half_t* rowp = O + (size_t)(row0 + ai * HALF + m * 16) * ldc + col0;
#pragma unroll
                for (int bj = 0; bj < 2; ++bj) { const f32x4 v0 = acc[ai][bj][m][0] + bv[bj][0], v1 = acc[ai][bj][m][1] + bv[bj][1];
                    u32x4 w; w.x = pk_h2(fast_sigmoid(v0[0]), fast_sigmoid(v0[1])); w.y = pk_h2(fast_sigmoid(v0[2]), fast_sigmoid(v0[3])); w.z = pk_h2(fast_sigmoid(v1[0]), fast_sigmoid(v1[1])); w.w = pk_h2(fast_sigmoid(v1[2]), fast_sigmoid(v1[3]));
                    *(u32x4*)(rowp + bj * HALF) = w; } }
    }
};
struct EpiBranch {
    static constexpr bool PERM = true;
    half_t* O; const half_t* G;
    __device__ __forceinline__ void operator()(const f32x4 (&acc)[2][2][4][2], const Unit& u, int wr, int wc, int fr, int fq) const {
        const int row0 = u.pm * BM + wr * 64 + fr, col0 = u.pn * BM + wc * 32 + 8 * fq; const int i = u.aux;
#pragma unroll
        for (int ai = 0; ai < 2; ++ai)
#pragma unroll
            for (int m = 0; m < 4; ++m) { const size_t r = (size_t)(row0 + ai * HALF + m * 16);
#pragma unroll
                for (int bj = 0; bj < 2; ++bj) {
                    const f16x8 gv = *(const f16x8*)(G + r * 3072 + i * 1024 + col0 + bj * HALF);
                    f16x8 pv = {0, 0, 0, 0, 0, 0, 0, 0};
                    if (i > 0) pv = *(const f16x8*)(O + r * 1024 + col0 + bj * HALF);
                    const f32x4 v0 = acc[ai][bj][m][0], v1 = acc[ai][bj][m][1];
                    u32x4 w; w.x = pk_h2((float)pv[0] + (float)gv[0] * v0[0], (float)pv[1] + (float)gv[1] * v0[1]); w.y = pk_h2((float)pv[2] + (float)gv[2] * v0[2], (float)pv[3] + (float)gv[3] * v0[3]);
                    w.z = pk_h2((float)pv[4] + (float)gv[4] * v1[0], (float)pv[5] + (float)gv[5] * v1[1]); w.w = pk_h2((float)pv[6] + (float)gv[6] * v1[2], (float)pv[7] + (float)gv[7] * v1[3]);
                    *(u32x4*)(O + r * 1024 + col0 + bj * HALF) = w; } }
    }
};
struct EpiOut {
    static constexpr bool PERM = false;
    float* O; const float* X; int ldc;
    __device__ __forceinline__ void operator()(const f32x4 (&acc)[2][2][4][2], const Unit& u, int wr, int wc, int fr, int fq) const {
        const int row0 = u.pm * BM + wr * 64 + fr, col0 = u.pn * BM + wc * 32 + 4 * fq;
#pragma unroll
        for (int ai = 0; ai < 2; ++ai)
#pragma unroll
            for (int m = 0; m < 4; ++m) { const size_t off = (size_t)(row0 + ai * HALF + m * 16) * ldc + col0;
#pragma unroll
                for (int bj = 0; bj < 2; ++bj)
#pragma unroll
                    for (int n = 0; n < 2; ++n) *(f32x4*)(O + off + bj * HALF + n * 16) = *(const f32x4*)(X + off + bj * HALF + n * 16) + acc[ai][bj][m][n]; }
    }
};
struct OrderBr {
    OrderMN base; const char* A; const char* B;
    __device__ void init(int G_, int c_, const void* cat, const void* wbr) { base.init(T, 1024, G_, c_, nullptr, 0, nullptr, 0); A = (const char*)cat; B = (const char*)wbr; }
    __device__ bool next(int j, Unit& u) const {
        const int r = j / 3, i = j - 3 * r;
        if (!base.next(r, u)) return false;
        u.aux = i;
        u.A = A + (size_t)u.pm * BM * 1536 * 2 + (size_t)i * 512 * 2;
        u.B = B + (size_t)i * 1024 * 512 * 2 + (size_t)u.pn * BM * 512 * 2;
        return true;
    }
};
}

constexpr int NWAVES = 8;
constexpr int RING_OFF = 0, RING_BYTES = 131072;
constexpr int LDSCTL_OFF = RING_BYTES, MISC_OFF = LDSCTL_OFF + 320;
constexpr int LDS_BYTES = 147456;
typedef GAS unsigned gu32;
#define RLX_AGENT __ATOMIC_RELAXED, __HIP_MEMORY_SCOPE_AGENT
#define LDS_WAIT() asm volatile("s_waitcnt lgkmcnt(0)" ::: "memory")
#define VM_WAIT() asm volatile("s_waitcnt vmcnt(0)" ::: "memory")

#define XB_TMO      128
#define XB_XCNT(j)  (256  + 64 * (j))
#define XB_XSUB(j)  (1280 + 64 * (j))
#define XB_XGEN(j)  (2304 + 64 * (j))
#define XB_TOP      3328
#define XB_TOPGEN   3392
#define XCD_BAR_WORDS 3456
#define XB_SPIN_CAP (1u << 18)
__device__ __forceinline__ unsigned xb_ld(unsigned* p)              { return __hip_atomic_load(p, __ATOMIC_RELAXED, __HIP_MEMORY_SCOPE_AGENT); }
__device__ __forceinline__ unsigned xb_add(unsigned* p, unsigned v) { return __hip_atomic_fetch_add(p, v, __ATOMIC_RELAXED, __HIP_MEMORY_SCOPE_AGENT); }
__device__ __forceinline__ unsigned xb_xcc_id() { return (unsigned)__builtin_amdgcn_s_getreg((3 << 11) | 20) & 0xFu; }
#define XB_SPIN(cond, bar) do { unsigned _sp = 0; while (cond) { __builtin_amdgcn_s_sleep(1); \
    if ((++_sp & 255u) == 0u) { if (xb_ld(&(bar)[XB_TMO])) break; if (_sp > XB_SPIN_CAP) { atomicAdd(&(bar)[XB_TMO], 1u); break; } } } } while (0)
struct XcdBarrier { unsigned* bar; unsigned x; volatile LAS unsigned* st; };
__device__ __forceinline__ XcdBarrier xcd_barrier_post(unsigned* bar, volatile LAS unsigned* st) {
    XcdBarrier b; b.bar = bar; b.x = xb_xcc_id(); b.st = st;
    if (threadIdx.x == 0) (void)xb_add(&bar[XB_XCNT(b.x)], 1u);
    return b;
}
__device__ __forceinline__ void xcd_barrier_complete(unsigned* bar, unsigned x, unsigned& nloc, unsigned& nx) {
    const unsigned G = gridDim.x * gridDim.y * gridDim.z;
    unsigned sum, cnt, mine, sp = 0u;
    for (;;) {
        sum = 0u; cnt = 0u; mine = 0u;
#pragma unroll
        for (unsigned j = 0; j < 16; ++j) { const unsigned c = xb_ld(&bar[XB_XCNT(j)]); sum += c; cnt += (c > 0u) ? 1u : 0u; mine = (j == x) ? c : mine; }
        if (sum == G) break;
        __builtin_amdgcn_s_sleep(1);
        if ((++sp & 255u) == 0u) { if (xb_ld(&bar[XB_TMO])) break; if (sp > XB_SPIN_CAP) { atomicAdd(&bar[XB_TMO], 1u); break; } }
    }
    nloc = mine > 0u ? mine : 1u; nx = cnt > 0u ? cnt : 1u;
}
__device__ __forceinline__ void xcd_barrier(const XcdBarrier& b) {
    asm volatile("s_waitcnt vmcnt(0)" ::: "memory");
    __syncthreads();
    if (threadIdx.x == 0) {
        unsigned* bar = b.bar;
        __builtin_amdgcn_s_waitcnt(0);
        unsigned nloc = b.st[0], nx = b.st[1];
        if (nloc == 0u) { xcd_barrier_complete(bar, b.x, nloc, nx); b.st[0] = nloc; b.st[1] = nx; }
        const unsigned old = xb_add(&bar[XB_XSUB(b.x)], 1u);
        const unsigned gen = old / nloc;
        if (old + 1u == (gen + 1u) * nloc) {
            __builtin_amdgcn_fence(__ATOMIC_RELEASE, "agent");
            asm volatile("s_waitcnt vmcnt(0)" ::: "memory");
            const unsigned og = xb_add(&bar[XB_TOP], 1u);
            const unsigned tg = og / nx;
            if (og + 1u == (tg + 1u) * nx) xb_add(&bar[XB_TOPGEN], 1u);
            else XB_SPIN(xb_ld(&bar[XB_TOPGEN]) == tg, bar);
            __builtin_amdgcn_fence(__ATOMIC_ACQUIRE, "agent");
            xb_add(&bar[XB_XGEN(b.x)], 1u);
            asm volatile("s_waitcnt vmcnt(0)" ::: "memory");
        } else {
            XB_SPIN(xb_ld(&bar[XB_XGEN(b.x)]) == gen, bar);
            __builtin_amdgcn_fence(__ATOMIC_ACQUIRE, "agent");
            asm volatile("s_waitcnt vmcnt(0)" ::: "memory");
        }
    }
    __syncthreads();
}

__device__ __forceinline__ float wave_sum(float v) {
#pragma unroll
    for (int o = 1; o < 64; o <<= 1) v += __shfl_xor(v, o);
    return v;
}

__device__ __forceinline__ void transpose_item(const float* W, int ldw, int k0, int n0, half_t* WT, int ldt, int drow0, LAS float* scr, int lane) {
    const int lk = lane >> 3, lc = (lane & 7) * 4;
    f32x4 v[8];
#pragma unroll
    for (int i = 0; i < 8; ++i) v[i] = *(const GAS f32x4*)(W + (size_t)(k0 + i * 8 + lk) * ldw + n0 + lc);
#pragma unroll
    for (int i = 0; i < 8; ++i) { LAS float* s = scr + (i * 8 + lk) * 33 + lc; s[0] = v[i].x; s[1] = v[i].y; s[2] = v[i].z; s[3] = v[i].w; }
    LDS_WAIT(); asm volatile("" ::: "memory");
    const int c = lane & 7;
#pragma unroll
    for (int j = 0; j < 4; ++j) { const int n = (lane >> 3) + 8 * j; const LAS float* s = scr + (8 * c) * 33 + n;
        u32x4 o; o.x = pk_h2(s[0 * 33], s[1 * 33]); o.y = pk_h2(s[2 * 33], s[3 * 33]); o.z = pk_h2(s[4 * 33], s[5 * 33]); o.w = pk_h2(s[6 * 33], s[7 * 33]);
        *(GAS u32x4*)(WT + (size_t)(drow0 + n) * ldt + k0 + 8 * c) = o; }
    LDS_WAIT(); asm volatile("" ::: "memory");
}
__device__ __forceinline__ void rms_row_to_f16(const float* xrow, const float* g, half_t* orow, int lane) {
    const GAS f32x4* xr = (const GAS f32x4*)xrow + lane;
    const GAS f32x4* gr = (const GAS f32x4*)g + lane;
    f32x4 v[4]; float s = 0.f;
#pragma unroll
    for (int j = 0; j < 4; ++j) { v[j] = xr[64 * j]; s += (v[j].x * v[j].x + v[j].y * v[j].y) + (v[j].z * v[j].z + v[j].w * v[j].w); }
    const float rs = 1.0f / sqrtf(wave_sum(s) * (1.f / 1024.f) + EPS);
    GAS u32x2* o8 = (GAS u32x2*)orow + lane;
#pragma unroll
    for (int j = 0; j < 4; ++j) { const f32x4 gg = gr[64 * j]; u32x2 w; w.x = pk_h2(v[j].x * rs * gg.x, v[j].y * rs * gg.y); w.y = pk_h2(v[j].z * rs * gg.z, v[j].w * rs * gg.w); o8[64 * j] = w; }
}

typedef float f32x16 __attribute__((ext_vector_type(16)));
__device__ __forceinline__ int crow(int r, int hi) { return (r & 3) + 8 * (r >> 2) + 4 * hi; }

__device__ __forceinline__ void kv_tile(const half_t* __restrict__ A  , const half_t* __restrict__ Bt  , half_t* K16, half_t* VT16, int tile, int wave, int lane) {
    const int m0 = (tile >> 4) * 64, n0 = (tile & 15) * 64;
    const int rb = wave >> 1, cb = (wave & 1) * 32;
    const int fr = lane & 15, fq = lane >> 4;
    const half_t* ap = A + (size_t)(m0 + 16 * rb + fr) * DM + 8 * fq;
    const half_t* bp0 = Bt + (size_t)(n0 + cb + fr) * DM + 8 * fq;
    const half_t* bp1 = bp0 + (size_t)16 * DM;
    f32x4 acc0 = {0.f, 0.f, 0.f, 0.f}, acc1 = {0.f, 0.f, 0.f, 0.f};
    const bool vpart = n0 >= 512;
#pragma unroll 4
    for (int k0 = 0; k0 < DM; k0 += 32) {
        const f16x8 a = *(const f16x8*)(ap + k0), b0 = *(const f16x8*)(bp0 + k0), b1 = *(const f16x8*)(bp1 + k0);
        if (vpart) { acc0 = __builtin_amdgcn_mfma_f32_16x16x32_f16(a, b0, acc0, 0, 0, 0); acc1 = __builtin_amdgcn_mfma_f32_16x16x32_f16(a, b1, acc1, 0, 0, 0); }
        else       { acc0 = __builtin_amdgcn_mfma_f32_16x16x32_f16(b0, a, acc0, 0, 0, 0); acc1 = __builtin_amdgcn_mfma_f32_16x16x32_f16(b1, a, acc1, 0, 0, 0); }
    }
    if (!vpart) {
        const int m = m0 + 16 * rb + fr;
        u32x2 w0, w1; w0.x = pk_h2(acc0[0], acc0[1]); w0.y = pk_h2(acc0[2], acc0[3]); w1.x = pk_h2(acc1[0], acc1[1]); w1.y = pk_h2(acc1[2], acc1[3]);
        *(u32x2*)(K16 + (size_t)m * 512 + n0 + cb + 4 * fq) = w0;
        *(u32x2*)(K16 + (size_t)m * 512 + n0 + cb + 16 + 4 * fq) = w1;
    } else {
        const int mb = m0 + 16 * rb + 4 * fq, b = mb >> 8, key = mb & 255;
        const int n = n0 - 512 + cb + fr;
        u32x2 w0, w1; w0.x = pk_h2(acc0[0], acc0[1]); w0.y = pk_h2(acc0[2], acc0[3]); w1.x = pk_h2(acc1[0], acc1[1]); w1.y = pk_h2(acc1[2], acc1[3]);
        *(u32x2*)(VT16 + ((size_t)b * 512 + n) * 256 + key) = w0;
        *(u32x2*)(VT16 + ((size_t)b * 512 + n + 16) * 256 + key) = w1;
    }
}

constexpr int ATT_K_OFF = 0, ATT_V_OFF = 65536, ATT_WS_OFF = RING_BYTES + 1024;
__device__ __forceinline__ void attn_unit(LAS unsigned char* lds, const half_t* __restrict__ PROJ16, const half_t* __restrict__ K16, const half_t* __restrict__ VT16, half_t* CAT16,
                                          int b, int h, int qb, int tid, int wave, int lane) {
    asm volatile("" : "+v"(tid), "+v"(lane));
    {
        const half_t* kg = K16 + (size_t)(b * 256) * 512 + h * 128;
        const half_t* vg = VT16 + ((size_t)b * 512 + h * 128) * 256;
        u32x4 kv[8], vv[8];
#pragma unroll
        for (int it = 0; it < 8; ++it) { const int idx = it * 512 + tid, key = idx >> 4, ch = idx & 15; kv[it] = *(const u32x4*)(kg + (size_t)key * 512 + ch * 8); }
#pragma unroll
        for (int it = 0; it < 8; ++it) { const int idx = it * 512 + tid, d = idx >> 5, ch = idx & 31; vv[it] = *(const u32x4*)(vg + (size_t)d * 256 + ch * 8); }
#pragma unroll
        for (int it = 0; it < 8; ++it) { const int idx = it * 512 + tid, key = idx >> 4, ch = idx & 15; *(LAS u32x4*)(lds + ATT_K_OFF + key * 256 + ((ch ^ (key & 15)) << 4)) = kv[it]; }
#pragma unroll
        for (int it = 0; it < 8; ++it) { const int idx = it * 512 + tid, d = idx >> 5, ch = idx & 31; const int m = (d & 31) << 3;
            u32x2 lo, hi2; lo.x = vv[it].x; lo.y = vv[it].y; hi2.x = vv[it].z; hi2.y = vv[it].w;
            *(LAS u32x2*)(lds + ATT_V_OFF + d * 512 + ((ch * 16) ^ m)) = lo;
            *(LAS u32x2*)(lds + ATT_V_OFF + d * 512 + ((ch * 16 + 8) ^ m)) = hi2; }
    }
    __syncthreads();
    const int c31 = lane & 31, hi = lane >> 5;
    const int tok0 = b * SEQ + qb * 256 + wave * 32;
    f16x8 qf[8];
    {
        const half_t* qp = PROJ16 + (size_t)(tok0 + c31) * INC + 1536 + h * 128 + 8 * hi;
#pragma unroll
        for (int s = 0; s < 8; ++s) qf[s] = *(const f16x8*)(qp + 16 * s);
    }
    __builtin_amdgcn_sched_barrier(0);
    f32x16 sb[8];
#pragma unroll
    for (int kb = 0; kb < 8; ++kb) {
        f32x16 a = {0.f, 0.f, 0.f, 0.f, 0.f, 0.f, 0.f, 0.f, 0.f, 0.f, 0.f, 0.f, 0.f, 0.f, 0.f, 0.f};
        const int key = kb * 32 + c31;
#pragma unroll
        for (int s = 0; s < 8; ++s) {
            const f16x8 kf = *(const LAS f16x8*)(lds + ATT_K_OFF + key * 256 + (((2 * s + hi) ^ (key & 15)) << 4));
            a = __builtin_amdgcn_mfma_f32_32x32x16_f16(kf, qf[s], a, 0, 0, 0);
        }
        sb[kb] = a;
    }
    __builtin_amdgcn_sched_barrier(0);
    float mx = -3.0e38f;
#pragma unroll
    for (int kb = 0; kb < 8; ++kb)
#pragma unroll
        for (int r = 0; r < 16; ++r) mx = fmaxf(mx, sb[kb][r]);
    mx = fmaxf(mx, __shfl_xor(mx, 32));
    const float c2 = 0.08838834764831845f * 1.4426950408889634f;
    const float mc = mx * c2;
    float l = 0.f;
    f16x8 pa[16];
#pragma unroll
    for (int kb = 0; kb < 8; ++kb)
#pragma unroll
        for (int s = 0; s < 2; ++s) {
#pragma unroll
            for (int j = 0; j < 8; ++j) { const float p = __builtin_amdgcn_exp2f(sb[kb][8 * s + j] * c2 - mc); l += p; pa[kb * 2 + s][j] = (_Float16)p; }
        }
    l += __shfl_xor(l, 32);
    LAS float* wsf = (LAS float*)(lds + ATT_WS_OFF) + wave * 32;
    if (hi == 0) wsf[c31] = l;
    __builtin_amdgcn_sched_barrier(0);
    f32x16 o[4];
#pragma unroll
    for (int db = 0; db < 4; ++db) o[db] = (f32x16){0.f, 0.f, 0.f, 0.f, 0.f, 0.f, 0.f, 0.f, 0.f, 0.f, 0.f, 0.f, 0.f, 0.f, 0.f, 0.f};
    const unsigned vbase = ATT_V_OFF + c31 * 512; const int m = c31 << 3;
#pragma unroll
    for (int ks = 0; ks < 16; ++ks) {
        const int kbyte = 32 * ks + 8 * hi;
#pragma unroll
        for (int db = 0; db < 4; ++db) {
            const f16x4 v0 = *(const LAS f16x4*)(lds + vbase + db * 16384 + (kbyte ^ m));
            const f16x4 v1 = *(const LAS f16x4*)(lds + vbase + db * 16384 + ((kbyte + 16) ^ m));
            const f16x8 vf = {v0[0], v0[1], v0[2], v0[3], v1[0], v1[1], v1[2], v1[3]};
            o[db] = __builtin_amdgcn_mfma_f32_32x32x16_f16(pa[ks], vf, o[db], 0, 0, 0);
        }
    }
    __builtin_amdgcn_sched_barrier(0);
    LDS_WAIT();
    half_t* op = CAT16 + (size_t)tok0 * 1536 + 1024 + h * 128 + c31;
#pragma unroll
    for (int r = 0; r < 16; ++r) {
        const int q = crow(r, hi);
        const float rl = __builtin_amdgcn_rcpf(wsf[q]);
#pragma unroll
        for (int db = 0; db < 4; ++db) op[(size_t)q * 1536 + db * 32] = (_Float16)(o[db][r] * rl);
    }
    __syncthreads();
}

constexpr int SP_VT_OFF = 0, SP_W_OFF = 32768, SP_RS_OFF = 65536;
__device__ __forceinline__ void spatial_unit(LAS unsigned char* lds, const half_t* __restrict__ PROJ16, const float* __restrict__ w_sp, const float* __restrict__ b_sp, const float* __restrict__ g_sgu,
                                             half_t* CAT16, int bc, int h, int tid, int wave, int lane) {
    asm volatile("" : "+v"(tid), "+v"(lane));
    const int tok0 = bc * CHUNK;
    LAS float* rs = (LAS float*)(lds + SP_RS_OFF);
#pragma unroll 4
    for (int i = 0; i < 16; ++i) {
        const int s = wave * 16 + i;
        const f16x8 v = *(const f16x8*)(PROJ16 + (size_t)(tok0 + s) * INC + 1024 + lane * 8);
        float q = 0.f;
#pragma unroll
        for (int j = 0; j < 8; ++j) { const float f = (float)v[j]; q += f * f; }
        q = wave_sum(q);
        if (lane == 0) rs[s] = 1.0f / sqrtf(q * (1.f / 512.f) + EPS);
    }
#pragma unroll
    for (int it = 0; it < 4; ++it) {
        const int idx = it * 512 + tid, s = idx >> 4, ch = idx & 15;
        const f16x8 v = *(const f16x8*)(PROJ16 + (size_t)(tok0 + s) * INC + 1024 + h * SHD + ch * 8);
#pragma unroll
        for (int j = 0; j < 8; ++j) { const int d = ch * 8 + j;
            *(LAS half_t*)(lds + SP_VT_OFF + d * 256 + ((((s >> 3) ^ (d & 15)) << 4) | ((s & 7) << 1))) = v[j]; }
    }
    __syncthreads();
#pragma unroll
    for (int it = 0; it < 8; ++it) {
        const int idx = it * 512 + tid, t = idx >> 5, s4 = (idx & 31) * 4;
        const f32x4 w = *(const f32x4*)(w_sp + ((size_t)h * CHUNK + t) * CHUNK + s4);
        const f32x4 r4 = *(const LAS f32x4*)(rs + s4);
        const float w0 = (s4 + 0 <= t) ? w[0] * r4[0] : 0.f, w1 = (s4 + 1 <= t) ? w[1] * r4[1] : 0.f, w2 = (s4 + 2 <= t) ? w[2] * r4[2] : 0.f, w3 = (s4 + 3 <= t) ? w[3] * r4[3] : 0.f;
        u32x2 o; o.x = pk_h2(w0, w1); o.y = pk_h2(w2, w3);
        *(LAS u32x2*)(lds + SP_W_OFF + t * 256 + ((((s4 >> 3) ^ (t & 15)) << 4) | ((s4 & 7) << 1))) = o;
    }
    __syncthreads();
    const int c31 = lane & 31, hi = lane >> 5, tb = wave >> 1, dh = wave & 1;
    f32x16 acc[2];
    acc[0] = (f32x16){0.f, 0.f, 0.f, 0.f, 0.f, 0.f, 0.f, 0.f, 0.f, 0.f, 0.f, 0.f, 0.f, 0.f, 0.f, 0.f}; acc[1] = acc[0];
    const int t = tb * 32 + c31;
    const int nks = 2 * (tb + 1);
    for (int ks = 0; ks < nks; ++ks) {
        const f16x8 wf = *(const LAS f16x8*)(lds + SP_W_OFF + t * 256 + (((2 * ks + hi) ^ (t & 15)) << 4));
#pragma unroll
        for (int q = 0; q < 2; ++q) {
            const int d = (2 * dh + q) * 32 + c31;
            const f16x8 vf = *(const LAS f16x8*)(lds + SP_VT_OFF + d * 256 + (((2 * ks + hi) ^ (d & 15)) << 4));
            acc[q] = __builtin_amdgcn_mfma_f32_32x32x16_f16(vf, wf, acc[q], 0, 0, 0);
        }
    }
    const float bias = b_sp[h * CHUNK + t];
    const half_t* up = PROJ16 + (size_t)(tok0 + t) * INC + 512 + h * SHD;
    half_t* op = CAT16 + (size_t)(tok0 + t) * 1536 + 512 + h * SHD;
#pragma unroll
    for (int q = 0; q < 2; ++q)
#pragma unroll
        for (int rg = 0; rg < 4; ++rg) {
            const int d = (2 * dh + q) * 32 + 8 * rg + 4 * hi;
            const f16x4 u = *(const f16x4*)(up + d);
            const f32x4 g = *(const f32x4*)(g_sgu + h * SHD + d);
            u32x2 o;
            o.x = pk_h2((float)u[0] * (g[0] * acc[q][4 * rg + 0] + bias), (float)u[1] * (g[1] * acc[q][4 * rg + 1] + bias));
            o.y = pk_h2((float)u[2] * (g[2] * acc[q][4 * rg + 2] + bias), (float)u[3] * (g[3] * acc[q][4 * rg + 3] + bias));
            *(u32x2*)(op + d) = o;
        }
    __syncthreads();
}

constexpr int SL = 32, NCH = T / SL;
struct SsmTabs { half_t* ktab; half_t* et; half_t* ft; float* xend; half_t* xin; };

__device__ __forceinline__ void ssm_tables_item(LAS unsigned char* lds, const float* lam_re, const float* lam_im, const float* log_dt, const float* b_re, const float* b_im,
                                                const float* c_re, const float* c_im, const float* d_skip, const SsmTabs& tb, int g, int tid) {
    LAS f32x2* pw = (LAS f32x2*)lds; LAS f32x2* bb = pw + 33 * 64; LAS f32x2* cc = bb + 64 * 16;
    const float dt = expf(log_dt[g]); const float idt = 1.0f / dt;
    {
        const int p = tid & 63, part = tid >> 6;
        const float are = lam_re[g * NP + p], aim = lam_im[g * NP + p];
#pragma unroll 1
        for (int k = part; k <= 32; k += 8) {
            const double ang = (double)aim * (double)dt * (double)k;
            const float e = expf(are * dt * (float)k);
            pw[k * 64 + p] = (f32x2){e * (float)cos(ang), e * (float)sin(ang)};
        }
        const double ang1 = (double)aim * (double)dt;
        const float e1 = expf(are * dt); const float lr = e1 * (float)cos(ang1), li = e1 * (float)sin(ang1);
        const float nr = lr - 1.f, ni = li, den = are * are + aim * aim;
        const float fr = (nr * are + ni * aim) / den * idt, fi = (ni * are - nr * aim) / den * idt;
#pragma unroll
        for (int q = 0; q < 2; ++q) { const int h = part * 2 + q; const float br = b_re[(g * NP + p) * SG + h], bi = b_im[(g * NP + p) * SG + h];
            bb[p * 16 + h] = (f32x2){fr * br - fi * bi, fr * bi + fi * br}; }
#pragma unroll
        for (int q = 0; q < 2; ++q) { const int i = tid * 2 + q; cc[i] = (f32x2){c_re[g * 1024 + i], c_im[g * 1024 + i]}; }
    }
    __syncthreads();
    half_t* kt = tb.ktab + (size_t)g * 33 * 256;
    if (tid < 256) kt[tid] = (_Float16)0.f;
#pragma unroll 1
    for (int j = 0; j < 16; ++j) {
        const int idx = j * 512 + tid, lag = idx >> 8, h = (idx >> 4) & 15, h2 = idx & 15;
        float acc = 0.f;
#pragma unroll 4
        for (int p = 0; p < 64; ++p) {
            const f32x2 c = cc[h * 64 + p], w = pw[lag * 64 + p], b = bb[p * 16 + h2];
            const float zr = c.x * w.x - c.y * w.y, zi = c.x * w.y + c.y * w.x;
            acc += zr * b.x - zi * b.y;
        }
        if (lag == 0 && h == h2) acc += d_skip[g * SG + h] * idt;
        kt[(lag + 1) * 256 + h * 16 + h2] = (_Float16)acc;
    }
    half_t* et = tb.et + (size_t)g * 128 * 512;
#pragma unroll 2
    for (int j = 0; j < 32; ++j) {
        const int idx = j * 512 + tid, hp = idx & 7, s = (idx >> 3) & 31, p = idx >> 8;
        const f32x2 w = pw[(31 - s) * 64 + p], b0 = bb[p * 16 + hp * 2], b1 = bb[p * 16 + hp * 2 + 1];
        *(unsigned*)(et + (size_t)p * 512 + s * 16 + hp * 2) = pk_h2(w.x * b0.x - w.y * b0.y, w.x * b1.x - w.y * b1.y);
        *(unsigned*)(et + (size_t)(64 + p) * 512 + s * 16 + hp * 2) = pk_h2(w.x * b0.y + w.y * b0.x, w.x * b1.y + w.y * b1.x);
    }
    half_t* ft = tb.ft + (size_t)g * 512 * 128;
#pragma unroll 2
    for (int j = 0; j < 32; ++j) {
        const int idx = j * 512 + tid, pp = idx & 31, h = (idx >> 5) & 15, t = idx >> 9;
        const f32x2 c0 = cc[h * 64 + pp * 2], c1 = cc[h * 64 + pp * 2 + 1], w0 = pw[(t + 1) * 64 + pp * 2], w1 = pw[(t + 1) * 64 + pp * 2 + 1];
        *(unsigned*)(ft + (size_t)(t * 16 + h) * 128 + pp * 2) = pk_h2(c0.x * w0.x - c0.y * w0.y, c1.x * w1.x - c1.y * w1.y);
        *(unsigned*)(ft + (size_t)(t * 16 + h) * 128 + 64 + pp * 2) = pk_h2(-(c0.x * w0.y + c0.y * w0.x), -(c1.x * w1.y + c1.y * w1.x));
    }
    __syncthreads();
}

__device__ __forceinline__ void ssm_pass1_item(const half_t* __restrict__ PROJ16, const SsmTabs& tb, int g, int q, int cbk, int lane) {
    asm volatile("" : "+v"(lane));
    const int c31 = lane & 31, hi = lane >> 5;
    const half_t* ap = tb.et + ((size_t)g * 128 + cbk * 32 + c31) * 512 + 8 * hi;
    const half_t* bp = PROJ16 + (size_t)((q * 32 + c31) * SL) * INC + g * SG + 8 * hi;
    f32x16 acc = {0.f, 0.f, 0.f, 0.f, 0.f, 0.f, 0.f, 0.f, 0.f, 0.f, 0.f, 0.f, 0.f, 0.f, 0.f, 0.f};
#pragma unroll 8
    for (int ks = 0; ks < 32; ++ks) {
        const f16x8 a = *(const f16x8*)(ap + 16 * ks);
        const f16x8 b = *(const f16x8*)(bp + (size_t)ks * INC);
        acc = __builtin_amdgcn_mfma_f32_32x32x16_f16(a, b, acc, 0, 0, 0);
    }
    float* xp = tb.xend + ((size_t)g * NCH + q * 32 + c31) * 128 + cbk * 32 + 4 * hi;
#pragma unroll
    for (int rg = 0; rg < 4; ++rg) *(f32x4*)(xp + 8 * rg) = (f32x4){acc[4 * rg], acc[4 * rg + 1], acc[4 * rg + 2], acc[4 * rg + 3]};
}

__device__ __forceinline__ void ssm_scan_thread(const float* lam_re, const float* lam_im, const float* log_dt, const SsmTabs& tb, int seq) {
    const int p = seq & 63, g = (seq >> 6) & 31, b = seq >> 11;
    const float are = lam_re[g * NP + p], aim = lam_im[g * NP + p];
    const float dt = expf(log_dt[g]);
    const double ang = (double)aim * (double)dt * 32.0;
    const float e = expf(are * dt * 32.f);
    const float Lr = e * (float)cos(ang), Li = e * (float)sin(ang);
    const float* xe = tb.xend + ((size_t)g * NCH + b * 128) * 128 + p;
    half_t* xi = tb.xin + ((size_t)g * NCH + b * 128) * 128 + p;
    float cr = 0.f, ci = 0.f;
    for (int c0 = 0; c0 < 128; c0 += 8) {
        float er[8], ei[8];
#pragma unroll
        for (int j = 0; j < 8; ++j) { er[j] = xe[(size_t)(c0 + j) * 128]; ei[j] = xe[(size_t)(c0 + j) * 128 + 64]; }
#pragma unroll
        for (int j = 0; j < 8; ++j) {
            xi[(size_t)(c0 + j) * 128] = (_Float16)cr; xi[(size_t)(c0 + j) * 128 + 64] = (_Float16)ci;
            const float nr = Lr * cr - Li * ci + er[j], ni = Lr * ci + Li * cr + ei[j];
            cr = nr; ci = ni;
        }
    }
}

__device__ __forceinline__ void ssm_pass2_item(const half_t* __restrict__ PROJ16, const SsmTabs& tb, const float* log_dt, half_t* YSG16, int g, int q, int qq, int lane) {
    asm volatile("" : "+v"(lane));
    const int c31 = lane & 31, hi = lane >> 5;
    const int cbs[4] = {qq, 7 - qq, 8 + qq, 15 - qq};
    const int tl = c31 >> 4, h = c31 & 15;
    const half_t* kt = tb.ktab + (size_t)g * 33 * 256 + h * 16 + 8 * hi;
    const half_t* bp = PROJ16 + (size_t)((q * 32 + c31) * SL) * INC + g * SG + 8 * hi;
    f32x16 acc[4];
#pragma unroll
    for (int j = 0; j < 4; ++j) acc[j] = (f32x16){0.f, 0.f, 0.f, 0.f, 0.f, 0.f, 0.f, 0.f, 0.f, 0.f, 0.f, 0.f, 0.f, 0.f, 0.f, 0.f};
#pragma unroll 2
    for (int ks = 0; ks < 32; ++ks) {
        const f16x8 b = *(const f16x8*)(bp + (size_t)ks * INC);
#pragma unroll
        for (int j = 0; j < 4; ++j) {
            if (2 * cbs[j] + 1 >= ks) {
                const int lag = 2 * cbs[j] + tl - ks;
                const f16x8 a = *(const f16x8*)(kt + (lag + 1) * 256);
                acc[j] = __builtin_amdgcn_mfma_f32_32x32x16_f16(a, b, acc[j], 0, 0, 0);
            }
        }
    }
    const half_t* xp = tb.xin + ((size_t)g * NCH + q * 32 + c31) * 128 + 8 * hi;
#pragma unroll 2
    for (int kk = 0; kk < 8; ++kk) {
        const f16x8 b = *(const f16x8*)(xp + 16 * kk);
#pragma unroll
        for (int j = 0; j < 4; ++j) {
            const f16x8 a = *(const f16x8*)(tb.ft + ((size_t)g * 512 + cbs[j] * 32 + c31) * 128 + 16 * kk + 8 * hi);
            acc[j] = __builtin_amdgcn_mfma_f32_32x32x16_f16(a, b, acc[j], 0, 0, 0);
        }
    }
    const float dt = expf(log_dt[g]);
    half_t* yp = YSG16 + (size_t)((q * 32 + c31) * SL) * SSMW + g * SG;
#pragma unroll
    for (int j = 0; j < 4; ++j)
#pragma unroll
        for (int rg = 0; rg < 4; ++rg) {
            const int t = 2 * cbs[j] + (rg >> 1), hh = 8 * (rg & 1) + 4 * hi;
            u32x2 o; o.x = pk_h2(fast_gelu(dt * acc[j][4 * rg]), fast_gelu(dt * acc[j][4 * rg + 1])); o.y = pk_h2(fast_gelu(dt * acc[j][4 * rg + 2]), fast_gelu(dt * acc[j][4 * rg + 3]));
            *(u32x2*)(yp + (size_t)t * SSMW + hh) = o;
        }
}

__device__ __forceinline__ float gelu_f(float x) {
    const float k0 = 0.7978845608028654f, k1 = 0.044715f;
    float u = k0 * (x + k1 * x * x * x);
    return 0.5f * x * (1.f + tanhf(u));
}
__device__ __forceinline__ float sigmoid_f(float x) { return 1.f / (1.f + expf(-x)); }

struct GemmP {
    const float* A; int lda; const int* gather;
    const float* B; int ldb; long strideB;
    const int* rowStart; const int* rowCount;
    int M, N, K;
    int mode; float* C; int ldc; const float* bias; const float* aux; int ldaux; int accum;
};

__device__ __forceinline__ void epi_apply(const GemmP& p, int row, int col, float v) {
    float* c = p.C + (size_t)row * p.ldc + col;
    switch (p.mode) {
        case 0: *c = v + (p.bias ? p.bias[col] : 0.f); break;
        case 1: *c = (col >= 512 && col < 1536) ? gelu_f(v) : v; break;
        case 2: { float g = sigmoid_f(v + p.bias[col]); float b = p.aux[(size_t)row * p.ldaux + col]; float prev = p.accum ? *c : 0.f; *c = prev + g * b; } break;
        case 3: *c = p.aux[(size_t)row * p.ldaux + col] + v; break;
        case 4: { float a = *c; *c = (a * sigmoid_f(a)) * v; } break;
        default: break;
    }
}

__global__ void __launch_bounds__(256) sgemm_kernel(GemmP p) {
    __shared__ float As[16][68];
    __shared__ float Bs[16][68];
    const int tid = threadIdx.x, tx = tid & 15, ty = tid >> 4;
    int r0 = 0, M = p.M; const float* B = p.B;
    if (p.rowStart) { const int z = blockIdx.z; r0 = p.rowStart[z]; M = p.rowCount[z]; B += (size_t)z * p.strideB; }
    const int n0 = blockIdx.x * 64;
    for (int rt = blockIdx.y; rt * 64 < M; rt += gridDim.y) {
        const int m0 = rt * 64;
        float acc[4][4];
#pragma unroll
        for (int i = 0; i < 4; ++i)
#pragma unroll
            for (int j = 0; j < 4; ++j) acc[i][j] = 0.f;
        const int ar = tid >> 2, ak = (tid & 3) * 4;
        const int arow = m0 + ar;
        const bool avalid = arow < M;
        long asrc = 0;
        if (avalid) asrc = (long)(p.gather ? p.gather[r0 + arow] : (r0 + arow)) * p.lda;
        const int bk = tid >> 4, bn = (tid & 15) * 4;
        for (int k0 = 0; k0 < p.K; k0 += 16) {
            float4 av = make_float4(0.f, 0.f, 0.f, 0.f);
            if (avalid) av = *(const float4*)(p.A + asrc + k0 + ak);
            float4 bv = *(const float4*)(B + (size_t)(k0 + bk) * p.ldb + n0 + bn);
            __syncthreads();
            As[ak + 0][ar] = av.x; As[ak + 1][ar] = av.y; As[ak + 2][ar] = av.z; As[ak + 3][ar] = av.w;
            *(float4*)&Bs[bk][bn] = bv;
            __syncthreads();
#pragma unroll
            for (int k = 0; k < 16; ++k) {
                float4 a = *(const float4*)&As[k][ty * 4];
                float4 b = *(const float4*)&Bs[k][tx * 4];
                float aa[4] = {a.x, a.y, a.z, a.w}, bb[4] = {b.x, b.y, b.z, b.w};
#pragma unroll
                for (int i = 0; i < 4; ++i)
#pragma unroll
                    for (int j = 0; j < 4; ++j) acc[i][j] = fmaf(aa[i], bb[j], acc[i][j]);
            }
        }
#pragma unroll
        for (int i = 0; i < 4; ++i) {
            const int row = m0 + ty * 4 + i;
            if (row < M) {
#pragma unroll
                for (int j = 0; j < 4; ++j) epi_apply(p, r0 + row, n0 + tx * 4 + j, acc[i][j]);
            }
        }
        __syncthreads();
    }
}

template <int PER>
__global__ void __launch_bounds__(256) rmsnorm_kernel(const float* in, int ldin, const float* g, float* out, int ldout) {
    __shared__ float red[4];
    constexpr int D = PER * 256;
    const int row = blockIdx.x, tid = threadIdx.x;
    const float* x = in + (size_t)row * ldin;
    float v[PER]; float s = 0.f;
#pragma unroll
    for (int j = 0; j < PER; ++j) { v[j] = x[tid + 256 * j]; s += v[j] * v[j]; }
    for (int o = 32; o > 0; o >>= 1) s += __shfl_xor(s, o);
    if ((tid & 63) == 0) red[tid >> 6] = s;
    __syncthreads();
    const float tot = red[0] + red[1] + red[2] + red[3];
    const float rs = rsqrtf(tot / (float)D + EPS);
#pragma unroll
    for (int j = 0; j < PER; ++j) out[(size_t)row * ldout + tid + 256 * j] = v[j] * rs * g[tid + 256 * j];
}

struct SsmP {
    const float* proj;
    const float *lam_re, *lam_im, *log_dt, *b_re, *b_im, *c_re, *c_im, *d_skip;
    float* xend;
    float* xin;
    float* ys;
};

__device__ __forceinline__ void ssm_coeffs(const SsmP& p, int g, int pp, float& lr, float& li, float (&bbr)[16], float (&bbi)[16]) {
    const float are = p.lam_re[g * NP + pp], aim = p.lam_im[g * NP + pp];
    const float dt = expf(p.log_dt[g]);
    const float e = expf(are * dt);
    lr = e * cosf(aim * dt); li = e * sinf(aim * dt);
    const float nr = lr - 1.f, ni = li;
    const float den = are * are + aim * aim;
    const float fr = (nr * are + ni * aim) / den, fi = (ni * are - nr * aim) / den;
#pragma unroll
    for (int h = 0; h < 16; ++h) {
        const float br = p.b_re[(g * NP + pp) * SG + h], bi = p.b_im[(g * NP + pp) * SG + h];
        bbr[h] = fr * br - fi * bi; bbi[h] = fr * bi + fi * br;
    }
}

__global__ void __launch_bounds__(64) ssm_pass1(SsmP p) {
    const int pp = threadIdx.x;
    const int g = blockIdx.x % NG, c = (blockIdx.x / NG) % NSC, b = blockIdx.x / (NG * NSC);
    float lr, li, bbr[16], bbi[16];
    ssm_coeffs(p, g, pp, lr, li, bbr, bbi);
    float xr = 0.f, xi = 0.f;
    const float* u = p.proj + (size_t)(b * SEQ + c * SCH) * INC + g * SG;
    for (int t = 0; t < SCH; ++t) {
        float ur = 0.f, ui = 0.f;
#pragma unroll
        for (int h = 0; h < 16; ++h) { const float uv = u[(size_t)t * INC + h]; ur = fmaf(bbr[h], uv, ur); ui = fmaf(bbi[h], uv, ui); }
        const float nr = lr * xr - li * xi + ur, ni = lr * xi + li * xr + ui;
        xr = nr; xi = ni;
    }
    float* o = p.xend + ((size_t)((b * NSC + c) * NG + g) * NP + pp) * 2;
    o[0] = xr; o[1] = xi;
}

__global__ void __launch_bounds__(64) ssm_carry(SsmP p) {
    const int pp = threadIdx.x, g = blockIdx.x % NG, b = blockIdx.x / NG;
    const float are = p.lam_re[g * NP + pp], aim = p.lam_im[g * NP + pp];
    const float dt = expf(p.log_dt[g]);
    const float e = expf(are * dt * (float)SCH);
    const float ang = aim * dt;
    const double angL = (double)ang * (double)SCH;
    const float Lr = e * (float)cos(angL), Li = e * (float)sin(angL);
    float cr = 0.f, ci = 0.f;
    for (int c = 0; c < NSC; ++c) {
        const size_t idx = ((size_t)((b * NSC + c) * NG + g) * NP + pp) * 2;
        p.xin[idx] = cr; p.xin[idx + 1] = ci;
        const float er = p.xend[idx], ei = p.xend[idx + 1];
        const float nr = Lr * cr - Li * ci + er, ni = Lr * ci + Li * cr + ei;
        cr = nr; ci = ni;
    }
}

__global__ void __launch_bounds__(64) ssm_pass2(SsmP p) {
    __shared__ float sre[64], sim[64];
    const int pp = threadIdx.x;
    const int g = blockIdx.x % NG, c = (blockIdx.x / NG) % NSC, b = blockIdx.x / (NG * NSC);
    float lr, li, bbr[16], bbi[16];
    ssm_coeffs(p, g, pp, lr, li, bbr, bbi);
    const size_t idx = ((size_t)((b * NSC + c) * NG + g) * NP + pp) * 2;
    float xr = p.xin[idx], xi = p.xin[idx + 1];
    const int h = pp & 15, q = pp >> 4;
    float cre[16], cim[16];
#pragma unroll
    for (int j = 0; j < 16; ++j) { cre[j] = p.c_re[(g * SG + h) * NP + q * 16 + j]; cim[j] = p.c_im[(g * SG + h) * NP + q * 16 + j]; }
    const float dsk = p.d_skip[g * SG + h];
    const float* u = p.proj + (size_t)(b * SEQ + c * SCH) * INC + g * SG;
    for (int t = 0; t < SCH; ++t) {
        float ur = 0.f, ui = 0.f;
#pragma unroll
        for (int hh = 0; hh < 16; ++hh) { const float uv = u[(size_t)t * INC + hh]; ur = fmaf(bbr[hh], uv, ur); ui = fmaf(bbi[hh], uv, ui); }
        const float nr = lr * xr - li * xi + ur, ni = lr * xi + li * xr + ui;
        xr = nr; xi = ni;
        sre[pp] = xr; sim[pp] = xi;
        __syncthreads();
        float s = 0.f;
#pragma unroll
        for (int j = 0; j < 16; ++j) s += sre[q * 16 + j] * cre[j] - sim[q * 16 + j] * cim[j];
        s += __shfl_xor(s, 16); s += __shfl_xor(s, 32);
        if (q == 0) {
            const float y = s + dsk * u[(size_t)t * INC + h];
            p.ys[(size_t)(b * SEQ + c * SCH + t) * SSMW + g * SG + h] = gelu_f(y);
        }
        __syncthreads();
    }
}

__global__ void glu_kernel(const float* glu, float* cat) {
    const size_t i = (size_t)blockIdx.x * 256 + threadIdx.x;
    const size_t row = i / 512; const int col = (int)(i % 512);
    const float a = glu[row * 1024 + col], b = glu[row * 1024 + 512 + col];
    cat[row * 1536 + col] = a * sigmoid_f(b);
}

__global__ void __launch_bounds__(128) spatial_kernel(const float* proj, const float* vn, const float* w_sp, const float* b_sp, float* cat) {
    const int d = threadIdx.x;
    const int t = blockIdx.x % CHUNK, h = (blockIdx.x / CHUNK) % SH, bc = blockIdx.x / (CHUNK * SH);
    const size_t row0 = (size_t)bc * CHUNK;
    const float* w = w_sp + ((size_t)h * CHUNK + t) * CHUNK;
    float s = 0.f;
    for (int ss = 0; ss <= t; ++ss) s = fmaf(w[ss], vn[(row0 + ss) * SGUW + h * SHD + d], s);
    s += b_sp[h * CHUNK + t];
    const float u = proj[(row0 + t) * INC + 512 + h * SHD + d];
    cat[(row0 + t) * 1536 + 512 + h * SHD + d] = u * s;
}

__global__ void __launch_bounds__(256) attn_kernel(const float* proj, const float* kv, float* cat) {
    __shared__ float sq[128]; __shared__ float sp[256]; __shared__ float red[4];
    const int tid = threadIdx.x; const int h = blockIdx.x % XH; const int tok = blockIdx.x / XH; const int b = tok / SEQ;
    if (tid < 128) sq[tid] = proj[(size_t)tok * INC + 1536 + h * XD + tid];
    __syncthreads();
    const float* kr = kv + (size_t)(b * MEML + tid) * 1024 + h * XD;
    float s = 0.f;
    for (int d = 0; d < 128; ++d) s = fmaf(sq[d], kr[d], s);
    s *= 0.08838834764831845f;
    float m = s;
    for (int o = 32; o > 0; o >>= 1) m = fmaxf(m, __shfl_xor(m, o));
    if ((tid & 63) == 0) red[tid >> 6] = m;
    __syncthreads();
    m = fmaxf(fmaxf(red[0], red[1]), fmaxf(red[2], red[3]));
    __syncthreads();
    const float e = expf(s - m);
    sp[tid] = e;
    float l = e;
    for (int o = 32; o > 0; o >>= 1) l += __shfl_xor(l, o);
    if ((tid & 63) == 0) red[tid >> 6] = l;
    __syncthreads();
    l = red[0] + red[1] + red[2] + red[3];
    if (tid < 128) {
        float o = 0.f;
        const float* vr = kv + (size_t)(b * MEML) * 1024 + 512 + h * XD + tid;
        for (int mm = 0; mm < 256; ++mm) o = fmaf(sp[mm], vr[(size_t)mm * 1024], o);
        cat[(size_t)tok * 1536 + 1024 + h * XD + tid] = o / l;
    }
}

struct RouteP {
    const float* h; const float* g_ffn; const float *w_group, *b_group, *w_router, *b_router;
    float* xf; int* eid; float* ew; int* counts;
};
__global__ void __launch_bounds__(128) route_kernel(RouteP p) {
    __shared__ float sx[1024]; __shared__ float red[2]; __shared__ float lg[72];
    const int tok = blockIdx.x, tid = threadIdx.x;
    const float* hr = p.h + (size_t)tok * DM;
    float s = 0.f;
    for (int j = tid; j < DM; j += 128) { const float v = hr[j]; sx[j] = v; s += v * v; }
    for (int o = 32; o > 0; o >>= 1) s += __shfl_xor(s, o);
    if ((tid & 63) == 0) red[tid >> 6] = s;
    __syncthreads();
    const float rs = rsqrtf((red[0] + red[1]) / (float)DM + EPS);
    __syncthreads();
    for (int j = tid; j < DM; j += 128) { const float v = sx[j] * rs * p.g_ffn[j]; sx[j] = v; p.xf[(size_t)tok * DM + j] = v; }
    __syncthreads();
    if (tid < 72) {
        float a = 0.f;
        if (tid < 64) { for (int i = 0; i < DM; ++i) a = fmaf(sx[i], p.w_router[i * NE + tid], a); a += p.b_router[tid]; lg[8 + tid] = a; }
        else { const int g = tid - 64; for (int i = 0; i < DM; ++i) a = fmaf(sx[i], p.w_group[i * NGRP + g], a); a += p.b_group[g]; lg[g] = a; }
    }
    __syncthreads();
    if (tid == 0) {
        int gi = 0; float gm = lg[0];
        for (int g = 1; g < 8; ++g) if (lg[g] > gm) { gm = lg[g]; gi = g; }
        float den = 0.f; for (int g = 0; g < 8; ++g) den += expf(lg[g] - gm);
        const float gw = 1.f / den;
        const float* el = lg + 8 + gi * 8;
        int i0 = 0; float v0 = el[0];
        for (int e = 1; e < 8; ++e) if (el[e] > v0) { v0 = el[e]; i0 = e; }
        int i1 = -1; float v1 = -3.0e38f;
        for (int e = 0; e < 8; ++e) if (e != i0 && el[e] > v1) { v1 = el[e]; i1 = e; }
        const float w0 = 1.f / (1.f + expf(v1 - v0)), w1 = 1.f - w0;
        const int e0 = gi * 8 + i0, e1 = gi * 8 + i1;
        p.eid[tok * 2] = e0; p.eid[tok * 2 + 1] = e1;
        p.ew[tok * 2] = gw * w0; p.ew[tok * 2 + 1] = gw * w1;
        atomicAdd(&p.counts[e0], 1); atomicAdd(&p.counts[e1], 1);
    }
}
__global__ void offsets_kernel(const int* counts, int* rowStart, int* cursor) {
    if (threadIdx.x == 0) { int a = 0; for (int e = 0; e < NE; ++e) { rowStart[e] = a; a += counts[e]; cursor[e] = 0; } }
}
__global__ void scatter_kernel(const int* eid, const int* rowStart, int* cursor, int* srcTok, int* posOf) {
    const int i = blockIdx.x * 256 + threadIdx.x;
    if (i >= T * 2) return;
    const int e = eid[i];
    const int pos = rowStart[e] + atomicAdd(&cursor[e], 1);
    srcTok[pos] = i >> 1; posOf[i] = pos;
}
__global__ void __launch_bounds__(256) final_kernel(const float* h, const float* Y, const int* posOf, const float* ew, const float* g, float* out) {
    __shared__ float red[4];
    const int tok = blockIdx.x, tid = threadIdx.x;
    const int p0 = posOf[tok * 2], p1 = posOf[tok * 2 + 1];
    const float w0 = ew[tok * 2], w1 = ew[tok * 2 + 1];
    float v[4]; float s = 0.f;
#pragma unroll
    for (int j = 0; j < 4; ++j) {
        const int c = tid + 256 * j;
        v[j] = h[(size_t)tok * DM + c] + (w0 * Y[(size_t)p0 * DM + c] + w1 * Y[(size_t)p1 * DM + c]);
        s += v[j] * v[j];
    }
    for (int o = 32; o > 0; o >>= 1) s += __shfl_xor(s, o);
    if ((tid & 63) == 0) red[tid >> 6] = s;
    __syncthreads();
    const float rs = rsqrtf((red[0] + red[1] + red[2] + red[3]) / (float)DM + EPS);
#pragma unroll
    for (int j = 0; j < 4; ++j) { const int c = tid + 256 * j; out[(size_t)tok * DM + c] = v[j] * rs * g[c]; }
}


constexpr size_t MiB = 1u << 20;
constexpr int CW_BAR = 4096;
constexpr size_t WS_CTL = 0, CTL_ZERO_BYTES = 1 * MiB;
constexpr size_t WS_WINT = 436 * MiB, WS_N16 = 440 * MiB, WS_PROJ16 = 193 * MiB;
constexpr size_t WS_G16 = 65 * MiB, WS_MERGED16 = 161 * MiB, WS_H32 = 1 * MiB, WS_WGATET = 499 * MiB, WS_WGLUT = 505 * MiB, WS_WBRT = 506 * MiB, WS_WOUTT = 509 * MiB;
constexpr size_t WS_YSG16 = 401 * MiB, WS_KTAB = 478 * MiB, WS_ET = 479 * MiB, WS_FT = 483 * MiB, WS_XEND = 487 * MiB, WS_XIN = 495 * MiB;
constexpr size_t WS_WKVT = 472 * MiB, WS_MEMN16 = 474 * MiB, WS_K16 = 476 * MiB, WS_VT16 = 477 * MiB, WS_CAT16 = 353 * MiB;

struct Args { const float* in[32]; float* out; unsigned char* ws; int ph_lo, ph_hi, li, pad; };

struct Frame {
    LAS unsigned char* lds; volatile LAS unsigned* MISC; unsigned* ctl;
    int tid, lane, wave, vcu, G;
};

__device__ __forceinline__ SsmTabs make_tabs(unsigned char* ws) { SsmTabs t; t.ktab = (half_t*)(ws + WS_KTAB); t.et = (half_t*)(ws + WS_ET); t.ft = (half_t*)(ws + WS_FT); t.xend = (float*)(ws + WS_XEND); t.xin = (half_t*)(ws + WS_XIN); return t; }
__device__ __forceinline__ void p0_prologue(const Frame& F, const Args& a) {
    { const SsmTabs tb = make_tabs(a.ws);
      for (int g = F.vcu; g < NG; g += F.G) ssm_tables_item(F.lds, a.in[7], a.in[8], a.in[9], a.in[10], a.in[11], a.in[12], a.in[13], a.in[14], tb, g, F.tid); }
    LAS float* scr = (LAS float*)(F.lds + RING_OFF + F.wave * 16384);
    const int gw = F.vcu * NWAVES + F.wave, NGW = F.G * NWAVES;
    half_t* N16 = (half_t*)(a.ws + WS_N16);
#pragma unroll 1
    for (int j = 0; j < 8; ++j) {
        const float* W; int ldw, K, N, mode = 0; half_t* WT;
        switch (j) {
            case 0: W = a.in[4];  ldw = INC;  K = DM;  N = INC;  WT = (half_t*)(a.ws + WS_WINT); break;
            case 1: W = a.in[20]; ldw = 1024; K = DM;  N = 1024; WT = (half_t*)(a.ws + WS_WKVT); break;
            case 2: W = a.in[5];  ldw = 3072; K = DM;  N = 3072; WT = (half_t*)(a.ws + WS_WGATET); break;
            case 3: W = a.in[15]; ldw = 1024; K = 512; N = 1024; WT = (half_t*)(a.ws + WS_WGLUT); mode = 1; break;
            case 4: W = a.in[21];                     ldw = 1024; K = 512; N = 1024; WT = (half_t*)(a.ws + WS_WBRT); break;
            case 5: W = a.in[21] + 512 * 1024;        ldw = 1024; K = 512; N = 1024; WT = (half_t*)(a.ws + WS_WBRT) + 1024 * 512; break;
            case 6: W = a.in[21] + 2 * 512 * 1024;    ldw = 1024; K = 512; N = 1024; WT = (half_t*)(a.ws + WS_WBRT) + 2 * 1024 * 512; break;
            default: W = a.in[22]; ldw = 1024; K = DM; N = 1024; WT = (half_t*)(a.ws + WS_WOUTT); break;
        }
        const int nblk = N / 32, items = (K / 64) * nblk;
#pragma unroll 1
        for (int it = gw; it < items; it += NGW) {
            const int kb = it / nblk, nb = it % nblk, n0 = nb * 32;
            int drow = n0;
            if (mode == 1) { const int half = n0 >> 9, jj = n0 & 511; drow = (jj >> 7) * 256 + half * 128 + (jj & 127); }
            transpose_item(W, ldw, kb * 64, n0, WT, K, drow, scr, F.lane);
        }
    }
    half_t* MEMN16 = (half_t*)(a.ws + WS_MEMN16);
    for (int m = gw; m < MROWS; m += NGW) rms_row_to_f16(a.in[1] + (size_t)m * DM, a.in[3], MEMN16 + (size_t)m * DM, F.lane);
    for (int m = gw; m < T; m += NGW) rms_row_to_f16(a.in[0] + (size_t)m * DM, a.in[2], N16 + (size_t)m * DM, F.lane);
}

__global__ void __launch_bounds__(NWAVES * 64, 2) mk_fwd(Args args) {
    extern __shared__ __attribute__((aligned(16))) unsigned char lds[];
    Frame F;
    F.lds = (LAS unsigned char*)lds;
    F.MISC = (volatile LAS unsigned*)(F.lds + MISC_OFF);
    F.tid = threadIdx.x; F.lane = F.tid & 63; F.wave = __builtin_amdgcn_readfirstlane(F.tid >> 6);
    F.G = gridDim.x; { const int bx = blockIdx.x; F.vcu = (F.G % 8 == 0) ? (bx % 8) * (F.G / 8) + bx / 8 : bx; }
    F.ctl = (unsigned*)(args.ws + WS_CTL);
    for (int u = F.tid; u < (LDS_BYTES - LDSCTL_OFF) / 4; u += NWAVES * 64) ((LAS unsigned*)(F.lds + LDSCTL_OFF))[u] = 0u;
    __syncthreads();
    XcdBarrier bar = xcd_barrier_post(F.ctl + CW_BAR + args.li * XCD_BAR_WORDS, F.MISC + 8);
    const int lo = args.ph_lo, hi = args.ph_hi;
#define IN(k) (lo <= (k) && (k) < hi)
#define BOTH(k) (IN(k) && IN((k) + 1))
    if (IN(0)) { p0_prologue(F, args); if (BOTH(0)) xcd_barrier(bar); }
    if (IN(1)) {
        pg::OrderMN S; S.init(T, INC, F.G, (int)blockIdx.x, args.ws + WS_N16, DM, args.ws + WS_WINT, DM);
        pg::EpiProj E{(half_t*)(args.ws + WS_PROJ16), INC};
        pg::gemm_phase<pg::EpiProj, pg::OrderMN, true, true>(F.lds + RING_OFF, DM, DM, DM / 64, S, E);
        for (int t = F.vcu; t < 256; t += F.G) kv_tile((const half_t*)(args.ws + WS_MEMN16), (const half_t*)(args.ws + WS_WKVT), (half_t*)(args.ws + WS_K16), (half_t*)(args.ws + WS_VT16), t, F.wave, F.lane);
        if (BOTH(1)) xcd_barrier(bar);
    }
    if (IN(2)) {
        const SsmTabs tb = make_tabs(args.ws);
        for (int gwi = F.vcu * NWAVES + F.wave; gwi < 2048; gwi += F.G * NWAVES) ssm_pass1_item((const half_t*)(args.ws + WS_PROJ16), tb, gwi >> 6, (gwi >> 2) & 15, gwi & 3, F.lane);
        if (BOTH(2)) xcd_barrier(bar);
    }
    if (IN(3)) {
        { const SsmTabs tb = make_tabs(args.ws);
          for (int sq = F.vcu * 512 + F.tid; sq < BATCH * NG * NP; sq += F.G * 512) ssm_scan_thread(args.in[7], args.in[8], args.in[9], tb, sq); }
        for (int u = F.vcu; u < 256; u += F.G)
            attn_unit(F.lds, (const half_t*)(args.ws + WS_PROJ16), (const half_t*)(args.ws + WS_K16), (const half_t*)(args.ws + WS_VT16), (half_t*)(args.ws + WS_CAT16), (u >> 4) >> 2, (u >> 4) & 3, u & 15, F.tid, F.wave, F.lane);
        for (int u = F.vcu; u < 512; u += F.G)
            spatial_unit(F.lds, (const half_t*)(args.ws + WS_PROJ16), args.in[18], args.in[19], args.in[17], (half_t*)(args.ws + WS_CAT16), u >> 2, u & 3, F.tid, F.wave, F.lane);
        if (BOTH(3)) xcd_barrier(bar);
    }
    if (IN(4)) {
        const SsmTabs tb = make_tabs(args.ws);
        for (int gwi = F.vcu * NWAVES + F.wave; gwi < 2048; gwi += F.G * NWAVES) ssm_pass2_item((const half_t*)(args.ws + WS_PROJ16), tb, args.in[9], (half_t*)(args.ws + WS_YSG16), gwi >> 6, (gwi >> 2) & 15, gwi & 3, F.lane);
        if (BOTH(4)) xcd_barrier(bar);
    }
    if (IN(5)) {
        { pg::OrderMN S; S.init(T, 1024, F.G, (int)blockIdx.x, args.ws + WS_YSG16, 512, args.ws + WS_WGLUT, 512);
          pg::EpiGlu E{(half_t*)(args.ws + WS_CAT16), 1536, args.in[16]};
          pg::gemm_phase<pg::EpiGlu, pg::OrderMN, true, true>(F.lds + RING_OFF, 512, 512, 8, S, E); }
        { pg::OrderMN S; S.init(T, 3072, F.G, (int)blockIdx.x, args.ws + WS_N16, DM, args.ws + WS_WGATET, DM);
          pg::EpiGate E{(half_t*)(args.ws + WS_G16), 3072, args.in[6]};
          pg::gemm_phase<pg::EpiGate, pg::OrderMN, true, true>(F.lds + RING_OFF, DM, DM, 16, S, E); }
        if (BOTH(5)) xcd_barrier(bar);
    }
    if (IN(6)) {
        pg::OrderBr S; S.init(F.G, (int)blockIdx.x, args.ws + WS_CAT16, args.ws + WS_WBRT);
        pg::EpiBranch E{(half_t*)(args.ws + WS_MERGED16), (const half_t*)(args.ws + WS_G16)};
        pg::gemm_phase<pg::EpiBranch, pg::OrderBr, true, true>(F.lds + RING_OFF, 1536, 512, 8, S, E);
        if (BOTH(6)) xcd_barrier(bar);
    }
    if (IN(7)) {
        pg::OrderMN S; S.init(T, 1024, F.G, (int)blockIdx.x, args.ws + WS_MERGED16, DM, args.ws + WS_WOUTT, DM);
        pg::EpiOut E{(float*)(args.ws + WS_H32), args.in[0], DM};
        pg::gemm_phase<pg::EpiOut, pg::OrderMN, true, true>(F.lds + RING_OFF, DM, DM, 16, S, E);
        if (BOTH(7)) xcd_barrier(bar);
    }
#undef IN
#undef BOTH
}

__global__ void cvt_h2f_kernel(const half_t* in, float* out, size_t n) {
    const size_t i = ((size_t)blockIdx.x * 256 + threadIdx.x) * 4;
    if (i < n) { const f16x4 v = *(const f16x4*)(in + i); *(f32x4*)(out + i) = (f32x4){(float)v.x, (float)v.y, (float)v.z, (float)v.w}; }
}

__global__ void cvt_h2f_2d_kernel(const half_t* in, int ldin, float* out, int ldout, int cols4) {
    const int r = blockIdx.x;
    for (int c = threadIdx.x; c < cols4; c += blockDim.x) {
        const f16x4 v = *(const f16x4*)(in + (size_t)r * ldin + c * 4);
        *(f32x4*)(out + (size_t)r * ldout + c * 4) = (f32x4){(float)v.x, (float)v.y, (float)v.z, (float)v.w};
    }
}

static void launch_gemm(hipStream_t st, GemmP p, int gy, int gz) {
    dim3 grid(p.N / 64, gy, gz);
    hipLaunchKernelGGL(sgemm_kernel, grid, dim3(256), 0, st, p);
}

extern "C" void kernel_launch(void* const* d_in, const int* in_sizes, int n_in, void* d_out, int out_size, void* d_ws, size_t ws_size, hipStream_t stream) {
    const float* x = (const float*)d_in[0];       const float* mem = (const float*)d_in[1];
    const float* g_mix = (const float*)d_in[2];   const float* g_mem = (const float*)d_in[3];
    const float* w_in = (const float*)d_in[4];    const float* w_gate = (const float*)d_in[5];
    const float* b_gate = (const float*)d_in[6];  const float* lam_re = (const float*)d_in[7];
    const float* lam_im = (const float*)d_in[8];  const float* log_dt = (const float*)d_in[9];
    const float* b_re = (const float*)d_in[10];   const float* b_im = (const float*)d_in[11];
    const float* c_re = (const float*)d_in[12];   const float* c_im = (const float*)d_in[13];
    const float* d_skip = (const float*)d_in[14]; const float* w_glu = (const float*)d_in[15];
    const float* b_glu = (const float*)d_in[16];  const float* g_sgu = (const float*)d_in[17];
    const float* w_spatial = (const float*)d_in[18]; const float* b_spatial = (const float*)d_in[19];
    const float* w_kv = (const float*)d_in[20];   const float* w_branch = (const float*)d_in[21];
    const float* w_out = (const float*)d_in[22];  const float* g_ffn = (const float*)d_in[23];
    const float* w_group = (const float*)d_in[24]; const float* b_group = (const float*)d_in[25];
    const float* w_router = (const float*)d_in[26]; const float* b_router = (const float*)d_in[27];
    const float* w1 = (const float*)d_in[28];     const float* w3 = (const float*)d_in[29];
    const float* w2 = (const float*)d_in[30];     const float* g_final = (const float*)d_in[31];
    float* out = (float*)d_out;

    char* ws = (char*)d_ws;
    int*   ctl   = (int*)(ws);
    float* bufN  = (float*)(ws + 1 * MiB);
    float* bufP  = (float*)(ws + 65 * MiB);
    float* bufC  = (float*)(ws + 193 * MiB);
    float* bufY  = (float*)(ws + 289 * MiB);
    float* bufG  = (float*)(ws + 353 * MiB);
    float* bufKV = (float*)(ws + 417 * MiB);
    float* bufMN = (float*)(ws + 421 * MiB);
    float* xend  = (float*)(ws + 425 * MiB);
    float* xin   = (float*)(ws + 428 * MiB);
    int*   eid   = (int*)(ws + 431 * MiB);
    float* ewt   = (float*)(ws + 432 * MiB);
    int*   srcTok= (int*)(ws + 433 * MiB);
    int*   posOf = (int*)(ws + 434 * MiB);
    if (ws_size < 480 * MiB) { fprintf(stderr, "ws too small: %zu\n", ws_size); return; }
    int* counts = ctl; int* rowStart = ctl + 64; int* cursor = ctl + 128;

    (void)hipMemsetAsync(ctl, 0, CTL_ZERO_BYTES, stream);

    {
        static int grid = 0;
        if (grid == 0) {
            int dev = 0, cus = 0;
            hipGetDevice(&dev); hipDeviceGetAttribute(&cus, hipDeviceAttributeMultiprocessorCount, dev);
            hipFuncSetAttribute((const void*)mk_fwd, hipFuncAttributeMaxDynamicSharedMemorySize, LDS_BYTES);
            grid = cus;
        }
        Args a{};
        for (int i = 0; i < 32; ++i) a.in[i] = (const float*)d_in[i];
        a.out = out; a.ws = (unsigned char*)d_ws; a.ph_lo = 0; a.ph_hi = 8; a.li = 0;
        hipLaunchKernelGGL(mk_fwd, dim3(grid), dim3(NWAVES * 64), LDS_BYTES, stream, a);
    }
    float* bufXF = bufC;
    { RouteP rp{bufN, g_ffn, w_group, b_group, w_router, b_router, bufXF, eid, ewt, counts};
      hipLaunchKernelGGL(route_kernel, dim3(T), dim3(128), 0, stream, rp); }
    hipLaunchKernelGGL(offsets_kernel, dim3(1), dim3(64), 0, stream, counts, rowStart, cursor);
    hipLaunchKernelGGL(scatter_kernel, dim3(T * 2 / 256), dim3(256), 0, stream, eid, rowStart, cursor, srcTok, posOf);
    float* bufH = bufY;
    float* bufYo = bufP;
    { GemmP p{}; p.A = bufXF; p.lda = DM; p.gather = srcTok; p.B = w1; p.ldb = DFF; p.strideB = (long)DM * DFF; p.rowStart = rowStart; p.rowCount = counts; p.M = 0; p.N = DFF; p.K = DM; p.mode = 0; p.C = bufH; p.ldc = DFF; launch_gemm(stream, p, 16, NE); }
    { GemmP p{}; p.A = bufXF; p.lda = DM; p.gather = srcTok; p.B = w3; p.ldb = DFF; p.strideB = (long)DM * DFF; p.rowStart = rowStart; p.rowCount = counts; p.M = 0; p.N = DFF; p.K = DM; p.mode = 4; p.C = bufH; p.ldc = DFF; launch_gemm(stream, p, 16, NE); }
    { GemmP p{}; p.A = bufH; p.lda = DFF; p.B = w2; p.ldb = DM; p.strideB = (long)DFF * DM; p.rowStart = rowStart; p.rowCount = counts; p.M = 0; p.N = DM; p.K = DFF; p.mode = 0; p.C = bufYo; p.ldc = DM; launch_gemm(stream, p, 16, NE); }
    hipLaunchKernelGGL(final_kernel, dim3(T), dim3(256), 0, stream, bufN, bufYo, posOf, ewt, g_final, out);
}
```

```cpp
#include <hip/hip_runtime.h>
#include <cstdio>
#include <cstdint>

constexpr int BATCH = 4, SEQ = 4096, DM = 1024, T = BATCH * SEQ;
constexpr int MEML = 256, MROWS = BATCH * MEML;
constexpr int SSMW = 512, SG = 16, NG = 32, NP = 64;
constexpr int SGUW = 512, SH = 4, SHD = 128, CHUNK = 128;
constexpr int XH = 4, XD = 128, XW = 512;
constexpr int INC = 2048;
constexpr int NGRP = 8, EPG = 8, NE = 64, DFF = 512;
constexpr float EPS = 1e-6f;
constexpr int SCH = 128;
constexpr int NSC = SEQ / SCH;

#define LAS __attribute__((address_space(3)))
#define GAS __attribute__((address_space(1)))
typedef _Float16 half_t;
typedef _Float16 f16x8 __attribute__((ext_vector_type(8)));
typedef _Float16 f16x4 __attribute__((ext_vector_type(4)));
typedef _Float16 f16x2 __attribute__((ext_vector_type(2)));
typedef float f32x4 __attribute__((ext_vector_type(4)));
typedef float f32x2 __attribute__((ext_vector_type(2)));
typedef unsigned u32x4 __attribute__((ext_vector_type(4)));
typedef unsigned u32x2 __attribute__((ext_vector_type(2)));

__device__ __forceinline__ unsigned pk_h2(float lo, float hi) { f16x2 v; v.x = (_Float16)lo; v.y = (_Float16)hi; return __builtin_bit_cast(unsigned, v); }
__device__ __forceinline__ float fast_sigmoid(float x) { return __builtin_amdgcn_rcpf(1.f + __builtin_amdgcn_exp2f(-1.4426950408889634f * x)); }
__device__ __forceinline__ float fast_gelu(float x) {
    const float u = 0.7978845608028654f * (x + 0.044715f * x * x * x);
    return x * __builtin_amdgcn_rcpf(1.f + __builtin_amdgcn_exp2f(-2.885390081777927f * u));
}

namespace pg {
constexpr int BM = 256, BK = 64, HALF = 128, HTB = HALF * BK * 2, STAGE_BYTES = 8 * HTB, NXCD = 8, WGM = 8;

__host__ __device__ __forceinline__ int lds_byte(int r, int c) { const int st = (r >> 4) * 2 + (c >> 5), rr = r & 15, cc = c & 31, ob = rr * 64 + cc * 2; return st * 1024 + (ob ^ (((ob >> 9) & 1) << 5)); }
__host__ __device__ __forceinline__ void stage_rc(int b, int& R, int& C) { const int st = b / 1024, sb = b % 1024, swz = sb ^ (((sb >> 9) & 1) << 5); R = (st >> 1) * 16 + swz / 64; C = (st & 1) * 32 + (swz % 64) / 2; }
__host__ __device__ __forceinline__ int perm32(int rho) { const int n = rho >> 4, i = rho & 15; return 8 * (i >> 2) + 4 * n + (i & 3); }

struct Unit { const char* A; const char* B; int pm, pn, aux; };

struct OrderMN {
    int nM, nN, nwg, G, c; const char* A; const char* B; size_t tA, tB;
    __device__ void init(int M, int N, int G_, int c_, const void* A_, size_t lda, const void* B_, size_t ldb) { nM = M / BM; nN = N / BM; nwg = nM * nN; G = G_; c = c_; A = (const char*)A_; B = (const char*)B_; tA = (size_t)BM * lda * 2; tB = (size_t)BM * ldb * 2; }
    __device__ bool next(int i, Unit& u) const {
        const long L = (long)i * G + c; if (L >= nwg) return false;
        int wgid = (int)L; { const int q = nwg / NXCD, r = nwg % NXCD, xcd = wgid % NXCD, off = wgid / NXCD; wgid = (xcd < r ? xcd * (q + 1) : r * (q + 1) + (xcd - r) * q) + off; }
        const int nig = WGM * nN, gid = wgid / nig, fm = gid * WGM, gsz = (nM - fm) < WGM ? (nM - fm) : WGM;
        u.pm = fm + ((wgid % nig) % gsz); u.pn = (wgid % nig) / gsz; u.aux = 0;
        u.A = A + (size_t)u.pm * tA; u.B = B + (size_t)u.pn * tB; return true;
    }
};

template <class Epi, class Sched, bool ALIGN_EPI, bool SP2>
__device__ __forceinline__ void gemm_phase(LAS unsigned char* lds, const int lda, const int ldb, const int nt, const Sched& S, const Epi& E) {
    const int tid = threadIdx.x, wid = __builtin_amdgcn_readfirstlane(tid >> 6), lane = tid & 63, wr = wid >> 2, wc = wid & 3, fr = lane & 15, fq = lane >> 4;
    unsigned voffA[2], voffB[2];
#pragma unroll
    for (int i = 0; i < 2; ++i) { int R, C; stage_rc(tid * 16 + i * 8192, R, C); const int Rb = Epi::PERM ? ((R & ~31) + perm32(R & 31)) : R;
        voffA[i] = (unsigned)(R * lda + C) * 2u; voffB[i] = (unsigned)(Rb * ldb + C) * 2u; }
    const size_t kstep = (size_t)(BK * 2);
    const size_t hstepA = (size_t)HALF * lda * 2, hstepB = (size_t)HALF * ldb * 2;
    const unsigned ldsw = (unsigned)wid * 1024u;
    const int aoff = lds_byte(wr * 64 + fr, fq * 8), boff = lds_byte(wc * 32 + fr, fq * 8);
#define PG_SA(b, h) (((b) * 2 + (h)) * HTB)
#define PG_SB(b, h) ((4 + (b) * 2 + (h)) * HTB)
#define PG_STAGE(bufoff, gbase, voff) do { _Pragma("unroll") for (int _i = 0; _i < 2; ++_i) \
        __builtin_amdgcn_global_load_lds((const unsigned*)((const char*)(gbase) + (voff)[_i]), (LAS unsigned*)(lds + (bufoff) + ldsw + _i * 8192), 16, 0, 0); } while (0)
#define PG_LDA(dst, b, h) do { _Pragma("unroll") for (int m = 0; m < 4; ++m) _Pragma("unroll") for (int k = 0; k < 2; ++k) dst[m][k] = *(const LAS f16x8*)(lds + PG_SA(b, h) + aoff + m * 2048 + k * 1024); } while (0)
#define PG_LDB(dst, b, h) do { _Pragma("unroll") for (int n = 0; n < 2; ++n) _Pragma("unroll") for (int k = 0; k < 2; ++k) dst[n][k] = *(const LAS f16x8*)(lds + PG_SB(b, h) + boff + n * 2048 + k * 1024); } while (0)
#define PG_MMA(ai, bj, At, Bt) do { __builtin_amdgcn_s_setprio(1); _Pragma("unroll") for (int m = 0; m < 4; ++m) _Pragma("unroll") for (int n = 0; n < 2; ++n) _Pragma("unroll") for (int k = 0; k < 2; ++k) \
        acc[ai][bj][m][n] = __builtin_amdgcn_mfma_f32_16x16x32_f16(Bt[n][k], At[m][k], acc[ai][bj][m][n], 0, 0, 0); __builtin_amdgcn_s_setprio(0); } while (0)
#define PG_WAIT_V(n) asm volatile("s_waitcnt vmcnt(" #n ")" ::: "memory")
#define PG_WAIT_L(n) asm volatile("s_waitcnt lgkmcnt(" #n ")" ::: "memory")
#define PG_BAR __builtin_amdgcn_s_barrier()
#define PG_SCHED __builtin_amdgcn_sched_barrier(0)
    Unit cur, nxt; int ui = 0;
    if (!S.next(0, cur)) return;
    f32x4 acc[2][2][4][2];
#pragma unroll
    for (int a = 0; a < 2; ++a)
#pragma unroll
        for (int b = 0; b < 2; ++b)
#pragma unroll
            for (int m = 0; m < 4; ++m)
#pragma unroll
                for (int n = 0; n < 2; ++n) acc[a][b][m][n] = (f32x4){0.f, 0.f, 0.f, 0.f};
    f16x8 At[4][2], B0[2][2], B1[2][2];
    const char* cA = cur.A; const char* cB = cur.B;
    if constexpr (SP2) {
        PG_STAGE(PG_SB(0, 0), cB, voffB); PG_STAGE(PG_SB(0, 1), cB + hstepB, voffB); PG_STAGE(PG_SA(0, 0), cA, voffA); PG_STAGE(PG_SA(0, 1), cA + hstepA, voffA);
        if (wr == 1) PG_BAR;
        PG_WAIT_V(2); PG_BAR;
        PG_STAGE(PG_SB(1, 0), cB + kstep, voffB); PG_STAGE(PG_SA(1, 0), cA + kstep, voffA); PG_STAGE(PG_SB(1, 1), cB + hstepB + kstep, voffB);
        PG_WAIT_V(6); PG_BAR;
    } else {
        PG_STAGE(PG_SB(0, 0), cB, voffB); PG_STAGE(PG_SA(0, 0), cA, voffA); PG_STAGE(PG_SB(0, 1), cB + hstepB, voffB); PG_STAGE(PG_SA(0, 1), cA + hstepA, voffA);
        if (wr == 1) PG_BAR;
        PG_WAIT_V(4); PG_BAR;
        PG_STAGE(PG_SB(1, 0), cB + kstep, voffB); PG_STAGE(PG_SA(1, 0), cA + kstep, voffA); PG_STAGE(PG_SB(1, 1), cB + hstepB + kstep, voffB);
        PG_WAIT_V(6); PG_BAR;
    }
    for (;;) {
        const bool has_next = S.next(ui + 1, nxt);
        const char* nA = has_next ? nxt.A : cA; const char* nB = has_next ? nxt.B : cB;
        for (int t = 0; t < nt; t += 2) {
            const bool last = (t == nt - 2);
            const char* a1 = cA + (size_t)(t + 1) * kstep;
            const char* a2 = last ? nA : cA + (size_t)(t + 2) * kstep; const char* b2 = last ? nB : cB + (size_t)(t + 2) * kstep;
            const char* a3 = a2 + kstep; const char* b3 = b2 + kstep;
            if constexpr (SP2) {
            PG_LDB(B0, 0, 0); PG_LDB(B1, 0, 1); PG_SCHED; PG_LDA(At, 0, 0); PG_STAGE(PG_SA(1, 1), a1 + hstepA, voffA);
            PG_WAIT_V(8); PG_WAIT_L(0); PG_BAR; PG_MMA(0, 0, At, B0); PG_MMA(0, 1, At, B1); PG_BAR; PG_SCHED;
            PG_LDA(At, 0, 1); PG_STAGE(PG_SB(0, 0), b2, voffB); PG_STAGE(PG_SB(0, 1), b2 + hstepB, voffB); PG_STAGE(PG_SA(0, 0), a2, voffA);
            PG_WAIT_V(8); PG_WAIT_L(0); PG_BAR; PG_MMA(1, 0, At, B0); PG_MMA(1, 1, At, B1); PG_BAR; PG_SCHED;
            PG_LDB(B0, 1, 0); PG_LDB(B1, 1, 1); PG_SCHED; PG_LDA(At, 1, 0); PG_STAGE(PG_SA(0, 1), a2 + hstepA, voffA);
            PG_WAIT_V(8); PG_WAIT_L(0); PG_BAR; PG_MMA(0, 0, At, B0); PG_MMA(0, 1, At, B1); PG_BAR; PG_SCHED;
            PG_LDA(At, 1, 1); PG_STAGE(PG_SB(1, 0), b3, voffB); PG_STAGE(PG_SB(1, 1), b3 + hstepB, voffB); PG_STAGE(PG_SA(1, 0), a3, voffA);
            PG_WAIT_V(8); PG_WAIT_L(0); PG_BAR; PG_MMA(1, 0, At, B0); PG_MMA(1, 1, At, B1); PG_BAR; PG_SCHED;
            } else {
            PG_LDB(B0, 0, 0); PG_SCHED; PG_LDA(At, 0, 0); PG_STAGE(PG_SA(1, 1), a1 + hstepA, voffA);
            PG_WAIT_L(8); PG_BAR; PG_WAIT_L(0); PG_MMA(0, 0, At, B0); PG_BAR; PG_SCHED;
            PG_LDB(B1, 0, 1); PG_STAGE(PG_SB(0, 0), b2, voffB);
            PG_BAR; PG_WAIT_L(0); PG_MMA(0, 1, At, B1); PG_BAR;
            PG_LDA(At, 0, 1); PG_STAGE(PG_SA(0, 0), a2, voffA);
            PG_BAR; PG_WAIT_L(0); PG_MMA(1, 0, At, B0); PG_BAR; PG_SCHED;
            PG_STAGE(PG_SB(0, 1), b2 + hstepB, voffB);
            PG_WAIT_V(6); PG_BAR; PG_MMA(1, 1, At, B1); PG_BAR;
            PG_LDB(B0, 1, 0); PG_SCHED; PG_LDA(At, 1, 0); PG_STAGE(PG_SA(0, 1), a2 + hstepA, voffA);
            PG_WAIT_L(8); PG_BAR; PG_WAIT_L(0); PG_MMA(0, 0, At, B0); PG_BAR; PG_SCHED;
            PG_LDB(B1, 1, 1); PG_STAGE(PG_SB(1, 0), b3, voffB);
            PG_BAR; PG_WAIT_L(0); PG_MMA(0, 1, At, B1); PG_BAR;
            PG_LDA(At, 1, 1); PG_STAGE(PG_SA(1, 0), a3, voffA);
            PG_BAR; PG_WAIT_L(0); PG_MMA(1, 0, At, B0); PG_BAR; PG_SCHED;
            PG_STAGE(PG_SB(1, 1), b3 + hstepB, voffB);
            PG_WAIT_V(6); PG_BAR; PG_MMA(1, 1, At, B1); PG_BAR;
            }
        }
        if constexpr (ALIGN_EPI) { if (wr == 0) PG_BAR; }
        E(acc, cur, wr, wc, fr, fq);
        if (!has_next) break;
#pragma unroll
        for (int a = 0; a < 2; ++a)
#pragma unroll
            for (int b = 0; b < 2; ++b)
#pragma unroll
                for (int m = 0; m < 4; ++m)
#pragma unroll
                    for (int n = 0; n < 2; ++n) acc[a][b][m][n] = (f32x4){0.f, 0.f, 0.f, 0.f};
        cur = nxt; cA = nA; cB = nB; ++ui;
        if constexpr (ALIGN_EPI) { if (wr == 1) PG_BAR; }
    }
    PG_WAIT_V(0);
    if constexpr (!ALIGN_EPI) { if (wr == 0) PG_BAR; }
    PG_BAR;
#undef PG_SA
#undef PG_SB
#undef PG_STAGE
#undef PG_LDA
#undef PG_LDB
#undef PG_MMA
#undef PG_WAIT_V
#undef PG_WAIT_L
#undef PG_BAR
#undef PG_SCHED
}

struct EpiProj {
    static constexpr bool PERM = true;
    half_t* O; int ldc;
    __device__ __forceinline__ void operator()(const f32x4 (&acc)[2][2][4][2], const Unit& u, int wr, int wc, int fr, int fq) const {
        const int row0 = u.pm * BM + wr * 64 + fr, col0 = u.pn * BM + wc * 32 + 8 * fq;
        const bool act = (u.pn >= 2 && u.pn < 6);
#pragma unroll
        for (int ai = 0; ai < 2; ++ai)
#pragma unroll
            for (int m = 0; m < 4; ++m) { half_t* rowp = O + (size_t)(row0 + ai * HALF + m * 16) * ldc + col0;
#pragma unroll
                for (int bj = 0; bj < 2; ++bj) { f32x4 v0 = acc[ai][bj][m][0], v1 = acc[ai][bj][m][1];
                    if (act) {
#pragma unroll
                        for (int j = 0; j < 4; ++j) { v0[j] = fast_gelu(v0[j]); v1[j] = fast_gelu(v1[j]); } }
                    u32x4 w; w.x = pk_h2(v0[0], v0[1]); w.y = pk_h2(v0[2], v0[3]); w.z = pk_h2(v1[0], v1[1]); w.w = pk_h2(v1[2], v1[3]);
                    *(u32x4*)(rowp + bj * HALF) = w; } }
    }
};

struct EpiGlu {
    static constexpr bool PERM = true;
    half_t* O; int ldc; const float* bias;
    __device__ __forceinline__ void operator()(const f32x4 (&acc)[2][2][4][2], const Unit& u, int wr, int wc, int fr, int fq) const {
        const int row0 = u.pm * BM + wr * 64 + fr, col0 = u.pn * HALF + wc * 32 + 8 * fq;
        const f32x4 ba0 = *(const f32x4*)(bias + col0), ba1 = *(const f32x4*)(bias + col0 + 4), bb0 = *(const f32x4*)(bias + 512 + col0), bb1 = *(const f32x4*)(bias + 512 + col0 + 4);
#pragma unroll
        for (int ai = 0; ai < 2; ++ai)
#pragma unroll
            for (int m = 0; m < 4; ++m) {
                const f32x4 a0 = acc[ai][0][m][0] + ba0, a1 = acc[ai][0][m][1] + ba1, b0 = acc[ai][1][m][0] + bb0, b1 = acc[ai][1][m][1] + bb1;
                u32x4 w; w.x = pk_h2(a0[0] * fast_sigmoid(b0[0]), a0[1] * fast_sigmoid(b0[1])); w.y = pk_h2(a0[2] * fast_sigmoid(b0[2]), a0[3] * fast_sigmoid(b0[3]));
                w.z = pk_h2(a1[0] * fast_sigmoid(b1[0]), a1[1] * fast_sigmoid(b1[1])); w.w = pk_h2(a1[2] * fast_sigmoid(b1[2]), a1[3] * fast_sigmoid(b1[3]));
                *(u32x4*)(O + (size_t)(row0 + ai * HALF + m * 16) * ldc + col0) = w; }
    }
};
struct EpiGate {
    static constexpr bool PERM = true;
    half_t* O; int ldc; const float* bias;
    __device__ __forceinline__ void operator()(const f32x4 (&acc)[2][2][4][2], const Unit& u, int wr, int wc, int fr, int fq) const {
        const int row0 = u.pm * BM + wr * 64 + fr, col0 = u.pn * BM + wc * 32 + 8 * fq;
        f32x4 bv[2][2];
#pragma unroll
        for (int bj = 0; bj < 2; ++bj)
#pragma unroll
            for (int n = 0; n < 2; ++n) bv[bj][n] = *(const f32x4*)(bias + col0 + bj * HALF + 4 * n);
#pragma unroll
        for (int ai = 0; ai < 2; ++ai)
#pragma unroll
            for (int m = 0; m < 4; ++m) { half_t* rowp = O + (size_t)(row0 + ai * HALF + m * 16) * ldc + col0;
#pragma unroll
                for (int bj = 0; bj < 2; ++bj) { const f32x4 v0 = acc[ai][bj][m][0] + bv[bj][0], v1 = acc[ai][bj][m][1] + bv[bj][1];
                    u32x4 w; w.x = pk_h2(fast_sigmoid(v0[0]), fast_sigmoid(v0[1])); w.y = pk_h2(fast_sigmoid(v0[2]), fast_sigmoid(v0[3])); w.z = pk_h2(fast_sigmoid(v1[0]), fast_sigmoid(v1[1])); w.w = pk_h2(fast_sigmoid(v1[2]), fast_sigmoid(v1[3]));
                    *(u32x4*)(rowp + bj * HALF) = w; } }
    }
};
struct EpiBranch {
    static constexpr bool PERM = true;
    half_t* O; const half_t* G;
    __device__ __forceinline__ void operator()(const f32x4 (&acc)[2][2][4][2], const Unit& u, int wr, int wc, int fr, int fq) const {
        const int row0 = u.pm * BM + wr * 64 + fr, col0 = u.pn * BM + wc * 32 + 8 * fq; const int i = u.aux;
#pragma unroll
        for (int ai = 0; ai < 2; ++ai)
#pragma unroll
            for (int m = 0; m < 4; ++m) { const size_t r = (size_t)(row0 + ai * HALF + m * 16);
#pragma unroll
                for (int bj = 0; bj < 2; ++bj) {
                    const f16x8 gv = *(const f16x8*)(G + r * 3072 + i * 1024 + col0 + bj * HALF);
                    f16x8 pv = {0, 0, 0, 0, 0, 0, 0, 0};
                    if (i > 0) pv = *(const f16x8*)(O + r * 1024 + col0 + bj * HALF);
                    const f32x4 v0 = acc[ai][bj][m][0], v1 = acc[ai][bj][m][1];
                    u32x4 w; w.x = pk_h2((float)pv[0] + (float)gv[0] * v0[0], (float)pv[1] + (float)gv[1] * v0[1]); w.y = pk_h2((float)pv[2] + (float)gv[2] * v0[2], (float)pv[3] + (float)gv[3] * v0[3]);
                    w.z = pk_h2((float)pv[4] + (float)gv[4] * v1[0], (float)pv[5] + (float)gv[5] * v1[1]); w.w = pk_h2((float)pv[6] + (float)gv[6] * v1[2], (float)pv[7] + (float)gv[7] * v1[3]);
                    *(u32x4*)(O + r * 1024 + col0 + bj * HALF) = w; } }
    }
};
struct EpiOut {
    static constexpr bool PERM = false;
    float* O; const float* X; int ldc;
    __device__ __forceinline__ void operator()(const f32x4 (&acc)[2][2][4][2], const Unit& u, int wr, int wc, int fr, int fq) const {
        const int row0 = u.pm * BM + wr * 64 + fr, col0 = u.pn * BM + wc * 32 + 4 * fq;
#pragma unroll
        for (int ai = 0; ai < 2; ++ai)
#pragma unroll
            for (int m = 0; m < 4; ++m) { const size_t off = (size_t)(row0 + ai * HALF + m * 16) * ldc + col0;
#pragma unroll
                for (int bj = 0; bj < 2; ++bj)
#pragma unroll
                    for (int n = 0; n < 2; ++n) *(f32x4*)(O + off + bj * HALF + n * 16) = *(const f32x4*)(X + off + bj * HALF + n * 16) + acc[ai][bj][m][n]; }
    }
};
struct OrderBr {
    OrderMN base; const char* A; const char* B;
    __device__ void init(int G_, int c_, const void* cat, const void* wbr) { base.init(T, 1024, G_, c_, nullptr, 0, nullptr, 0); A = (const char*)cat; B = (const char*)wbr; }
    __device__ bool next(int j, Unit& u) const {
        const int r = j / 3, i = j - 3 * r;
        if (!base.next(r, u)) return false;
        u.aux = i;
        u.A = A + (size_t)u.pm * BM * 1536 * 2 + (size_t)i * 512 * 2;
        u.B = B + (size_t)i * 1024 * 512 * 2 + (size_t)u.pn * BM * 512 * 2;
        return true;
    }
};
}

constexpr int NWAVES = 8;
constexpr int RING_OFF = 0, RING_BYTES = 131072;
constexpr int LDSCTL_OFF = RING_BYTES, MISC_OFF = LDSCTL_OFF + 320;
constexpr int LDS_BYTES = 147456;
typedef GAS unsigned gu32;
#define RLX_AGENT __ATOMIC_RELAXED, __HIP_MEMORY_SCOPE_AGENT
#define LDS_WAIT() asm volatile("s_waitcnt lgkmcnt(0)" ::: "memory")
#define VM_WAIT() asm volatile("s_waitcnt vmcnt(0)" ::: "memory")

#define XB_TMO      128
#define XB_XCNT(j)  (256  + 64 * (j))
#define XB_XSUB(j)  (1280 + 64 * (j))
#define XB_XGEN(j)  (2304 + 64 * (j))
#define XB_TOP      3328
#define XB_TOPGEN   3392
#define XCD_BAR_WORDS 3456
#define XB_SPIN_CAP (1u << 18)
__device__ __forceinline__ unsigned xb_ld(unsigned* p)              { return __hip_atomic_load(p, __ATOMIC_RELAXED, __HIP_MEMORY_SCOPE_AGENT); }
__device__ __forceinline__ unsigned xb_add(unsigned* p, unsigned v) { return __hip_atomic_fetch_add(p, v, __ATOMIC_RELAXED, __HIP_MEMORY_SCOPE_AGENT); }
__device__ __forceinline__ unsigned xb_xcc_id() { return (unsigned)__builtin_amdgcn_s_getreg((3 << 11) | 20) & 0xFu; }
#define XB_SPIN(cond, bar) do { unsigned _sp = 0; while (cond) { __builtin_amdgcn_s_sleep(1); \
    if ((++_sp & 255u) == 0u) { if (xb_ld(&(bar)[XB_TMO])) break; if (_sp > XB_SPIN_CAP) { atomicAdd(&(bar)[XB_TMO], 1u); break; } } } } while (0)
struct XcdBarrier { unsigned* bar; unsigned x; volatile LAS unsigned* st; };
__device__ __forceinline__ XcdBarrier xcd_barrier_post(unsigned* bar, volatile LAS unsigned* st) {
    XcdBarrier b; b.bar = bar; b.x = xb_xcc_id(); b.st = st;
    if (threadIdx.x == 0) (void)xb_add(&bar[XB_XCNT(b.x)], 1u);
    return b;
}
__device__ __forceinline__ void xcd_barrier_complete(unsigned* bar, unsigned x, unsigned& nloc, unsigned& nx) {
    const unsigned G = gridDim.x * gridDim.y * gridDim.z;
    unsigned sum, cnt, mine, sp = 0u;
    for (;;) {
        sum = 0u; cnt = 0u; mine = 0u;
#pragma unroll
        for (unsigned j = 0; j < 16; ++j) { const unsigned c = xb_ld(&bar[XB_XCNT(j)]); sum += c; cnt += (c > 0u) ? 1u : 0u; mine = (j == x) ? c : mine; }
        if (sum == G) break;
        __builtin_amdgcn_s_sleep(1);
        if ((++sp & 255u) == 0u) { if (xb_ld(&bar[XB_TMO])) break; if (sp > XB_SPIN_CAP) { atomicAdd(&bar[XB_TMO], 1u); break; } }
    }
    nloc = mine > 0u ? mine : 1u; nx = cnt > 0u ? cnt : 1u;
}
__device__ __forceinline__ void xcd_barrier(const XcdBarrier& b) {
    asm volatile("s_waitcnt vmcnt(0)" ::: "memory");
    __syncthreads();
    if (threadIdx.x == 0) {
        unsigned* bar = b.bar;
        __builtin_amdgcn_s_waitcnt(0);
        unsigned nloc = b.st[0], nx = b.st[1];
        if (nloc == 0u) { xcd_barrier_complete(bar, b.x, nloc, nx); b.st[0] = nloc; b.st[1] = nx; }
        const unsigned old = xb_add(&bar[XB_XSUB(b.x)], 1u);
        const unsigned gen = old / nloc;
        if (old + 1u == (gen + 1u) * nloc) {
            __builtin_amdgcn_fence(__ATOMIC_RELEASE, "agent");
            asm volatile("s_waitcnt vmcnt(0)" ::: "memory");
            const unsigned og = xb_add(&bar[XB_TOP], 1u);
            const unsigned tg = og / nx;
            if (og + 1u == (tg + 1u) * nx) xb_add(&bar[XB_TOPGEN], 1u);
            else XB_SPIN(xb_ld(&bar[XB_TOPGEN]) == tg, bar);
            __builtin_amdgcn_fence(__ATOMIC_ACQUIRE, "agent");
            xb_add(&bar[XB_XGEN(b.x)], 1u);
            asm volatile("s_waitcnt vmcnt(0)" ::: "memory");
        } else {
            XB_SPIN(xb_ld(&bar[XB_XGEN(b.x)]) == gen, bar);
            __builtin_amdgcn_fence(__ATOMIC_ACQUIRE, "agent");
            asm volatile("s_waitcnt vmcnt(0)" ::: "memory");
        }
    }
    __syncthreads();
}

__device__ __forceinline__ float wave_sum(float v) {
#pragma unroll
    for (int o = 1; o < 64; o <<= 1) v += __shfl_xor(v, o);
    return v;
}

__device__ __forceinline__ void transpose_item(const float* W, int ldw, int k0, int n0, half_t* WT, int ldt, int drow0, LAS float* scr, int lane, const float* kscale = nullptr) {
    const int lk = lane >> 3, lc = (lane & 7) * 4;
    f32x4 v[8];
#pragma unroll
    for (int i = 0; i < 8; ++i) v[i] = *(const GAS f32x4*)(W + (size_t)(k0 + i * 8 + lk) * ldw + n0 + lc);
#pragma unroll
    for (int i = 0; i < 8; ++i) { LAS float* s = scr + (i * 8 + lk) * 33 + lc; s[0] = v[i].x; s[1] = v[i].y; s[2] = v[i].z; s[3] = v[i].w; }
    LDS_WAIT(); asm volatile("" ::: "memory");
    const int c = lane & 7;
    f32x4 g0 = {1.f, 1.f, 1.f, 1.f}, g1 = g0;
    if (kscale) { g0 = *(const GAS f32x4*)(kscale + k0 + 8 * c); g1 = *(const GAS f32x4*)(kscale + k0 + 8 * c + 4); }
#pragma unroll
    for (int j = 0; j < 4; ++j) { const int n = (lane >> 3) + 8 * j; const LAS float* s = scr + (8 * c) * 33 + n;
        u32x4 o; o.x = pk_h2(s[0 * 33] * g0[0], s[1 * 33] * g0[1]); o.y = pk_h2(s[2 * 33] * g0[2], s[3 * 33] * g0[3]); o.z = pk_h2(s[4 * 33] * g1[0], s[5 * 33] * g1[1]); o.w = pk_h2(s[6 * 33] * g1[2], s[7 * 33] * g1[3]);
        *(GAS u32x4*)(WT + (size_t)(drow0 + n) * ldt + k0 + 8 * c) = o; }
    LDS_WAIT(); asm volatile("" ::: "memory");
}
__device__ __forceinline__ void rms_row_to_f16(const float* xrow, const float* g, half_t* orow, int lane) {
    const GAS f32x4* xr = (const GAS f32x4*)xrow + lane;
    const GAS f32x4* gr = (const GAS f32x4*)g + lane;
    f32x4 v[4]; float s = 0.f;
#pragma unroll
    for (int j = 0; j < 4; ++j) { v[j] = xr[64 * j]; s += (v[j].x * v[j].x + v[j].y * v[j].y) + (v[j].z * v[j].z + v[j].w * v[j].w); }
    const float rs = 1.0f / sqrtf(wave_sum(s) * (1.f / 1024.f) + EPS);
    GAS u32x2* o8 = (GAS u32x2*)orow + lane;
#pragma unroll
    for (int j = 0; j < 4; ++j) { const f32x4 gg = gr[64 * j]; u32x2 w; w.x = pk_h2(v[j].x * rs * gg.x, v[j].y * rs * gg.y); w.y = pk_h2(v[j].z * rs * gg.z, v[j].w * rs * gg.w); o8[64 * j] = w; }
}

typedef float f32x16 __attribute__((ext_vector_type(16)));
__device__ __forceinline__ int crow(int r, int hi) { return (r & 3) + 8 * (r >> 2) + 4 * hi; }

__device__ __forceinline__ void kv_tile(const half_t* __restrict__ A  , const half_t* __restrict__ Bt  , half_t* K16, half_t* VT16, int tile, int wave, int lane) {
    const int m0 = (tile >> 4) * 64, n0 = (tile & 15) * 64;
    const int rb = wave >> 1, cb = (wave & 1) * 32;
    const int fr = lane & 15, fq = lane >> 4;
    const half_t* ap = A + (size_t)(m0 + 16 * rb + fr) * DM + 8 * fq;
    const half_t* bp0 = Bt + (size_t)(n0 + cb + fr) * DM + 8 * fq;
    const half_t* bp1 = bp0 + (size_t)16 * DM;
    f32x4 acc0 = {0.f, 0.f, 0.f, 0.f}, acc1 = {0.f, 0.f, 0.f, 0.f};
    const bool vpart = n0 >= 512;
#pragma unroll 4
    for (int k0 = 0; k0 < DM; k0 += 32) {
        const f16x8 a = *(const f16x8*)(ap + k0), b0 = *(const f16x8*)(bp0 + k0), b1 = *(const f16x8*)(bp1 + k0);
        if (vpart) { acc0 = __builtin_amdgcn_mfma_f32_16x16x32_f16(a, b0, acc0, 0, 0, 0); acc1 = __builtin_amdgcn_mfma_f32_16x16x32_f16(a, b1, acc1, 0, 0, 0); }
        else       { acc0 = __builtin_amdgcn_mfma_f32_16x16x32_f16(b0, a, acc0, 0, 0, 0); acc1 = __builtin_amdgcn_mfma_f32_16x16x32_f16(b1, a, acc1, 0, 0, 0); }
    }
    if (!vpart) {
        const int m = m0 + 16 * rb + fr;
        u32x2 w0, w1; w0.x = pk_h2(acc0[0], acc0[1]); w0.y = pk_h2(acc0[2], acc0[3]); w1.x = pk_h2(acc1[0], acc1[1]); w1.y = pk_h2(acc1[2], acc1[3]);
        *(u32x2*)(K16 + (size_t)m * 512 + n0 + cb + 4 * fq) = w0;
        *(u32x2*)(K16 + (size_t)m * 512 + n0 + cb + 16 + 4 * fq) = w1;
    } else {
        const int mb = m0 + 16 * rb + 4 * fq, b = mb >> 8, key = mb & 255;
        const int n = n0 - 512 + cb + fr;
        u32x2 w0, w1; w0.x = pk_h2(acc0[0], acc0[1]); w0.y = pk_h2(acc0[2], acc0[3]); w1.x = pk_h2(acc1[0], acc1[1]); w1.y = pk_h2(acc1[2], acc1[3]);
        *(u32x2*)(VT16 + ((size_t)b * 512 + n) * 256 + key) = w0;
        *(u32x2*)(VT16 + ((size_t)b * 512 + n + 16) * 256 + key) = w1;
    }
}

constexpr int ATT_K_OFF = 0, ATT_V_OFF = 65536, ATT_WS_OFF = RING_BYTES + 1024;
__device__ __forceinline__ void attn_unit(LAS unsigned char* lds, const half_t* __restrict__ PROJ16, const half_t* __restrict__ K16, const half_t* __restrict__ VT16, half_t* CAT16,
                                          int b, int h, int qb, int tid, int wave, int lane) {
    asm volatile("" : "+v"(tid), "+v"(lane));
    {
        const half_t* kg = K16 + (size_t)(b * 256) * 512 + h * 128;
        const half_t* vg = VT16 + ((size_t)b * 512 + h * 128) * 256;
        u32x4 kv[8], vv[8];
#pragma unroll
        for (int it = 0; it < 8; ++it) { const int idx = it * 512 + tid, key = idx >> 4, ch = idx & 15; kv[it] = *(const u32x4*)(kg + (size_t)key * 512 + ch * 8); }
#pragma unroll
        for (int it = 0; it < 8; ++it) { const int idx = it * 512 + tid, d = idx >> 5, ch = idx & 31; vv[it] = *(const u32x4*)(vg + (size_t)d * 256 + ch * 8); }
#pragma unroll
        for (int it = 0; it < 8; ++it) { const int idx = it * 512 + tid, key = idx >> 4, ch = idx & 15; *(LAS u32x4*)(lds + ATT_K_OFF + key * 256 + ((ch ^ (key & 15)) << 4)) = kv[it]; }
#pragma unroll
        for (int it = 0; it < 8; ++it) { const int idx = it * 512 + tid, d = idx >> 5, ch = idx & 31; const int m = (d & 31) << 3;
            u32x2 lo, hi2; lo.x = vv[it].x; lo.y = vv[it].y; hi2.x = vv[it].z; hi2.y = vv[it].w;
            *(LAS u32x2*)(lds + ATT_V_OFF + d * 512 + ((ch * 16) ^ m)) = lo;
            *(LAS u32x2*)(lds + ATT_V_OFF + d * 512 + ((ch * 16 + 8) ^ m)) = hi2; }
    }
    __syncthreads();
    const int c31 = lane & 31, hi = lane >> 5;
    const int tok0 = b * SEQ + qb * 256 + wave * 32;
    f16x8 qf[8];
    {
        const half_t* qp = PROJ16 + (size_t)(tok0 + c31) * INC + 1536 + h * 128 + 8 * hi;
#pragma unroll
        for (int s = 0; s < 8; ++s) qf[s] = *(const f16x8*)(qp + 16 * s);
    }
    __builtin_amdgcn_sched_barrier(0);
    f32x16 sb[8];
#pragma unroll
    for (int kb = 0; kb < 8; ++kb) {
        f32x16 a = {0.f, 0.f, 0.f, 0.f, 0.f, 0.f, 0.f, 0.f, 0.f, 0.f, 0.f, 0.f, 0.f, 0.f, 0.f, 0.f};
        const int key = kb * 32 + c31;
#pragma unroll
        for (int s = 0; s < 8; ++s) {
            const f16x8 kf = *(const LAS f16x8*)(lds + ATT_K_OFF + key * 256 + (((2 * s + hi) ^ (key & 15)) << 4));
            a = __builtin_amdgcn_mfma_f32_32x32x16_f16(kf, qf[s], a, 0, 0, 0);
        }
        sb[kb] = a;
    }
    __builtin_amdgcn_sched_barrier(0);
    float mx = -3.0e38f;
#pragma unroll
    for (int kb = 0; kb < 8; ++kb)
#pragma unroll
        for (int r = 0; r < 16; ++r) mx = fmaxf(mx, sb[kb][r]);
    mx = fmaxf(mx, __shfl_xor(mx, 32));
    const float c2 = 0.08838834764831845f * 1.4426950408889634f;
    const float mc = mx * c2;
    float l = 0.f;
    f16x8 pa[16];
#pragma unroll
    for (int kb = 0; kb < 8; ++kb)
#pragma unroll
        for (int s = 0; s < 2; ++s) {
#pragma unroll
            for (int j = 0; j < 8; ++j) { const float p = __builtin_amdgcn_exp2f(sb[kb][8 * s + j] * c2 - mc); l += p; pa[kb * 2 + s][j] = (_Float16)p; }
        }
    l += __shfl_xor(l, 32);
    LAS float* wsf = (LAS float*)(lds + ATT_WS_OFF) + wave * 32;
    if (hi == 0) wsf[c31] = l;
    __builtin_amdgcn_sched_barrier(0);
    f32x16 o[4];
#pragma unroll
    for (int db = 0; db < 4; ++db) o[db] = (f32x16){0.f, 0.f, 0.f, 0.f, 0.f, 0.f, 0.f, 0.f, 0.f, 0.f, 0.f, 0.f, 0.f, 0.f, 0.f, 0.f};
    const unsigned vbase = ATT_V_OFF + c31 * 512; const int m = c31 << 3;
#pragma unroll
    for (int ks = 0; ks < 16; ++ks) {
        const int kbyte = 32 * ks + 8 * hi;
#pragma unroll
        for (int db = 0; db < 4; ++db) {
            const f16x4 v0 = *(const LAS f16x4*)(lds + vbase + db * 16384 + (kbyte ^ m));
            const f16x4 v1 = *(const LAS f16x4*)(lds + vbase + db * 16384 + ((kbyte + 16) ^ m));
            const f16x8 vf = {v0[0], v0[1], v0[2], v0[3], v1[0], v1[1], v1[2], v1[3]};
            o[db] = __builtin_amdgcn_mfma_f32_32x32x16_f16(pa[ks], vf, o[db], 0, 0, 0);
        }
    }
    __builtin_amdgcn_sched_barrier(0);
    LDS_WAIT();
    half_t* op = CAT16 + (size_t)tok0 * 1536 + 1024 + h * 128 + c31;
#pragma unroll
    for (int r = 0; r < 16; ++r) {
        const int q = crow(r, hi);
        const float rl = __builtin_amdgcn_rcpf(wsf[q]);
#pragma unroll
        for (int db = 0; db < 4; ++db) op[(size_t)q * 1536 + db * 32] = (_Float16)(o[db][r] * rl);
    }
    __syncthreads();
}

constexpr int SP_VT_OFF = 0, SP_W_OFF = 32768, SP_RS_OFF = 65536;
__device__ __forceinline__ void spatial_unit(LAS unsigned char* lds, const half_t* __restrict__ PROJ16, const float* __restrict__ w_sp, const float* __restrict__ b_sp, const float* __restrict__ g_sgu,
                                             half_t* CAT16, int bc, int h, int tid, int wave, int lane) {
    asm volatile("" : "+v"(tid), "+v"(lane));
    const int tok0 = bc * CHUNK;
    LAS float* rs = (LAS float*)(lds + SP_RS_OFF);
#pragma unroll 4
    for (int i = 0; i < 16; ++i) {
        const int s = wave * 16 + i;
        const f16x8 v = *(const f16x8*)(PROJ16 + (size_t)(tok0 + s) * INC + 1024 + lane * 8);
        float q = 0.f;
#pragma unroll
        for (int j = 0; j < 8; ++j) { const float f = (float)v[j]; q += f * f; }
        q = wave_sum(q);
        if (lane == 0) rs[s] = 1.0f / sqrtf(q * (1.f / 512.f) + EPS);
    }
#pragma unroll
    for (int it = 0; it < 4; ++it) {
        const int idx = it * 512 + tid, s = idx >> 4, ch = idx & 15;
        const f16x8 v = *(const f16x8*)(PROJ16 + (size_t)(tok0 + s) * INC + 1024 + h * SHD + ch * 8);
#pragma unroll
        for (int j = 0; j < 8; ++j) { const int d = ch * 8 + j;
            *(LAS half_t*)(lds + SP_VT_OFF + d * 256 + ((((s >> 3) ^ (d & 15)) << 4) | ((s & 7) << 1))) = v[j]; }
    }
    __syncthreads();
#pragma unroll
    for (int it = 0; it < 8; ++it) {
        const int idx = it * 512 + tid, t = idx >> 5, s4 = (idx & 31) * 4;
        const f32x4 w = *(const f32x4*)(w_sp + ((size_t)h * CHUNK + t) * CHUNK + s4);
        const f32x4 r4 = *(const LAS f32x4*)(rs + s4);
        const float w0 = (s4 + 0 <= t) ? w[0] * r4[0] : 0.f, w1 = (s4 + 1 <= t) ? w[1] * r4[1] : 0.f, w2 = (s4 + 2 <= t) ? w[2] * r4[2] : 0.f, w3 = (s4 + 3 <= t) ? w[3] * r4[3] : 0.f;
        u32x2 o; o.x = pk_h2(w0, w1); o.y = pk_h2(w2, w3);
        *(LAS u32x2*)(lds + SP_W_OFF + t * 256 + ((((s4 >> 3) ^ (t & 15)) << 4) | ((s4 & 7) << 1))) = o;
    }
    __syncthreads();
    const int c31 = lane & 31, hi = lane >> 5, tb = wave >> 1, dh = wave & 1;
    f32x16 acc[2];
    acc[0] = (f32x16){0.f, 0.f, 0.f, 0.f, 0.f, 0.f, 0.f, 0.f, 0.f, 0.f, 0.f, 0.f, 0.f, 0.f, 0.f, 0.f}; acc[1] = acc[0];
    const int t = tb * 32 + c31;
    const int nks = 2 * (tb + 1);
    for (int ks = 0; ks < nks; ++ks) {
        const f16x8 wf = *(const LAS f16x8*)(lds + SP_W_OFF + t * 256 + (((2 * ks + hi) ^ (t & 15)) << 4));
#pragma unroll
        for (int q = 0; q < 2; ++q) {
            const int d = (2 * dh + q) * 32 + c31;
            const f16x8 vf = *(const LAS f16x8*)(lds + SP_VT_OFF + d * 256 + (((2 * ks + hi) ^ (d & 15)) << 4));
            acc[q] = __builtin_amdgcn_mfma_f32_32x32x16_f16(vf, wf, acc[q], 0, 0, 0);
        }
    }
    const float bias = b_sp[h * CHUNK + t];
    const half_t* up = PROJ16 + (size_t)(tok0 + t) * INC + 512 + h * SHD;
    half_t* op = CAT16 + (size_t)(tok0 + t) * 1536 + 512 + h * SHD;
#pragma unroll
    for (int q = 0; q < 2; ++q)
#pragma unroll
        for (int rg = 0; rg < 4; ++rg) {
            const int d = (2 * dh + q) * 32 + 8 * rg + 4 * hi;
            const f16x4 u = *(const f16x4*)(up + d);
            const f32x4 g = *(const f32x4*)(g_sgu + h * SHD + d);
            u32x2 o;
            o.x = pk_h2((float)u[0] * (g[0] * acc[q][4 * rg + 0] + bias), (float)u[1] * (g[1] * acc[q][4 * rg + 1] + bias));
            o.y = pk_h2((float)u[2] * (g[2] * acc[q][4 * rg + 2] + bias), (float)u[3] * (g[3] * acc[q][4 * rg + 3] + bias));
            *(u32x2*)(op + d) = o;
        }
    __syncthreads();
}

constexpr int SL = 32, NCH = T / SL;
struct SsmTabs { half_t* ktab; half_t* et; half_t* ft; float* xend; half_t* xin; };

__device__ __forceinline__ void ssm_tables_item(LAS unsigned char* lds, const float* lam_re, const float* lam_im, const float* log_dt, const float* b_re, const float* b_im,
                                                const float* c_re, const float* c_im, const float* d_skip, const SsmTabs& tb, int g, int tid) {
    LAS f32x2* pw = (LAS f32x2*)lds; LAS f32x2* bb = pw + 33 * 64; LAS f32x2* cc = bb + 64 * 16;
    const float dt = expf(log_dt[g]); const float idt = 1.0f / dt;
    {
        const int p = tid & 63, part = tid >> 6;
        const float are = lam_re[g * NP + p], aim = lam_im[g * NP + p];
#pragma unroll 1
        for (int k = part; k <= 32; k += 8) {
            const double ang = (double)aim * (double)dt * (double)k;
            const float e = expf(are * dt * (float)k);
            pw[k * 64 + p] = (f32x2){e * (float)cos(ang), e * (float)sin(ang)};
        }
        const double ang1 = (double)aim * (double)dt;
        const float e1 = expf(are * dt); const float lr = e1 * (float)cos(ang1), li = e1 * (float)sin(ang1);
        const float nr = lr - 1.f, ni = li, den = are * are + aim * aim;
        const float fr = (nr * are + ni * aim) / den * idt, fi = (ni * are - nr * aim) / den * idt;
#pragma unroll
        for (int q = 0; q < 2; ++q) { const int h = part * 2 + q; const float br = b_re[(g * NP + p) * SG + h], bi = b_im[(g * NP + p) * SG + h];
            bb[p * 16 + h] = (f32x2){fr * br - fi * bi, fr * bi + fi * br}; }
#pragma unroll
        for (int q = 0; q < 2; ++q) { const int i = tid * 2 + q; cc[i] = (f32x2){c_re[g * 1024 + i], c_im[g * 1024 + i]}; }
    }
    __syncthreads();
    half_t* kt = tb.ktab + (size_t)g * 33 * 256;
    if (tid < 256) kt[tid] = (_Float16)0.f;
#pragma unroll 1
    for (int j = 0; j < 16; ++j) {
        const int idx = j * 512 + tid, lag = idx >> 8, h = (idx >> 4) & 15, h2 = idx & 15;
        float acc = 0.f;
#pragma unroll 4
        for (int p = 0; p < 64; ++p) {
            const f32x2 c = cc[h * 64 + p], w = pw[lag * 64 + p], b = bb[p * 16 + h2];
            const float zr = c.x * w.x - c.y * w.y, zi = c.x * w.y + c.y * w.x;
            acc += zr * b.x - zi * b.y;
        }
        if (lag == 0 && h == h2) acc += d_skip[g * SG + h] * idt;
        kt[(lag + 1) * 256 + h * 16 + h2] = (_Float16)acc;
    }
    half_t* et = tb.et + (size_t)g * 128 * 512;
#pragma unroll 2
    for (int j = 0; j < 32; ++j) {
        const int idx = j * 512 + tid, hp = idx & 7, s = (idx >> 3) & 31, p = idx >> 8;
        const f32x2 w = pw[(31 - s) * 64 + p], b0 = bb[p * 16 + hp * 2], b1 = bb[p * 16 + hp * 2 + 1];
        *(unsigned*)(et + (size_t)p * 512 + s * 16 + hp * 2) = pk_h2(w.x * b0.x - w.y * b0.y, w.x * b1.x - w.y * b1.y);
        *(unsigned*)(et + (size_t)(64 + p) * 512 + s * 16 + hp * 2) = pk_h2(w.x * b0.y + w.y * b0.x, w.x * b1.y + w.y * b1.x);
    }
    half_t* ft = tb.ft + (size_t)g * 512 * 128;
#pragma unroll 2
    for (int j = 0; j < 32; ++j) {
        const int idx = j * 512 + tid, pp = idx & 31, h = (idx >> 5) & 15, t = idx >> 9;
        const f32x2 c0 = cc[h * 64 + pp * 2], c1 = cc[h * 64 + pp * 2 + 1], w0 = pw[(t + 1) * 64 + pp * 2], w1 = pw[(t + 1) * 64 + pp * 2 + 1];
        *(unsigned*)(ft + (size_t)(t * 16 + h) * 128 + pp * 2) = pk_h2(c0.x * w0.x - c0.y * w0.y, c1.x * w1.x - c1.y * w1.y);
        *(unsigned*)(ft + (size_t)(t * 16 + h) * 128 + 64 + pp * 2) = pk_h2(-(c0.x * w0.y + c0.y * w0.x), -(c1.x * w1.y + c1.y * w1.x));
    }
    __syncthreads();
}

__device__ __forceinline__ void ssm_pass1_item(const half_t* __restrict__ PROJ16, const SsmTabs& tb, int g, int q, int cbk, int lane) {
    asm volatile("" : "+v"(lane));
    const int c31 = lane & 31, hi = lane >> 5;
    const half_t* ap = tb.et + ((size_t)g * 128 + cbk * 32 + c31) * 512 + 8 * hi;
    const half_t* bp = PROJ16 + (size_t)((q * 32 + c31) * SL) * INC + g * SG + 8 * hi;
    f32x16 acc = {0.f, 0.f, 0.f, 0.f, 0.f, 0.f, 0.f, 0.f, 0.f, 0.f, 0.f, 0.f, 0.f, 0.f, 0.f, 0.f};
#pragma unroll 8
    for (int ks = 0; ks < 32; ++ks) {
        const f16x8 a = *(const f16x8*)(ap + 16 * ks);
        const f16x8 b = *(const f16x8*)(bp + (size_t)ks * INC);
        acc = __builtin_amdgcn_mfma_f32_32x32x16_f16(a, b, acc, 0, 0, 0);
    }
    float* xp = tb.xend + ((size_t)g * NCH + q * 32 + c31) * 128 + cbk * 32 + 4 * hi;
#pragma unroll
    for (int rg = 0; rg < 4; ++rg) *(f32x4*)(xp + 8 * rg) = (f32x4){acc[4 * rg], acc[4 * rg + 1], acc[4 * rg + 2], acc[4 * rg + 3]};
}

__device__ __forceinline__ void ssm_scan_thread(const float* lam_re, const float* lam_im, const float* log_dt, const SsmTabs& tb, int seq) {
    const int p = seq & 63, g = (seq >> 6) & 31, b = seq >> 11;
    const float are = lam_re[g * NP + p], aim = lam_im[g * NP + p];
    const float dt = expf(log_dt[g]);
    const double ang = (double)aim * (double)dt * 32.0;
    const float e = expf(are * dt * 32.f);
    const float Lr = e * (float)cos(ang), Li = e * (float)sin(ang);
    const float* xe = tb.xend + ((size_t)g * NCH + b * 128) * 128 + p;
    half_t* xi = tb.xin + ((size_t)g * NCH + b * 128) * 128 + p;
    float cr = 0.f, ci = 0.f;
    for (int c0 = 0; c0 < 128; c0 += 8) {
        float er[8], ei[8];
#pragma unroll
        for (int j = 0; j < 8; ++j) { er[j] = xe[(size_t)(c0 + j) * 128]; ei[j] = xe[(size_t)(c0 + j) * 128 + 64]; }
#pragma unroll
        for (int j = 0; j < 8; ++j) {
            xi[(size_t)(c0 + j) * 128] = (_Float16)cr; xi[(size_t)(c0 + j) * 128 + 64] = (_Float16)ci;
            const float nr = Lr * cr - Li * ci + er[j], ni = Lr * ci + Li * cr + ei[j];
            cr = nr; ci = ni;
        }
    }
}

__device__ __forceinline__ void ssm_pass2_item(const half_t* __restrict__ PROJ16, const SsmTabs& tb, const float* log_dt, half_t* YSG16, int g, int q, int qq, int lane) {
    asm volatile("" : "+v"(lane));
    const int c31 = lane & 31, hi = lane >> 5;
    const int cbs[4] = {qq, 7 - qq, 8 + qq, 15 - qq};
    const int tl = c31 >> 4, h = c31 & 15;
    const half_t* kt = tb.ktab + (size_t)g * 33 * 256 + h * 16 + 8 * hi;
    const half_t* bp = PROJ16 + (size_t)((q * 32 + c31) * SL) * INC + g * SG + 8 * hi;
    f32x16 acc[4];
#pragma unroll
    for (int j = 0; j < 4; ++j) acc[j] = (f32x16){0.f, 0.f, 0.f, 0.f, 0.f, 0.f, 0.f, 0.f, 0.f, 0.f, 0.f, 0.f, 0.f, 0.f, 0.f, 0.f};
#pragma unroll 2
    for (int ks = 0; ks < 32; ++ks) {
        const f16x8 b = *(const f16x8*)(bp + (size_t)ks * INC);
#pragma unroll
        for (int j = 0; j < 4; ++j) {
            if (2 * cbs[j] + 1 >= ks) {
                const int lag = 2 * cbs[j] + tl - ks;
                const f16x8 a = *(const f16x8*)(kt + (lag + 1) * 256);
                acc[j] = __builtin_amdgcn_mfma_f32_32x32x16_f16(a, b, acc[j], 0, 0, 0);
            }
        }
    }
    const half_t* xp = tb.xin + ((size_t)g * NCH + q * 32 + c31) * 128 + 8 * hi;
#pragma unroll 2
    for (int kk = 0; kk < 8; ++kk) {
        const f16x8 b = *(const f16x8*)(xp + 16 * kk);
#pragma unroll
        for (int j = 0; j < 4; ++j) {
            const f16x8 a = *(const f16x8*)(tb.ft + ((size_t)g * 512 + cbs[j] * 32 + c31) * 128 + 16 * kk + 8 * hi);
            acc[j] = __builtin_amdgcn_mfma_f32_32x32x16_f16(a, b, acc[j], 0, 0, 0);
        }
    }
    const float dt = expf(log_dt[g]);
    half_t* yp = YSG16 + (size_t)((q * 32 + c31) * SL) * SSMW + g * SG;
#pragma unroll
    for (int j = 0; j < 4; ++j)
#pragma unroll
        for (int rg = 0; rg < 4; ++rg) {
            const int t = 2 * cbs[j] + (rg >> 1), hh = 8 * (rg & 1) + 4 * hi;
            u32x2 o; o.x = pk_h2(fast_gelu(dt * acc[j][4 * rg]), fast_gelu(dt * acc[j][4 * rg + 1])); o.y = pk_h2(fast_gelu(dt * acc[j][4 * rg + 2]), fast_gelu(dt * acc[j][4 * rg + 3]));
            *(u32x2*)(yp + (size_t)t * SSMW + hh) = o;
        }
}

constexpr int MOE_TILES_OFF = RING_BYTES + 4096, MOE_NT_OFF = RING_BYTES + 4096 + 4096, MOE_MAXTILES = 256;
typedef int i32x4 __attribute__((ext_vector_type(4)));
struct RouteBufs { int* eid; float* ew; int* posOf; float* rsT; float* rsrow; int* wghist; const half_t* wrt_hi; const half_t* wrt_lo; };

__device__ __forceinline__ void route_block(LAS unsigned char* lds, const float* __restrict__ H32, const RouteBufs& rb, const float* b_group, const float* b_router, int tb, int tid, int wave, int lane) {
    asm volatile("" : "+v"(tid), "+v"(lane));
    LAS float* part = (LAS float*)lds;
    LAS float* lg   = (LAS float*)(lds + 32768);
    LAS float* rsl  = (LAS float*)(lds + 65536);
    LAS float* ssp  = (LAS float*)(lds + 65536 + 256);
    LAS int*   hist = (LAS int*)(lds + 65536 + 512);
    if (tid < 64) hist[tid] = 0;
    const int it = wave >> 1, kh = wave & 1, fr = lane & 15, fq = lane >> 4;
    const int tok0 = tb * 64 + it * 16;
    const float* hp = H32 + (size_t)(tok0 + fr) * DM + kh * 512 + 8 * fq;
    const half_t* wh = rb.wrt_hi + (size_t)fr * DM + kh * 512 + 8 * fq;
    const half_t* wl = rb.wrt_lo + (size_t)fr * DM + kh * 512 + 8 * fq;
    f32x4 acc[5];
#pragma unroll
    for (int nb = 0; nb < 5; ++nb) acc[nb] = (f32x4){0.f, 0.f, 0.f, 0.f};
    float ss = 0.f;
#pragma unroll 2
    for (int ks = 0; ks < 16; ++ks) {
        const f32x4 v0 = *(const f32x4*)(hp + 32 * ks), v1 = *(const f32x4*)(hp + 32 * ks + 4);
        f16x8 xh, xl;
#pragma unroll
        for (int j = 0; j < 4; ++j) { ss += v0[j] * v0[j] + v1[j] * v1[j];
            xh[j] = (_Float16)v0[j]; xl[j] = (_Float16)(v0[j] - (float)xh[j]); xh[4 + j] = (_Float16)v1[j]; xl[4 + j] = (_Float16)(v1[j] - (float)xh[4 + j]); }
#pragma unroll
        for (int nb = 0; nb < 5; ++nb) {
            const f16x8 bh = *(const f16x8*)(wh + (size_t)nb * 16 * DM + 32 * ks), bl = *(const f16x8*)(wl + (size_t)nb * 16 * DM + 32 * ks);
            acc[nb] = __builtin_amdgcn_mfma_f32_16x16x32_f16(xh, bh, acc[nb], 0, 0, 0);
            acc[nb] = __builtin_amdgcn_mfma_f32_16x16x32_f16(xh, bl, acc[nb], 0, 0, 0);
            acc[nb] = __builtin_amdgcn_mfma_f32_16x16x32_f16(xl, bh, acc[nb], 0, 0, 0);
        }
    }
    ss += __shfl_xor(ss, 16); ss += __shfl_xor(ss, 32);
    if (kh == 1) {
        LAS float* pp = part + (it * 64 + lane) * 24;
#pragma unroll
        for (int nb = 0; nb < 5; ++nb) *(LAS f32x4*)(pp + 4 * nb) = acc[nb];
        if (fq == 0) ssp[it * 16 + fr] = ss;
    }
    __syncthreads();
    if (kh == 0) {
        const LAS float* pp = part + (it * 64 + lane) * 24;
#pragma unroll
        for (int nb = 0; nb < 5; ++nb) acc[nb] += *(const LAS f32x4*)(pp + 4 * nb);
        if (fq == 0) { const float tot = ss + ssp[it * 16 + fr]; const float rs = 1.0f / sqrtf(tot * (1.f / 1024.f) + EPS); rsl[it * 16 + fr] = rs; rb.rsT[tok0 + fr] = rs; }
        LDS_WAIT();
#pragma unroll
        for (int nb = 0; nb < 5; ++nb) {
            const int n = nb * 16 + fr;
            const float bias = (n < 64) ? b_router[n] : ((n < 72) ? b_group[n - 64] : 0.f);
#pragma unroll
            for (int r = 0; r < 4; ++r) { const int tk = 4 * fq + r; lg[(it * 16 + tk) * 80 + n] = acc[nb][r] * rsl[it * 16 + tk] * (1.f / 64.f) + bias; }
        }
        LDS_WAIT();
        if (lane < 16) {
            const LAS float* l = lg + (it * 16 + lane) * 80;
            int gi = 0; float gm = l[64];
#pragma unroll
            for (int g = 1; g < 8; ++g) { const float v = l[64 + g]; if (v > gm) { gm = v; gi = g; } }
            float den = 0.f;
#pragma unroll
            for (int g = 0; g < 8; ++g) den += expf(l[64 + g] - gm);
            const float gw = 1.f / den;
            const LAS float* el = l + gi * 8;
            int i0 = 0; float v0 = el[0];
#pragma unroll
            for (int e = 1; e < 8; ++e) { const float v = el[e]; if (v > v0) { v0 = v; i0 = e; } }
            int i1 = -1; float v1 = -3.0e38f;
#pragma unroll
            for (int e = 0; e < 8; ++e) { const float v = el[e]; if (e != i0 && v > v1) { v1 = v; i1 = e; } }
            const float w0 = 1.f / (1.f + expf(v1 - v0)), w1 = 1.f - w0;
            const int e0 = gi * 8 + i0, e1 = gi * 8 + i1, tok = tok0 + lane;
            rb.eid[tok * 2] = e0; rb.eid[tok * 2 + 1] = e1;
            rb.ew[tok * 2] = gw * w0; rb.ew[tok * 2 + 1] = gw * w1;
            __hip_atomic_fetch_add(&hist[e0], 1, __ATOMIC_RELAXED, __HIP_MEMORY_SCOPE_WORKGROUP); __hip_atomic_fetch_add(&hist[e1], 1, __ATOMIC_RELAXED, __HIP_MEMORY_SCOPE_WORKGROUP);
        }
    }
    __syncthreads();
    if (tid < 64) rb.wghist[tb * 64 + tid] = hist[tid];
    __syncthreads();
}

__device__ __forceinline__ void gather_block(LAS unsigned char* lds, const float* __restrict__ H32, const RouteBufs& rb, half_t* XS16, int tb, bool do_rows, int tid, int wave, int lane) {
    asm volatile("" : "+v"(tid), "+v"(lane));
    LAS int* psumA = (LAS int*)lds;
    LAS int* psumP = psumA + 512;
    LAS int* base  = psumP + 512;
    LAS int* lcur  = base + 64;
    LAS i32x4* tiles = (LAS i32x4*)(lds + MOE_TILES_OFF);
    LAS int* ntl = (LAS int*)(lds + MOE_NT_OFF);
    {
        const int e = tid & 63, part = tid >> 6; int sa = 0, sp = 0;
#pragma unroll 4
        for (int w = part * 32; w < part * 32 + 32; ++w) { const int v = rb.wghist[w * 64 + e]; sa += v; sp += (w < tb) ? v : 0; }
        psumA[part * 64 + e] = sa; psumP[part * 64 + e] = sp;
    }
    __syncthreads();
    if (wave == 0) {
        int tot = 0, pre = 0;
#pragma unroll
        for (int p = 0; p < 8; ++p) { tot += psumA[p * 64 + lane]; pre += psumP[p * 64 + lane]; }
        const int nt = (tot + 255) >> 8;
        int rs_incl = tot, ts_incl = nt;
#pragma unroll
        for (int o = 1; o < 64; o <<= 1) { const int a = __shfl_up(rs_incl, o), b = __shfl_up(ts_incl, o); if (lane >= o) { rs_incl += a; ts_incl += b; } }
        const int rstart = rs_incl - tot, tstart = ts_incl - nt;
        base[lane] = rstart + pre; lcur[lane] = 0;
        for (int j = 0; j < nt; ++j) { const int rem = tot - 256 * j; if (tstart + j < MOE_MAXTILES) tiles[tstart + j] = (i32x4){lane, rstart + 256 * j, rem < 256 ? rem : 256, 0}; }
        if (lane == 63) ntl[0] = ts_incl < MOE_MAXTILES ? ts_incl : MOE_MAXTILES;
    }
    __syncthreads();
    if (do_rows) {
#pragma unroll 1
        for (int i = 0; i < 16; ++i) {
            const int a = wave * 16 + i, t = tb * 64 + (a >> 1), k = a & 1;
            const int e = rb.eid[t * 2 + k];
            int pos = 0;
            if (lane == 0) pos = base[e] + __hip_atomic_fetch_add(&lcur[e], 1, __ATOMIC_RELAXED, __HIP_MEMORY_SCOPE_WORKGROUP);
            pos = __builtin_amdgcn_readfirstlane(pos);
            if (lane == 0) { rb.posOf[t * 2 + k] = pos; rb.rsrow[pos] = rb.rsT[t]; }
            const float* hp = H32 + (size_t)t * DM + lane * 16;
            const f32x4 v0 = *(const f32x4*)hp, v1 = *(const f32x4*)(hp + 4), v2 = *(const f32x4*)(hp + 8), v3 = *(const f32x4*)(hp + 12);
            u32x4 o0, o1;
            o0.x = pk_h2(v0[0], v0[1]); o0.y = pk_h2(v0[2], v0[3]); o0.z = pk_h2(v1[0], v1[1]); o0.w = pk_h2(v1[2], v1[3]);
            o1.x = pk_h2(v2[0], v2[1]); o1.y = pk_h2(v2[2], v2[3]); o1.z = pk_h2(v3[0], v3[1]); o1.w = pk_h2(v3[2], v3[3]);
            half_t* xp = XS16 + (size_t)pos * DM + lane * 16;
            *(u32x4*)xp = o0; *(u32x4*)(xp + 8) = o1;
        }
    }
    __syncthreads();
}

__device__ __forceinline__ void final_token(const float* __restrict__ H32, const half_t* __restrict__ YS16, const RouteBufs& rb, const float* g_final, float* out, int tok, int lane) {
    const int p0 = rb.posOf[tok * 2], p1 = rb.posOf[tok * 2 + 1];
    const float w0 = rb.ew[tok * 2], w1 = rb.ew[tok * 2 + 1];
    f32x4 v[4]; float s = 0.f;
#pragma unroll
    for (int j = 0; j < 4; ++j) {
        const int c = 4 * lane + 256 * j;
        const f32x4 h = *(const f32x4*)(H32 + (size_t)tok * DM + c);
        const f16x4 a = *(const f16x4*)(YS16 + (size_t)p0 * DM + c), b = *(const f16x4*)(YS16 + (size_t)p1 * DM + c);
#pragma unroll
        for (int q = 0; q < 4; ++q) { v[j][q] = h[q] + (w0 * (float)a[q] + w1 * (float)b[q]); s += v[j][q] * v[j][q]; }
    }
    const float rs = 1.0f / sqrtf(wave_sum(s) * (1.f / 1024.f) + EPS);
#pragma unroll
    for (int j = 0; j < 4; ++j) { const int c = 4 * lane + 256 * j; const f32x4 g = *(const f32x4*)(g_final + c); *(f32x4*)(out + (size_t)tok * DM + c) = v[j] * rs * g; }
}

namespace pg {
struct OrderMoe {
    const LAS i32x4* tiles; int nunits, G, c; const char* A; size_t rowA; const char* B; size_t expB, tileB;
    __device__ bool next(int i, Unit& u) const {
        const int L = i * G + c; if (L >= nunits) return false;
        const i32x4 t = tiles[L >> 2];
        u.pm = t.y; u.pn = L & 3; u.aux = t.z;
        u.A = A + (size_t)t.y * rowA; u.B = B + (size_t)t.x * expB + (size_t)(L & 3) * tileB; return true;
    }
};
struct EpiUp {
    static constexpr bool PERM = true;
    half_t* O; const float* rsrow;
    __device__ __forceinline__ void operator()(const f32x4 (&acc)[2][2][4][2], const Unit& u, int wr, int wc, int fr, int fq) const {
        const int col0 = u.pn * HALF + wc * 32 + 8 * fq;
#pragma unroll
        for (int ai = 0; ai < 2; ++ai)
#pragma unroll
            for (int m = 0; m < 4; ++m) {
                const int rl = ai * HALF + wr * 64 + m * 16 + fr;
                if (rl < u.aux) {
                    const float rs = rsrow[u.pm + rl];
                    const f32x4 a0 = acc[ai][0][m][0] * rs, a1 = acc[ai][0][m][1] * rs, b0 = acc[ai][1][m][0] * rs, b1 = acc[ai][1][m][1] * rs;
                    u32x4 w; w.x = pk_h2(a0[0] * fast_sigmoid(a0[0]) * b0[0], a0[1] * fast_sigmoid(a0[1]) * b0[1]); w.y = pk_h2(a0[2] * fast_sigmoid(a0[2]) * b0[2], a0[3] * fast_sigmoid(a0[3]) * b0[3]);
                    w.z = pk_h2(a1[0] * fast_sigmoid(a1[0]) * b1[0], a1[1] * fast_sigmoid(a1[1]) * b1[1]); w.w = pk_h2(a1[2] * fast_sigmoid(a1[2]) * b1[2], a1[3] * fast_sigmoid(a1[3]) * b1[3]);
                    *(u32x4*)(O + (size_t)(u.pm + rl) * DFF + col0) = w; } }
    }
};
struct EpiDown {
    static constexpr bool PERM = true;
    half_t* O;
    __device__ __forceinline__ void operator()(const f32x4 (&acc)[2][2][4][2], const Unit& u, int wr, int wc, int fr, int fq) const {
        const int col0 = u.pn * BM + wc * 32 + 8 * fq;
#pragma unroll
        for (int ai = 0; ai < 2; ++ai)
#pragma unroll
            for (int m = 0; m < 4; ++m) {
                const int rl = ai * HALF + wr * 64 + m * 16 + fr;
                if (rl < u.aux) {
#pragma unroll
                    for (int bj = 0; bj < 2; ++bj) { const f32x4 v0 = acc[ai][bj][m][0], v1 = acc[ai][bj][m][1];
                        u32x4 w; w.x = pk_h2(v0[0], v0[1]); w.y = pk_h2(v0[2], v0[3]); w.z = pk_h2(v1[0], v1[1]); w.w = pk_h2(v1[2], v1[3]);
                        *(u32x4*)(O + (size_t)(u.pm + rl) * DM + col0 + bj * HALF) = w; } } }
    }
};
}

constexpr size_t MiB = 1u << 20;
constexpr int CW_BAR = 4096;
constexpr size_t WS_CTL = 0, CTL_ZERO_BYTES = 1 * MiB;
constexpr size_t WS_K16 = 1 * MiB, WS_VT16 = 2 * MiB, WS_KTAB = 3 * MiB;
constexpr size_t WS_ROUTE = 4 * MiB;
constexpr size_t WS_WRT = 5 * MiB;
constexpr size_t WS_MEMN16 = 6 * MiB;
constexpr size_t WS_ET = 8 * MiB, WS_FT = 12 * MiB, WS_XEND = 16 * MiB, WS_XIN = 24 * MiB;
constexpr size_t WS_WINT = 28 * MiB, WS_WGATET = 32 * MiB, WS_WGLUT = 38 * MiB, WS_WKVT = 39 * MiB, WS_WBRT = 41 * MiB, WS_WOUTT = 44 * MiB;
constexpr size_t WS_W13T = 46 * MiB, WS_W2T = 174 * MiB;
constexpr size_t WS_PROJ16 = 238 * MiB, WS_XS16 = 238 * MiB;
constexpr size_t WS_G16 = 303 * MiB, WS_YS16 = 303 * MiB;
constexpr size_t WS_N16 = 399 * MiB, WS_MERGED16 = 399 * MiB, WS_H16 = 399 * MiB;
constexpr size_t WS_CAT16 = 432 * MiB, WS_YSG16 = 480 * MiB, WS_H32 = 432 * MiB;
constexpr size_t WS_END = 496 * MiB;

struct Args { const float* in[32]; float* out; unsigned char* ws; int ph_lo, ph_hi, li, pad; };
struct Frame { LAS unsigned char* lds; volatile LAS unsigned* MISC; unsigned* ctl; int tid, lane, wave, vcu, G; };

__device__ __forceinline__ SsmTabs make_tabs(unsigned char* ws) { SsmTabs t; t.ktab = (half_t*)(ws + WS_KTAB); t.et = (half_t*)(ws + WS_ET); t.ft = (half_t*)(ws + WS_FT); t.xend = (float*)(ws + WS_XEND); t.xin = (half_t*)(ws + WS_XIN); return t; }
__device__ __forceinline__ RouteBufs make_route(unsigned char* ws) {
    RouteBufs r; unsigned char* b = ws + WS_ROUTE;
    r.eid = (int*)b; r.ew = (float*)(b + 131072); r.posOf = (int*)(b + 262144); r.rsT = (float*)(b + 393216); r.rsrow = (float*)(b + 458752); r.wghist = (int*)(b + 655360);
    r.wrt_hi = (const half_t*)(ws + WS_WRT); r.wrt_lo = (const half_t*)(ws + WS_WRT + 163840); return r;
}

__device__ __forceinline__ void p0_prologue(const Frame& F, const Args& a) {
    { const SsmTabs tb = make_tabs(a.ws);
      for (int g = F.vcu; g < NG; g += F.G) ssm_tables_item(F.lds, a.in[7], a.in[8], a.in[9], a.in[10], a.in[11], a.in[12], a.in[13], a.in[14], tb, g, F.tid); }
    LAS float* scr = (LAS float*)(F.lds + RING_OFF + F.wave * 16384);
    const int gw = F.vcu * NWAVES + F.wave, NGW = F.G * NWAVES;
    {
        half_t* whi = (half_t*)(a.ws + WS_WRT); half_t* wlo = (half_t*)(a.ws + WS_WRT + 163840);
        for (int idx = gw * 64 + F.lane; idx < 80 * DM; idx += NGW * 64) {
            const int n = idx >> 10, k = idx & 1023;
            float w = 0.f;
            if (n < 64) w = a.in[26][k * NE + n]; else if (n < 72) w = a.in[24][k * NGRP + (n - 64)];
            w *= 64.f * a.in[23][k];
            const _Float16 h = (_Float16)w; whi[idx] = h; wlo[idx] = (_Float16)(w - (float)h);
        }
    }
#pragma unroll 1
    for (int j = 0; j < 8; ++j) {
        const float* W; int ldw, K, N, mode = 0; half_t* WT;
        switch (j) {
            case 0: W = a.in[4];  ldw = INC;  K = DM;  N = INC;  WT = (half_t*)(a.ws + WS_WINT); break;
            case 1: W = a.in[20]; ldw = 1024; K = DM;  N = 1024; WT = (half_t*)(a.ws + WS_WKVT); break;
            case 2: W = a.in[5];  ldw = 3072; K = DM;  N = 3072; WT = (half_t*)(a.ws + WS_WGATET); break;
            case 3: W = a.in[15]; ldw = 1024; K = 512; N = 1024; WT = (half_t*)(a.ws + WS_WGLUT); mode = 1; break;
            case 4: W = a.in[21];                     ldw = 1024; K = 512; N = 1024; WT = (half_t*)(a.ws + WS_WBRT); break;
            case 5: W = a.in[21] + 512 * 1024;        ldw = 1024; K = 512; N = 1024; WT = (half_t*)(a.ws + WS_WBRT) + 1024 * 512; break;
            case 6: W = a.in[21] + 2 * 512 * 1024;    ldw = 1024; K = 512; N = 1024; WT = (half_t*)(a.ws + WS_WBRT) + 2 * 1024 * 512; break;
            default: W = a.in[22]; ldw = 1024; K = DM; N = 1024; WT = (half_t*)(a.ws + WS_WOUTT); break;
        }
        const int nblk = N / 32, items = (K / 64) * nblk;
#pragma unroll 1
        for (int it = gw; it < items; it += NGW) {
            const int kb = it / nblk, nb = it % nblk, n0 = nb * 32;
            int drow = n0;
            if (mode == 1) { const int half = n0 >> 9, jj = n0 & 511; drow = (jj >> 7) * 256 + half * 128 + (jj & 127); }
            transpose_item(W, ldw, kb * 64, n0, WT, K, drow, scr, F.lane);
        }
    }
    half_t* MEMN16 = (half_t*)(a.ws + WS_MEMN16);
    for (int m = gw; m < MROWS; m += NGW) rms_row_to_f16(a.in[1] + (size_t)m * DM, a.in[3], MEMN16 + (size_t)m * DM, F.lane);
    half_t* N16 = (half_t*)(a.ws + WS_N16);
    for (int m = gw; m < T; m += NGW) rms_row_to_f16(a.in[0] + (size_t)m * DM, a.in[2], N16 + (size_t)m * DM, F.lane);
    {
        half_t* W13T = (half_t*)(a.ws + WS_W13T); half_t* W2T = (half_t*)(a.ws + WS_W2T);
#pragma unroll 1
        for (int it = gw; it < NE * 768; it += NGW) {
            const int e = it / 768, r = it % 768, which = r >> 8, q = r & 255;
            if (which < 2) {
                const int kb = q >> 4, nb = q & 15, n0 = nb * 32;
                const float* W = (which == 0 ? a.in[28] : a.in[29]) + (size_t)e * DM * DFF;
                transpose_item(W, DFF, kb * 64, n0, W13T + (size_t)e * 1024 * 1024, 1024, (n0 >> 7) * 256 + which * 128 + (n0 & 127), scr, F.lane, a.in[23]);
            } else {
                const int kb = q >> 5, nb = q & 31, n0 = nb * 32;
                transpose_item(a.in[30] + (size_t)e * DFF * DM, DM, kb * 64, n0, W2T + (size_t)e * 1024 * 512, 512, n0, scr, F.lane);
            }
        }
    }
}

__global__ void __launch_bounds__(NWAVES * 64, 2) mk_fwd(Args args) {
    extern __shared__ __attribute__((aligned(16))) unsigned char lds[];
    Frame F;
    F.lds = (LAS unsigned char*)lds;
    F.MISC = (volatile LAS unsigned*)(F.lds + MISC_OFF);
    F.tid = threadIdx.x; F.lane = F.tid & 63; F.wave = __builtin_amdgcn_readfirstlane(F.tid >> 6);
    F.G = gridDim.x; { const int bx = blockIdx.x; F.vcu = (F.G % 8 == 0) ? (bx % 8) * (F.G / 8) + bx / 8 : bx; }
    F.ctl = (unsigned*)(args.ws + WS_CTL);
    for (int u = F.tid; u < (LDS_BYTES - LDSCTL_OFF) / 4; u += NWAVES * 64) ((LAS unsigned*)(F.lds + LDSCTL_OFF))[u] = 0u;
    __syncthreads();
    XcdBarrier bar = xcd_barrier_post(F.ctl + CW_BAR + args.li * XCD_BAR_WORDS, F.MISC + 8);
    const int lo = args.ph_lo, hi = args.ph_hi;
    unsigned char* ws = args.ws;
    const int gw = F.vcu * NWAVES + F.wave, NGW = F.G * NWAVES;
#define IN(k) (lo <= (k) && (k) < hi)
#define BOTH(k) (IN(k) && IN((k) + 1))
    if (IN(0)) { p0_prologue(F, args); if (BOTH(0)) xcd_barrier(bar); }
    if (IN(1)) {
        pg::OrderMN S; S.init(T, INC, F.G, (int)blockIdx.x, ws + WS_N16, DM, ws + WS_WINT, DM);
        pg::EpiProj E{(half_t*)(ws + WS_PROJ16), INC};
        pg::gemm_phase<pg::EpiProj, pg::OrderMN, true, true>(F.lds + RING_OFF, DM, DM, DM / 64, S, E);
        for (int t = F.vcu; t < 256; t += F.G) kv_tile((const half_t*)(ws + WS_MEMN16), (const half_t*)(ws + WS_WKVT), (half_t*)(ws + WS_K16), (half_t*)(ws + WS_VT16), t, F.wave, F.lane);
        if (BOTH(1)) xcd_barrier(bar);
    }
    if (IN(2)) {
        const SsmTabs tb = make_tabs(ws);
        for (int gwi = gw; gwi < 2048; gwi += NGW) ssm_pass1_item((const half_t*)(ws + WS_PROJ16), tb, gwi >> 6, (gwi >> 2) & 15, gwi & 3, F.lane);
        if (BOTH(2)) xcd_barrier(bar);
    }
    if (IN(3)) {
        { const SsmTabs tb = make_tabs(ws);
          for (int sq = F.vcu * 512 + F.tid; sq < BATCH * NG * NP; sq += F.G * 512) ssm_scan_thread(args.in[7], args.in[8], args.in[9], tb, sq); }
        for (int u = F.vcu; u < 256; u += F.G)
            attn_unit(F.lds, (const half_t*)(ws + WS_PROJ16), (const half_t*)(ws + WS_K16), (const half_t*)(ws + WS_VT16), (half_t*)(ws + WS_CAT16), (u >> 4) >> 2, (u >> 4) & 3, u & 15, F.tid, F.wave, F.lane);
        for (int u = F.vcu; u < 512; u += F.G)
            spatial_unit(F.lds, (const half_t*)(ws + WS_PROJ16), args.in[18], args.in[19], args.in[17], (half_t*)(ws + WS_CAT16), u >> 2, u & 3, F.tid, F.wave, F.lane);
        if (BOTH(3)) xcd_barrier(bar);
    }
    if (IN(4)) {
        const SsmTabs tb = make_tabs(ws);
        for (int gwi = gw; gwi < 2048; gwi += NGW) ssm_pass2_item((const half_t*)(ws + WS_PROJ16), tb, args.in[9], (half_t*)(ws + WS_YSG16), gwi >> 6, (gwi >> 2) & 15, gwi & 3, F.lane);
        if (BOTH(4)) xcd_barrier(bar);
    }
    if (IN(5)) {
        { pg::OrderMN S; S.init(T, 1024, F.G, (int)blockIdx.x, ws + WS_YSG16, 512, ws + WS_WGLUT, 512);
          pg::EpiGlu E{(half_t*)(ws + WS_CAT16), 1536, args.in[16]};
          pg::gemm_phase<pg::EpiGlu, pg::OrderMN, true, true>(F.lds + RING_OFF, 512, 512, 8, S, E); }
        { pg::OrderMN S; S.init(T, 3072, F.G, (int)blockIdx.x, ws + WS_N16, DM, ws + WS_WGATET, DM);
          pg::EpiGate E{(half_t*)(ws + WS_G16), 3072, args.in[6]};
          pg::gemm_phase<pg::EpiGate, pg::OrderMN, true, true>(F.lds + RING_OFF, DM, DM, 16, S, E); }
        if (BOTH(5)) xcd_barrier(bar);
    }
    if (IN(6)) {
        pg::OrderBr S; S.init(F.G, (int)blockIdx.x, ws + WS_CAT16, ws + WS_WBRT);
        pg::EpiBranch E{(half_t*)(ws + WS_MERGED16), (const half_t*)(ws + WS_G16)};
        pg::gemm_phase<pg::EpiBranch, pg::OrderBr, true, true>(F.lds + RING_OFF, 1536, 512, 8, S, E);
        if (BOTH(6)) xcd_barrier(bar);
    }
    if (IN(7)) {
        pg::OrderMN S; S.init(T, 1024, F.G, (int)blockIdx.x, ws + WS_MERGED16, DM, ws + WS_WOUTT, DM);
        pg::EpiOut E{(float*)(ws + WS_H32), args.in[0], DM};
        pg::gemm_phase<pg::EpiOut, pg::OrderMN, true, true>(F.lds + RING_OFF, DM, DM, 16, S, E);
        if (BOTH(7)) xcd_barrier(bar);
    }
    if (IN(8)) {
        const RouteBufs rb = make_route(ws);
        for (int tb = F.vcu; tb < 256; tb += F.G) route_block(F.lds, (const float*)(ws + WS_H32), rb, args.in[25], args.in[27], tb, F.tid, F.wave, F.lane);
        if (BOTH(8)) xcd_barrier(bar);
    }
    if (IN(9)) {
        const RouteBufs rb = make_route(ws);
        bool any = false;
        for (int tb = F.vcu; tb < 256; tb += F.G) { gather_block(F.lds, (const float*)(ws + WS_H32), rb, (half_t*)(ws + WS_XS16), tb, true, F.tid, F.wave, F.lane); any = true; }
        if (!any) gather_block(F.lds, (const float*)(ws + WS_H32), rb, (half_t*)(ws + WS_XS16), 0, false, F.tid, F.wave, F.lane);
        if (BOTH(9)) xcd_barrier(bar);
    }
    if (IN(10)) {
        const RouteBufs rb = make_route(ws);
        pg::OrderMoe S{(const LAS i32x4*)(F.lds + MOE_TILES_OFF), 4 * *(const LAS int*)(F.lds + MOE_NT_OFF), F.G, (int)blockIdx.x, (const char*)(ws + WS_XS16), (size_t)DM * 2, (const char*)(ws + WS_W13T), (size_t)1024 * 1024 * 2, (size_t)256 * 1024 * 2};
        pg::EpiUp E{(half_t*)(ws + WS_H16), rb.rsrow};
        pg::gemm_phase<pg::EpiUp, pg::OrderMoe, true, true>(F.lds + RING_OFF, DM, DM, 16, S, E);
        if (BOTH(10)) xcd_barrier(bar);
    }
    if (IN(11)) {
        pg::OrderMoe S{(const LAS i32x4*)(F.lds + MOE_TILES_OFF), 4 * *(const LAS int*)(F.lds + MOE_NT_OFF), F.G, (int)blockIdx.x, (const char*)(ws + WS_H16), (size_t)DFF * 2, (const char*)(ws + WS_W2T), (size_t)1024 * 512 * 2, (size_t)256 * 512 * 2};
        pg::EpiDown E{(half_t*)(ws + WS_YS16)};
        pg::gemm_phase<pg::EpiDown, pg::OrderMoe, true, true>(F.lds + RING_OFF, DFF, DFF, 8, S, E);
        if (BOTH(11)) xcd_barrier(bar);
    }
    if (IN(12)) {
        const RouteBufs rb = make_route(ws);
        for (int tok = gw; tok < T; tok += NGW) final_token((const float*)(ws + WS_H32), (const half_t*)(ws + WS_YS16), rb, args.in[31], args.out, tok, F.lane);
    }
#undef IN
#undef BOTH
}

extern "C" void kernel_launch(void* const* d_in, const int* in_sizes, int n_in, void* d_out, int out_size, void* d_ws, size_t ws_size, hipStream_t stream) {
    static int grid = 0;
    if (grid == 0) {
        if (n_in != 32 || ws_size < WS_END) { fprintf(stderr, "kernel_launch: unexpected inputs (n_in %d, ws %zu)\n", n_in, ws_size); grid = -1; return; }
        int dev = 0, cus = 0;
        if (hipGetDevice(&dev) != hipSuccess || hipDeviceGetAttribute(&cus, hipDeviceAttributeMultiprocessorCount, dev) != hipSuccess) { grid = -1; return; }
        if (hipFuncSetAttribute((const void*)mk_fwd, hipFuncAttributeMaxDynamicSharedMemorySize, LDS_BYTES) != hipSuccess) { grid = -1; return; }
        int per_cu = 0;
        (void)hipOccupancyMaxActiveBlocksPerMultiprocessor(&per_cu, (const void*)mk_fwd, NWAVES * 64, LDS_BYTES);
        (void)hipGetLastError();
        grid = cus;
    }
    if (grid < 0) return;
    (void)hipMemsetAsync((char*)d_ws + WS_CTL, 0, CTL_ZERO_BYTES, stream);
    Args a{};
    for (int i = 0; i < 32; ++i) a.in[i] = (const float*)d_in[i];
    a.out = (float*)d_out; a.ws = (unsigned char*)d_ws; a.ph_lo = 0; a.ph_hi = 13; a.li = 0;
    hipLaunchKernelGGL(mk_fwd, dim3(grid), dim3(NWAVES * 64), LDS_BYTES, stream, a);
}
```

```cpp
#include <hip/hip_runtime.h>
#include <cstdio>
#include <cstdint>

constexpr int BATCH = 4, SEQ = 4096, DM = 1024, T = BATCH * SEQ;
constexpr int MEML = 256, MROWS = BATCH * MEML;
constexpr int SSMW = 512, SG = 16, NG = 32, NP = 64;
constexpr int SGUW = 512, SH = 4, SHD = 128, CHUNK = 128;
constexpr int XH = 4, XD = 128, XW = 512;
constexpr int INC = 2048;
constexpr int NGRP = 8, EPG = 8, NE = 64, DFF = 512;
constexpr float EPS = 1e-6f;
constexpr int SCH = 128;
constexpr int NSC = SEQ / SCH;

#define LAS __attribute__((address_space(3)))
#define GAS __attribute__((address_space(1)))
typedef _Float16 half_t;
typedef _Float16 f16x8 __attribute__((ext_vector_type(8)));
typedef _Float16 f16x4 __attribute__((ext_vector_type(4)));
typedef _Float16 f16x2 __attribute__((ext_vector_type(2)));
typedef float f32x4 __attribute__((ext_vector_type(4)));
typedef float f32x2 __attribute__((ext_vector_type(2)));
typedef unsigned u32x4 __attribute__((ext_vector_type(4)));
typedef unsigned u32x2 __attribute__((ext_vector_type(2)));

__device__ __forceinline__ unsigned pk_h2(float lo, float hi) { f16x2 v; v.x = (_Float16)lo; v.y = (_Float16)hi; return __builtin_bit_cast(unsigned, v); }
__device__ __forceinline__ float fast_sigmoid(float x) { return __builtin_amdgcn_rcpf(1.f + __builtin_amdgcn_exp2f(-1.4426950408889634f * x)); }
__device__ __forceinline__ float fast_gelu(float x) {
    const float u = 0.7978845608028654f * (x + 0.044715f * x * x * x);
    return x * __builtin_amdgcn_rcpf(1.f + __builtin_amdgcn_exp2f(-2.885390081777927f * u));
}

namespace pg {
constexpr int BM = 256, BK = 64, HALF = 128, HTB = HALF * BK * 2, STAGE_BYTES = 8 * HTB, NXCD = 8, WGM = 8;

__host__ __device__ __forceinline__ int lds_byte(int r, int c) { const int st = (r >> 4) * 2 + (c >> 5), rr = r & 15, cc = c & 31, ob = rr * 64 + cc * 2; return st * 1024 + (ob ^ (((ob >> 9) & 1) << 5)); }
__host__ __device__ __forceinline__ void stage_rc(int b, int& R, int& C) { const int st = b / 1024, sb = b % 1024, swz = sb ^ (((sb >> 9) & 1) << 5); R = (st >> 1) * 16 + swz / 64; C = (st & 1) * 32 + (swz % 64) / 2; }
__host__ __device__ __forceinline__ int perm32(int rho) { const int n = rho >> 4, i = rho & 15; return 8 * (i >> 2) + 4 * n + (i & 3); }

struct Unit { const char* A; const char* B; int pm, pn, aux; };

struct OrderMN {
    int nM, nN, nwg, G, c; const char* A; const char* B; size_t tA, tB;
    __device__ void init(int M, int N, int G_, int c_, const void* A_, size_t lda, const void* B_, size_t ldb) { nM = M / BM; nN = N / BM; nwg = nM * nN; G = G_; c = c_; A = (const char*)A_; B = (const char*)B_; tA = (size_t)BM * lda * 2; tB = (size_t)BM * ldb * 2; }
    __device__ bool next(int i, Unit& u) const {
        const long L = (long)i * G + c; if (L >= nwg) return false;
        int wgid = (int)L; { const int q = nwg / NXCD, r = nwg % NXCD, xcd = wgid % NXCD, off = wgid / NXCD; wgid = (xcd < r ? xcd * (q + 1) : r * (q + 1) + (xcd - r) * q) + off; }
        const int nig = WGM * nN, gid = wgid / nig, fm = gid * WGM, gsz = (nM - fm) < WGM ? (nM - fm) : WGM;
        u.pm = fm + ((wgid % nig) % gsz); u.pn = (wgid % nig) / gsz; u.aux = 0;
        u.A = A + (size_t)u.pm * tA; u.B = B + (size_t)u.pn * tB; return true;
    }
};

template <class Epi, class Sched, bool ALIGN_EPI, bool GATHER = false>
__device__ __forceinline__ void gemm_phase(LAS unsigned char* lds, const int lda, const int ldb, const int nt, const Sched& S, const Epi& E, const LAS int* ridxc = nullptr) {
    const int tid = threadIdx.x, wid = __builtin_amdgcn_readfirstlane(tid >> 6), lane = tid & 63, wr = wid >> 2, wc = wid & 3, fr = lane & 15, fq = lane >> 4;
    const size_t kstep = (size_t)(BK * 2);
    const size_t hstepA = (size_t)HALF * lda * 2, hstepB = (size_t)HALF * ldb * 2;
    unsigned voffA[2][2], nvA[2][2], voffB[2]; int RA[2], CA2[2];
#pragma unroll
    for (int i = 0; i < 2; ++i) { int R, C; stage_rc(tid * 16 + i * 8192, R, C); const int Rb = Epi::PERM ? ((R & ~31) + perm32(R & 31)) : R;
        RA[i] = R; CA2[i] = C * 2;
        voffA[0][i] = (unsigned)(R * lda + C) * 2u; voffA[1][i] = voffA[0][i] + (unsigned)hstepA; voffB[i] = (unsigned)(Rb * ldb + C) * 2u; }
#define PG_GVOFF(dst, slot) do { _Pragma("unroll") for (int _h = 0; _h < 2; ++_h) _Pragma("unroll") for (int _i = 0; _i < 2; ++_i) \
        dst[_h][_i] = (unsigned)ridxc[(slot) * 256 + _h * HALF + RA[_i]] * (unsigned)(lda * 2) + (unsigned)CA2[_i]; } while (0)
    const unsigned ldsw = (unsigned)wid * 1024u;
    const int aoff = lds_byte(wr * 64 + fr, fq * 8), boff = lds_byte(wc * 32 + fr, fq * 8);
#define PG_SA(b, h) (((b) * 2 + (h)) * HTB)
#define PG_SB(b, h) ((4 + (b) * 2 + (h)) * HTB)
#define PG_STAGE(bufoff, gbase, voff) do { _Pragma("unroll") for (int _i = 0; _i < 2; ++_i) \
        __builtin_amdgcn_global_load_lds((const unsigned*)((const char*)(gbase) + (voff)[_i]), (LAS unsigned*)(lds + (bufoff) + ldsw + _i * 8192), 16, 0, 0); } while (0)
#define PG_LDA(dst, b, h) do { _Pragma("unroll") for (int m = 0; m < 4; ++m) _Pragma("unroll") for (int k = 0; k < 2; ++k) dst[m][k] = *(const LAS f16x8*)(lds + PG_SA(b, h) + aoff + m * 2048 + k * 1024); } while (0)
#define PG_LDB(dst, b, h) do { _Pragma("unroll") for (int n = 0; n < 2; ++n) _Pragma("unroll") for (int k = 0; k < 2; ++k) dst[n][k] = *(const LAS f16x8*)(lds + PG_SB(b, h) + boff + n * 2048 + k * 1024); } while (0)
#define PG_MMA(ai, bj, At, Bt) do { __builtin_amdgcn_s_setprio(1); _Pragma("unroll") for (int m = 0; m < 4; ++m) _Pragma("unroll") for (int n = 0; n < 2; ++n) _Pragma("unroll") for (int k = 0; k < 2; ++k) \
        acc[ai][bj][m][n] = __builtin_amdgcn_mfma_f32_16x16x32_f16(Bt[n][k], At[m][k], acc[ai][bj][m][n], 0, 0, 0); __builtin_amdgcn_s_setprio(0); } while (0)
#define PG_WAIT_V(n) asm volatile("s_waitcnt vmcnt(" #n ")" ::: "memory")
#define PG_WAIT_L(n) asm volatile("s_waitcnt lgkmcnt(" #n ")" ::: "memory")
#define PG_BAR __builtin_amdgcn_s_barrier()
#define PG_SCHED __builtin_amdgcn_sched_barrier(0)
    Unit cur, nxt; int ui = 0;
    if (!S.next(0, cur)) return;
    if constexpr (GATHER) PG_GVOFF(voffA, 0);
    f32x4 acc[2][2][4][2];
#pragma unroll
    for (int a = 0; a < 2; ++a)
#pragma unroll
        for (int b = 0; b < 2; ++b)
#pragma unroll
            for (int m = 0; m < 4; ++m)
#pragma unroll
                for (int n = 0; n < 2; ++n) acc[a][b][m][n] = (f32x4){0.f, 0.f, 0.f, 0.f};
    f16x8 At[4][2], B0[2][2], B1[2][2];
    const char* cA = cur.A; const char* cB = cur.B;
    PG_STAGE(PG_SB(0, 0), cB, voffB); PG_STAGE(PG_SB(0, 1), cB + hstepB, voffB); PG_STAGE(PG_SA(0, 0), cA, voffA[0]); PG_STAGE(PG_SA(0, 1), cA, voffA[1]);
    if (wr == 1) PG_BAR;
    PG_WAIT_V(2); PG_BAR;
    PG_STAGE(PG_SB(1, 0), cB + kstep, voffB); PG_STAGE(PG_SA(1, 0), cA + kstep, voffA[0]); PG_STAGE(PG_SB(1, 1), cB + hstepB + kstep, voffB);
    PG_WAIT_V(6); PG_BAR;
    for (;;) {
        const bool has_next = S.next(ui + 1, nxt);
        const char* nA = has_next ? nxt.A : cA; const char* nB = has_next ? nxt.B : cB;
        if constexpr (GATHER) { if (has_next) PG_GVOFF(nvA, ui + 1); else {
#pragma unroll
            for (int _h = 0; _h < 2; ++_h)
#pragma unroll
                for (int _i = 0; _i < 2; ++_i) nvA[_h][_i] = voffA[_h][_i]; } }
        for (int t = 0; t < nt; t += 2) {
            const bool last = (t == nt - 2);
            const char* a1 = cA + (size_t)(t + 1) * kstep;
            const char* a2 = last ? nA : cA + (size_t)(t + 2) * kstep; const char* b2 = last ? nB : cB + (size_t)(t + 2) * kstep;
            const char* a3 = a2 + kstep; const char* b3 = b2 + kstep;
            unsigned sv[2][2];
#pragma unroll
            for (int _h = 0; _h < 2; ++_h)
#pragma unroll
                for (int _i = 0; _i < 2; ++_i) sv[_h][_i] = (GATHER && last) ? nvA[_h][_i] : voffA[_h][_i];
            PG_LDB(B0, 0, 0); PG_LDB(B1, 0, 1); PG_SCHED; PG_LDA(At, 0, 0); PG_STAGE(PG_SA(1, 1), a1, voffA[1]);
            PG_WAIT_V(8); PG_WAIT_L(0); PG_BAR; PG_MMA(0, 0, At, B0); PG_MMA(0, 1, At, B1); PG_BAR; PG_SCHED;
            PG_LDA(At, 0, 1); PG_STAGE(PG_SB(0, 0), b2, voffB); PG_STAGE(PG_SB(0, 1), b2 + hstepB, voffB); PG_STAGE(PG_SA(0, 0), a2, sv[0]);
            PG_WAIT_V(8); PG_WAIT_L(0); PG_BAR; PG_MMA(1, 0, At, B0); PG_MMA(1, 1, At, B1); PG_BAR; PG_SCHED;
            PG_LDB(B0, 1, 0); PG_LDB(B1, 1, 1); PG_SCHED; PG_LDA(At, 1, 0); PG_STAGE(PG_SA(0, 1), a2, sv[1]);
            PG_WAIT_V(8); PG_WAIT_L(0); PG_BAR; PG_MMA(0, 0, At, B0); PG_MMA(0, 1, At, B1); PG_BAR; PG_SCHED;
            PG_LDA(At, 1, 1); PG_STAGE(PG_SB(1, 0), b3, voffB); PG_STAGE(PG_SB(1, 1), b3 + hstepB, voffB); PG_STAGE(PG_SA(1, 0), a3, sv[0]);
            PG_WAIT_V(8); PG_WAIT_L(0); PG_BAR; PG_MMA(1, 0, At, B0); PG_MMA(1, 1, At, B1); PG_BAR; PG_SCHED;
        }
        if constexpr (ALIGN_EPI) { if (wr == 0) PG_BAR; }
        E(acc, cur, wr, wc, fr, fq);
        if (!has_next) break;
#pragma unroll
        for (int a = 0; a < 2; ++a)
#pragma unroll
            for (int b = 0; b < 2; ++b)
#pragma unroll
                for (int m = 0; m < 4; ++m)
#pragma unroll
                    for (int n = 0; n < 2; ++n) acc[a][b][m][n] = (f32x4){0.f, 0.f, 0.f, 0.f};
        cur = nxt; cA = nA; cB = nB; ++ui;
        if constexpr (GATHER) {
#pragma unroll
            for (int _h = 0; _h < 2; ++_h)
#pragma unroll
                for (int _i = 0; _i < 2; ++_i) voffA[_h][_i] = nvA[_h][_i]; }
        if constexpr (ALIGN_EPI) { if (wr == 1) PG_BAR; }
    }
    PG_WAIT_V(0);
    if constexpr (!ALIGN_EPI) { if (wr == 0) PG_BAR; }
    PG_BAR;
#undef PG_GVOFF
#undef PG_SA
#undef PG_SB
#undef PG_STAGE
#undef PG_LDA
#undef PG_LDB
#undef PG_MMA
#undef PG_WAIT_V
#undef PG_WAIT_L
#undef PG_BAR
#undef PG_SCHED
}

struct EpiProj {
    static constexpr bool PERM = true;
    half_t* O; int ldc; float* vsq;
    __device__ __forceinline__ void operator()(const f32x4 (&acc)[2][2][4][2], const Unit& u, int wr, int wc, int fr, int fq) const {
        const int row0 = u.pm * BM + wr * 64 + fr, col0 = u.pn * BM + wc * 32 + 8 * fq;
        const bool act = (u.pn >= 2 && u.pn < 6), isv = (u.pn >= 4 && u.pn < 6);
#pragma unroll
        for (int ai = 0; ai < 2; ++ai)
#pragma unroll
            for (int m = 0; m < 4; ++m) { half_t* rowp = O + (size_t)(row0 + ai * HALF + m * 16) * ldc + col0; float sq = 0.f;
#pragma unroll
                for (int bj = 0; bj < 2; ++bj) { f32x4 v0 = acc[ai][bj][m][0], v1 = acc[ai][bj][m][1];
                    if (act) {
#pragma unroll
                        for (int j = 0; j < 4; ++j) { v0[j] = fast_gelu(v0[j]); v1[j] = fast_gelu(v1[j]); sq += v0[j] * v0[j] + v1[j] * v1[j]; } }
                    u32x4 w; w.x = pk_h2(v0[0], v0[1]); w.y = pk_h2(v0[2], v0[3]); w.z = pk_h2(v1[0], v1[1]); w.w = pk_h2(v1[2], v1[3]);
                    *(u32x4*)(rowp + bj * HALF) = w; }
                if (isv) { sq += __shfl_xor(sq, 16); sq += __shfl_xor(sq, 32); if (fq == 0) vsq[(size_t)(row0 + ai * HALF + m * 16) * 8 + (u.pn - 4) * 4 + wc] = sq; } }
    }
};

struct EpiGlu {
    static constexpr bool PERM = true;
    half_t* O; int ldc; const float* bias;
    __device__ __forceinline__ void operator()(const f32x4 (&acc)[2][2][4][2], const Unit& u, int wr, int wc, int fr, int fq) const {
        const int row0 = u.pm * BM + wr * 64 + fr, col0 = u.pn * HALF + wc * 32 + 8 * fq;
        const f32x4 ba0 = *(const f32x4*)(bias + col0), ba1 = *(const f32x4*)(bias + col0 + 4), bb0 = *(const f32x4*)(bias + 512 + col0), bb1 = *(const f32x4*)(bias + 512 + col0 + 4);
#pragma unroll
        for (int ai = 0; ai < 2; ++ai)
#pragma unroll
            for (int m = 0; m < 4; ++m) {
                const f32x4 a0 = acc[ai][0][m][0] + ba0, a1 = acc[ai][0][m][1] + ba1, b0 = acc[ai][1][m][0] + bb0, b1 = acc[ai][1][m][1] + bb1;
                u32x4 w; w.x = pk_h2(a0[0] * fast_sigmoid(b0[0]), a0[1] * fast_sigmoid(b0[1])); w.y = pk_h2(a0[2] * fast_sigmoid(b0[2]), a0[3] * fast_sigmoid(b0[3]));
                w.z = pk_h2(a1[0] * fast_sigmoid(b1[0]), a1[1] * fast_sigmoid(b1[1])); w.w = pk_h2(a1[2] * fast_sigmoid(b1[2]), a1[3] * fast_sigmoid(b1[3]));
                *(u32x4*)(O + (size_t)(row0 + ai * HALF + m * 16) * ldc + col0) = w; }
    }
};
struct EpiGate {
    static constexpr bool PERM = true;
    half_t* O; int ldc; const float* bias;
    __device__ __forceinline__ void operator()(const f32x4 (&acc)[2][2][4][2], const Unit& u, int wr, int wc, int fr, int fq) const {
        const int row0 = u.pm * BM + wr * 64 + fr, col0 = u.pn * BM + wc * 32 + 8 * fq;
        f32x4 bv[2][2];
#pragma unroll
        for (int bj = 0; bj < 2; ++bj)
#pragma unroll
            for (int n = 0; n < 2; ++n) bv[bj][n] = *(const f32x4*)(bias + col0 + bj * HALF + 4 * n);
#pragma unroll
        for (int ai = 0; ai < 2; ++ai)
#pragma unroll
            for (int m = 0; m < 4; ++m) { half_t* rowp = O + (size_t)(row0 + ai * HALF + m * 16) * ldc + col0;
#pragma unroll
                for (int bj = 0; bj < 2; ++bj) { const f32x4 v0 = acc[ai][bj][m][0] + bv[bj][0], v1 = acc[ai][bj][m][1] + bv[bj][1];
                    u32x4 w; w.x = pk_h2(fast_sigmoid(v0[0]), fast_sigmoid(v0[1])); w.y = pk_h2(fast_sigmoid(v0[2]), fast_sigmoid(v0[3])); w.z = pk_h2(fast_sigmoid(v1[0]), fast_sigmoid(v1[1])); w.w = pk_h2(fast_sigmoid(v1[2]), fast_sigmoid(v1[3]));
                    *(u32x4*)(rowp + bj * HALF) = w; } }
    }
};
struct EpiBranch {
    static constexpr bool PERM = true;
    half_t* O; const half_t* G;
    __device__ __forceinline__ void operator()(const f32x4 (&acc)[2][2][4][2], const Unit& u, int wr, int wc, int fr, int fq) const {
        const int row0 = u.pm * BM + wr * 64 + fr, col0 = u.pn * BM + wc * 32 + 8 * fq; const int i = u.aux;
#pragma unroll
        for (int ai = 0; ai < 2; ++ai)
#pragma unroll
            for (int m = 0; m < 4; ++m) { const size_t r = (size_t)(row0 + ai * HALF + m * 16);
#pragma unroll
                for (int bj = 0; bj < 2; ++bj) {
                    const f16x8 gv = *(const f16x8*)(G + r * 3072 + i * 1024 + col0 + bj * HALF);
                    f16x8 pv = {0, 0, 0, 0, 0, 0, 0, 0};
                    if (i > 0) pv = *(const f16x8*)(O + r * 1024 + col0 + bj * HALF);
                    const f32x4 v0 = acc[ai][bj][m][0], v1 = acc[ai][bj][m][1];
                    u32x4 w; w.x = pk_h2((float)pv[0] + (float)gv[0] * v0[0], (float)pv[1] + (float)gv[1] * v0[1]); w.y = pk_h2((float)pv[2] + (float)gv[2] * v0[2], (float)pv[3] + (float)gv[3] * v0[3]);
                    w.z = pk_h2((float)pv[4] + (float)gv[4] * v1[0], (float)pv[5] + (float)gv[5] * v1[1]); w.w = pk_h2((float)pv[6] + (float)gv[6] * v1[2], (float)pv[7] + (float)gv[7] * v1[3]);
                    *(u32x4*)(O + r * 1024 + col0 + bj * HALF) = w; } }
    }
};
struct EpiOut {
    static constexpr bool PERM = true;
    half_t* O; const float* X; int ldc;
    __device__ __forceinline__ void operator()(const f32x4 (&acc)[2][2][4][2], const Unit& u, int wr, int wc, int fr, int fq) const {
        const int row0 = u.pm * BM + wr * 64 + fr, col0 = u.pn * BM + wc * 32 + 8 * fq;
#pragma unroll
        for (int ai = 0; ai < 2; ++ai)
#pragma unroll
            for (int m = 0; m < 4; ++m) { const size_t off = (size_t)(row0 + ai * HALF + m * 16) * ldc + col0;
#pragma unroll
                for (int bj = 0; bj < 2; ++bj) {
                    const f32x4 v0 = *(const f32x4*)(X + off + bj * HALF) + acc[ai][bj][m][0], v1 = *(const f32x4*)(X + off + bj * HALF + 4) + acc[ai][bj][m][1];
                    u32x4 w; w.x = pk_h2(v0[0], v0[1]); w.y = pk_h2(v0[2], v0[3]); w.z = pk_h2(v1[0], v1[1]); w.w = pk_h2(v1[2], v1[3]);
                    *(u32x4*)(O + off + bj * HALF) = w; } }
    }
};
struct OrderBr {
    OrderMN base; const char* A; const char* B;
    __device__ void init(int G_, int c_, const void* cat, const void* wbr) { base.init(T, 1024, G_, c_, nullptr, 0, nullptr, 0); A = (const char*)cat; B = (const char*)wbr; }
    __device__ bool next(int j, Unit& u) const {
        const int r = j / 3, i = j - 3 * r;
        if (!base.next(r, u)) return false;
        u.aux = i;
        u.A = A + (size_t)u.pm * BM * 1536 * 2 + (size_t)i * 512 * 2;
        u.B = B + (size_t)i * 1024 * 512 * 2 + (size_t)u.pn * BM * 512 * 2;
        return true;
    }
};
}

constexpr int NWAVES = 8;
constexpr int RING_OFF = 0, RING_BYTES = 131072;
constexpr int LDSCTL_OFF = RING_BYTES, MISC_OFF = LDSCTL_OFF + 320;
constexpr int LDS_BYTES = 147456;
typedef GAS unsigned gu32;
#define RLX_AGENT __ATOMIC_RELAXED, __HIP_MEMORY_SCOPE_AGENT
#define LDS_WAIT() asm volatile("s_waitcnt lgkmcnt(0)" ::: "memory")
#define VM_WAIT() asm volatile("s_waitcnt vmcnt(0)" ::: "memory")

#define XB_TMO      128
#define XB_XCNT(j)  (256  + 64 * (j))
#define XB_XSUB(j)  (1280 + 64 * (j))
#define XB_XGEN(j)  (2304 + 64 * (j))
#define XB_TOP      3328
#define XB_TOPGEN   3392
#define XCD_BAR_WORDS 3456
#define XB_SPIN_CAP (1u << 18)
__device__ __forceinline__ unsigned xb_ld(unsigned* p)              { return __hip_atomic_load(p, __ATOMIC_RELAXED, __HIP_MEMORY_SCOPE_AGENT); }
__device__ __forceinline__ unsigned xb_add(unsigned* p, unsigned v) { return __hip_atomic_fetch_add(p, v, __ATOMIC_RELAXED, __HIP_MEMORY_SCOPE_AGENT); }
__device__ __forceinline__ unsigned xb_xcc_id() { return (unsigned)__builtin_amdgcn_s_getreg((3 << 11) | 20) & 0xFu; }
#define XB_SPIN(cond, bar) do { unsigned _sp = 0; while (cond) { __builtin_amdgcn_s_sleep(1); \
    if ((++_sp & 255u) == 0u) { if (xb_ld(&(bar)[XB_TMO])) break; if (_sp > XB_SPIN_CAP) { atomicAdd(&(bar)[XB_TMO], 1u); break; } } } } while (0)
struct XcdBarrier { unsigned* bar; unsigned x; volatile LAS unsigned* st; };
__device__ __forceinline__ XcdBarrier xcd_barrier_post(unsigned* bar, volatile LAS unsigned* st) {
    XcdBarrier b; b.bar = bar; b.x = xb_xcc_id(); b.st = st;
    if (threadIdx.x == 0) (void)xb_add(&bar[XB_XCNT(b.x)], 1u);
    return b;
}
__device__ __forceinline__ void xcd_barrier_complete(unsigned* bar, unsigned x, unsigned& nloc, unsigned& nx) {
    const unsigned G = gridDim.x * gridDim.y * gridDim.z;
    unsigned sum, cnt, mine, sp = 0u;
    for (;;) {
        sum = 0u; cnt = 0u; mine = 0u;
#pragma unroll
        for (unsigned j = 0; j < 16; ++j) { const unsigned c = xb_ld(&bar[XB_XCNT(j)]); sum += c; cnt += (c > 0u) ? 1u : 0u; mine = (j == x) ? c : mine; }
        if (sum == G) break;
        __builtin_amdgcn_s_sleep(1);
        if ((++sp & 255u) == 0u) { if (xb_ld(&bar[XB_TMO])) break; if (sp > XB_SPIN_CAP) { atomicAdd(&bar[XB_TMO], 1u); break; } }
    }
    nloc = mine > 0u ? mine : 1u; nx = cnt > 0u ? cnt : 1u;
}
__device__ __forceinline__ void xcd_barrier(const XcdBarrier& b) {
    asm volatile("s_waitcnt vmcnt(0)" ::: "memory");
    __syncthreads();
    if (threadIdx.x == 0) {
        unsigned* bar = b.bar;
        __builtin_amdgcn_s_waitcnt(0);
        unsigned nloc = b.st[0], nx = b.st[1];
        if (nloc == 0u) { xcd_barrier_complete(bar, b.x, nloc, nx); b.st[0] = nloc; b.st[1] = nx; }
        const unsigned old = xb_add(&bar[XB_XSUB(b.x)], 1u);
        const unsigned gen = old / nloc;
        if (old + 1u == (gen + 1u) * nloc) {
            __builtin_amdgcn_fence(__ATOMIC_RELEASE, "agent");
            asm volatile("s_waitcnt vmcnt(0)" ::: "memory");
            const unsigned og = xb_add(&bar[XB_TOP], 1u);
            const unsigned tg = og / nx;
            if (og + 1u == (tg + 1u) * nx) xb_add(&bar[XB_TOPGEN], 1u);
            else XB_SPIN(xb_ld(&bar[XB_TOPGEN]) == tg, bar);
            __builtin_amdgcn_fence(__ATOMIC_ACQUIRE, "agent");
            xb_add(&bar[XB_XGEN(b.x)], 1u);
            asm volatile("s_waitcnt vmcnt(0)" ::: "memory");
        } else {
            XB_SPIN(xb_ld(&bar[XB_XGEN(b.x)]) == gen, bar);
            __builtin_amdgcn_fence(__ATOMIC_ACQUIRE, "agent");
            asm volatile("s_waitcnt vmcnt(0)" ::: "memory");
        }
    }
    __syncthreads();
}

__device__ __forceinline__ float wave_sum(float v) {
#pragma unroll
    for (int o = 1; o < 64; o <<= 1) v += __shfl_xor(v, o);
    return v;
}

__device__ __forceinline__ void transpose_item(const float* W, int ldw, int k0, int n0, half_t* WT, int ldt, int drow0, LAS float* scr, int lane, const float* kscale = nullptr) {
    const int lk = lane >> 3, lc = (lane & 7) * 4;
    f32x4 v[8];
#pragma unroll
    for (int i = 0; i < 8; ++i) v[i] = *(const GAS f32x4*)(W + (size_t)(k0 + i * 8 + lk) * ldw + n0 + lc);
#pragma unroll
    for (int i = 0; i < 8; ++i) { LAS float* s = scr + (i * 8 + lk) * 33 + lc; s[0] = v[i].x; s[1] = v[i].y; s[2] = v[i].z; s[3] = v[i].w; }
    LDS_WAIT(); asm volatile("" ::: "memory");
    const int c = lane & 7;
    f32x4 g0 = {1.f, 1.f, 1.f, 1.f}, g1 = g0;
    if (kscale) { g0 = *(const GAS f32x4*)(kscale + k0 + 8 * c); g1 = *(const GAS f32x4*)(kscale + k0 + 8 * c + 4); }
#pragma unroll
    for (int j = 0; j < 4; ++j) { const int n = (lane >> 3) + 8 * j; const LAS float* s = scr + (8 * c) * 33 + n;
        u32x4 o; o.x = pk_h2(s[0 * 33] * g0[0], s[1 * 33] * g0[1]); o.y = pk_h2(s[2 * 33] * g0[2], s[3 * 33] * g0[3]); o.z = pk_h2(s[4 * 33] * g1[0], s[5 * 33] * g1[1]); o.w = pk_h2(s[6 * 33] * g1[2], s[7 * 33] * g1[3]);
        *(GAS u32x4*)(WT + (size_t)(drow0 + n) * ldt + k0 + 8 * c) = o; }
    LDS_WAIT(); asm volatile("" ::: "memory");
}
__device__ __forceinline__ void rms_row_to_f16(const float* xrow, const float* g, half_t* orow, int lane) {
    const GAS f32x4* xr = (const GAS f32x4*)xrow + lane;
    const GAS f32x4* gr = (const GAS f32x4*)g + lane;
    f32x4 v[4]; float s = 0.f;
#pragma unroll
    for (int j = 0; j < 4; ++j) { v[j] = xr[64 * j]; s += (v[j].x * v[j].x + v[j].y * v[j].y) + (v[j].z * v[j].z + v[j].w * v[j].w); }
    const float rs = 1.0f / sqrtf(wave_sum(s) * (1.f / 1024.f) + EPS);
    GAS u32x2* o8 = (GAS u32x2*)orow + lane;
#pragma unroll
    for (int j = 0; j < 4; ++j) { const f32x4 gg = gr[64 * j]; u32x2 w; w.x = pk_h2(v[j].x * rs * gg.x, v[j].y * rs * gg.y); w.y = pk_h2(v[j].z * rs * gg.z, v[j].w * rs * gg.w); o8[64 * j] = w; }
}

typedef float f32x16 __attribute__((ext_vector_type(16)));
__device__ __forceinline__ int crow(int r, int hi) { return (r & 3) + 8 * (r >> 2) + 4 * hi; }

__device__ __forceinline__ void kv_tile(const half_t* __restrict__ A  , const half_t* __restrict__ Bt  , half_t* K16, half_t* VT16, int tile, int wave, int lane) {
    const int m0 = (tile >> 4) * 64, n0 = (tile & 15) * 64;
    const int rb = wave >> 1, cb = (wave & 1) * 32;
    const int fr = lane & 15, fq = lane >> 4;
    const half_t* ap = A + (size_t)(m0 + 16 * rb + fr) * DM + 8 * fq;
    const half_t* bp0 = Bt + (size_t)(n0 + cb + fr) * DM + 8 * fq;
    const half_t* bp1 = bp0 + (size_t)16 * DM;
    f32x4 acc0 = {0.f, 0.f, 0.f, 0.f}, acc1 = {0.f, 0.f, 0.f, 0.f};
    const bool vpart = n0 >= 512;
#pragma unroll 4
    for (int k0 = 0; k0 < DM; k0 += 32) {
        const f16x8 a = *(const f16x8*)(ap + k0), b0 = *(const f16x8*)(bp0 + k0), b1 = *(const f16x8*)(bp1 + k0);
        if (vpart) { acc0 = __builtin_amdgcn_mfma_f32_16x16x32_f16(a, b0, acc0, 0, 0, 0); acc1 = __builtin_amdgcn_mfma_f32_16x16x32_f16(a, b1, acc1, 0, 0, 0); }
        else       { acc0 = __builtin_amdgcn_mfma_f32_16x16x32_f16(b0, a, acc0, 0, 0, 0); acc1 = __builtin_amdgcn_mfma_f32_16x16x32_f16(b1, a, acc1, 0, 0, 0); }
    }
    if (!vpart) {
        const int m = m0 + 16 * rb + fr;
        u32x2 w0, w1; w0.x = pk_h2(acc0[0], acc0[1]); w0.y = pk_h2(acc0[2], acc0[3]); w1.x = pk_h2(acc1[0], acc1[1]); w1.y = pk_h2(acc1[2], acc1[3]);
        *(u32x2*)(K16 + (size_t)m * 512 + n0 + cb + 4 * fq) = w0;
        *(u32x2*)(K16 + (size_t)m * 512 + n0 + cb + 16 + 4 * fq) = w1;
    } else {
        const int mb = m0 + 16 * rb + 4 * fq, b = mb >> 8, key = mb & 255;
        const int n = n0 - 512 + cb + fr;
        u32x2 w0, w1; w0.x = pk_h2(acc0[0], acc0[1]); w0.y = pk_h2(acc0[2], acc0[3]); w1.x = pk_h2(acc1[0], acc1[1]); w1.y = pk_h2(acc1[2], acc1[3]);
        *(u32x2*)(VT16 + ((size_t)b * 512 + n) * 256 + key) = w0;
        *(u32x2*)(VT16 + ((size_t)b * 512 + n + 16) * 256 + key) = w1;
    }
}

constexpr int ATT_K_OFF = 0, ATT_V_OFF = 65536, ATT_WS_OFF = RING_BYTES + 1024;
__device__ __forceinline__ void attn_unit(LAS unsigned char* lds, const half_t* __restrict__ PROJ16, const half_t* __restrict__ K16, const half_t* __restrict__ VT16, half_t* CAT16,
                                          int b, int h, int qb, int tid, int wave, int lane) {
    asm volatile("" : "+v"(tid), "+v"(lane));
    {
        const half_t* kg = K16 + (size_t)(b * 256) * 512 + h * 128;
        const half_t* vg = VT16 + ((size_t)b * 512 + h * 128) * 256;
        u32x4 kv[8], vv[8];
#pragma unroll
        for (int it = 0; it < 8; ++it) { const int idx = it * 512 + tid, key = idx >> 4, ch = idx & 15; kv[it] = *(const u32x4*)(kg + (size_t)key * 512 + ch * 8); }
#pragma unroll
        for (int it = 0; it < 8; ++it) { const int idx = it * 512 + tid, d = idx >> 5, ch = idx & 31; vv[it] = *(const u32x4*)(vg + (size_t)d * 256 + ch * 8); }
#pragma unroll
        for (int it = 0; it < 8; ++it) { const int idx = it * 512 + tid, key = idx >> 4, ch = idx & 15; *(LAS u32x4*)(lds + ATT_K_OFF + key * 256 + ((ch ^ (key & 15)) << 4)) = kv[it]; }
#pragma unroll
        for (int it = 0; it < 8; ++it) { const int idx = it * 512 + tid, d = idx >> 5, ch = idx & 31; const int m = (d & 31) << 3;
            u32x2 lo, hi2; lo.x = vv[it].x; lo.y = vv[it].y; hi2.x = vv[it].z; hi2.y = vv[it].w;
            *(LAS u32x2*)(lds + ATT_V_OFF + d * 512 + ((ch * 16) ^ m)) = lo;
            *(LAS u32x2*)(lds + ATT_V_OFF + d * 512 + ((ch * 16 + 8) ^ m)) = hi2; }
    }
    __syncthreads();
    const int c31 = lane & 31, hi = lane >> 5;
    const int tok0 = b * SEQ + qb * 256 + wave * 32;
    f16x8 qf[8];
    {
        const half_t* qp = PROJ16 + (size_t)(tok0 + c31) * INC + 1536 + h * 128 + 8 * hi;
#pragma unroll
        for (int s = 0; s < 8; ++s) qf[s] = *(const f16x8*)(qp + 16 * s);
    }
    __builtin_amdgcn_sched_barrier(0);
    f32x16 sb[8];
#pragma unroll
    for (int kb = 0; kb < 8; ++kb) {
        f32x16 a = {0.f, 0.f, 0.f, 0.f, 0.f, 0.f, 0.f, 0.f, 0.f, 0.f, 0.f, 0.f, 0.f, 0.f, 0.f, 0.f};
        const int key = kb * 32 + c31;
#pragma unroll
        for (int s = 0; s < 8; ++s) {
            const f16x8 kf = *(const LAS f16x8*)(lds + ATT_K_OFF + key * 256 + (((2 * s + hi) ^ (key & 15)) << 4));
            a = __builtin_amdgcn_mfma_f32_32x32x16_f16(kf, qf[s], a, 0, 0, 0);
        }
        sb[kb] = a;
    }
    __builtin_amdgcn_sched_barrier(0);
    float mx = -3.0e38f;
#pragma unroll
    for (int kb = 0; kb < 8; ++kb)
#pragma unroll
        for (int r = 0; r < 16; ++r) mx = fmaxf(mx, sb[kb][r]);
    mx = fmaxf(mx, __shfl_xor(mx, 32));
    const float c2 = 0.08838834764831845f * 1.4426950408889634f;
    const float mc = mx * c2;
    float l = 0.f;
    f16x8 pa[16];
#pragma unroll
    for (int kb = 0; kb < 8; ++kb)
#pragma unroll
        for (int s = 0; s < 2; ++s) {
#pragma unroll
            for (int j = 0; j < 8; ++j) { const float p = __builtin_amdgcn_exp2f(sb[kb][8 * s + j] * c2 - mc); l += p; pa[kb * 2 + s][j] = (_Float16)p; }
        }
    l += __shfl_xor(l, 32);
    LAS float* wsf = (LAS float*)(lds + ATT_WS_OFF) + wave * 32;
    if (hi == 0) wsf[c31] = l;
    __builtin_amdgcn_sched_barrier(0);
    f32x16 o[4];
#pragma unroll
    for (int db = 0; db < 4; ++db) o[db] = (f32x16){0.f, 0.f, 0.f, 0.f, 0.f, 0.f, 0.f, 0.f, 0.f, 0.f, 0.f, 0.f, 0.f, 0.f, 0.f, 0.f};
    const unsigned vbase = ATT_V_OFF + c31 * 512; const int m = c31 << 3;
#pragma unroll
    for (int ks = 0; ks < 16; ++ks) {
        const int kbyte = 32 * ks + 8 * hi;
#pragma unroll
        for (int db = 0; db < 4; ++db) {
            const f16x4 v0 = *(const LAS f16x4*)(lds + vbase + db * 16384 + (kbyte ^ m));
            const f16x4 v1 = *(const LAS f16x4*)(lds + vbase + db * 16384 + ((kbyte + 16) ^ m));
            const f16x8 vf = {v0[0], v0[1], v0[2], v0[3], v1[0], v1[1], v1[2], v1[3]};
            o[db] = __builtin_amdgcn_mfma_f32_32x32x16_f16(pa[ks], vf, o[db], 0, 0, 0);
        }
    }
    __builtin_amdgcn_sched_barrier(0);
    LDS_WAIT();
    half_t* op = CAT16 + (size_t)tok0 * 1536 + 1024 + h * 128 + c31;
#pragma unroll
    for (int r = 0; r < 16; ++r) {
        const int q = crow(r, hi);
        const float rl = __builtin_amdgcn_rcpf(wsf[q]);
#pragma unroll
        for (int db = 0; db < 4; ++db) op[(size_t)q * 1536 + db * 32] = (_Float16)(o[db][r] * rl);
    }
    __syncthreads();
}

constexpr int SP_VT_OFF = 0, SP_W_OFF = 32768, SP_RS_OFF = 65536;
__device__ __forceinline__ void spatial_unit(LAS unsigned char* lds, const half_t* __restrict__ PROJ16, const float* __restrict__ VSQ, const half_t* __restrict__ WSP16, const float* __restrict__ b_sp, const float* __restrict__ g_sgu,
                                             half_t* CAT16, int bc, int h, int tid, int wave, int lane) {
    asm volatile("" : "+v"(tid), "+v"(lane));
    const int tok0 = bc * CHUNK;
    LAS float* rs = (LAS float*)(lds + SP_RS_OFF);
    if (tid < CHUNK) { const f32x4 a = *(const f32x4*)(VSQ + (size_t)(tok0 + tid) * 8), b = *(const f32x4*)(VSQ + (size_t)(tok0 + tid) * 8 + 4);
        const float q = ((a[0] + a[1]) + (a[2] + a[3])) + ((b[0] + b[1]) + (b[2] + b[3])); rs[tid] = 1.0f / sqrtf(q * (1.f / 512.f) + EPS); }
#pragma unroll
    for (int it = 0; it < 4; ++it) { const int idx = it * 512 + tid, t = idx >> 4, ch = idx & 15;
        *(LAS u32x4*)(lds + SP_W_OFF + t * 256 + ((ch ^ (t & 15)) << 4)) = *(const u32x4*)(WSP16 + ((size_t)h * CHUNK + t) * CHUNK + ch * 8); }
    __syncthreads();
#pragma unroll
    for (int it = 0; it < 4; ++it) {
        const int idx = it * 512 + tid, s = idx >> 4, ch = idx & 15;
        const f16x8 v = *(const f16x8*)(PROJ16 + (size_t)(tok0 + s) * INC + 1024 + h * SHD + ch * 8);
        const float r = rs[s];
#pragma unroll
        for (int j = 0; j < 8; ++j) { const int d = ch * 8 + j;
            *(LAS half_t*)(lds + SP_VT_OFF + d * 256 + ((((s >> 3) ^ (d & 15)) << 4) | ((s & 7) << 1))) = (_Float16)((float)v[j] * r); }
    }
    __syncthreads();
    const int c31 = lane & 31, hi = lane >> 5, tb = wave >> 1, dh = wave & 1;
    f32x16 acc[2];
    acc[0] = (f32x16){0.f, 0.f, 0.f, 0.f, 0.f, 0.f, 0.f, 0.f, 0.f, 0.f, 0.f, 0.f, 0.f, 0.f, 0.f, 0.f}; acc[1] = acc[0];
    const int t = tb * 32 + c31;
    const int nks = 2 * (tb + 1);
    for (int ks = 0; ks < nks; ++ks) {
        const f16x8 wf = *(const LAS f16x8*)(lds + SP_W_OFF + t * 256 + (((2 * ks + hi) ^ (t & 15)) << 4));
#pragma unroll
        for (int q = 0; q < 2; ++q) {
            const int d = (2 * dh + q) * 32 + c31;
            const f16x8 vf = *(const LAS f16x8*)(lds + SP_VT_OFF + d * 256 + (((2 * ks + hi) ^ (d & 15)) << 4));
            acc[q] = __builtin_amdgcn_mfma_f32_32x32x16_f16(vf, wf, acc[q], 0, 0, 0);
        }
    }
    const float bias = b_sp[h * CHUNK + t];
    const half_t* up = PROJ16 + (size_t)(tok0 + t) * INC + 512 + h * SHD;
    half_t* op = CAT16 + (size_t)(tok0 + t) * 1536 + 512 + h * SHD;
#pragma unroll
    for (int q = 0; q < 2; ++q)
#pragma unroll
        for (int rg = 0; rg < 4; ++rg) {
            const int d = (2 * dh + q) * 32 + 8 * rg + 4 * hi;
            const f16x4 u = *(const f16x4*)(up + d);
            const f32x4 g = *(const f32x4*)(g_sgu + h * SHD + d);
            u32x2 o;
            o.x = pk_h2((float)u[0] * (g[0] * acc[q][4 * rg + 0] + bias), (float)u[1] * (g[1] * acc[q][4 * rg + 1] + bias));
            o.y = pk_h2((float)u[2] * (g[2] * acc[q][4 * rg + 2] + bias), (float)u[3] * (g[3] * acc[q][4 * rg + 3] + bias));
            *(u32x2*)(op + d) = o;
        }
    __syncthreads();
}

constexpr int SL = 32, NCH = T / SL;
struct SsmTabs { half_t* ktab; half_t* et; half_t* ft; float* xend; half_t* xin; };

__device__ __forceinline__ void ssm_tables_item(LAS unsigned char* lds, const float* lam_re, const float* lam_im, const float* log_dt, const float* b_re, const float* b_im,
                                                const float* c_re, const float* c_im, const float* d_skip, const SsmTabs& tb, int g, int part, int tid) {
    LAS f32x2* pw = (LAS f32x2*)lds; LAS f32x2* bb = pw + 33 * 64; LAS f32x2* cc = bb + 64 * 16;
    const float dt = expf(log_dt[g]); const float idt = 1.0f / dt;
    {
        const int p = tid & 63, part = tid >> 6;
        const float are = lam_re[g * NP + p], aim = lam_im[g * NP + p];
#pragma unroll 1
        for (int k = part; k <= 32; k += 8) {
            const double ang = (double)aim * (double)dt * (double)k;
            const float e = expf(are * dt * (float)k);
            pw[k * 64 + p] = (f32x2){e * (float)cos(ang), e * (float)sin(ang)};
        }
        const double ang1 = (double)aim * (double)dt;
        const float e1 = expf(are * dt); const float lr = e1 * (float)cos(ang1), li = e1 * (float)sin(ang1);
        const float nr = lr - 1.f, ni = li, den = are * are + aim * aim;
        const float fr = (nr * are + ni * aim) / den * idt, fi = (ni * are - nr * aim) / den * idt;
#pragma unroll
        for (int q = 0; q < 2; ++q) { const int h = part * 2 + q; const float br = b_re[(g * NP + p) * SG + h], bi = b_im[(g * NP + p) * SG + h];
            bb[p * 16 + h] = (f32x2){fr * br - fi * bi, fr * bi + fi * br}; }
#pragma unroll
        for (int q = 0; q < 2; ++q) { const int i = tid * 2 + q; cc[i] = (f32x2){c_re[g * 1024 + i], c_im[g * 1024 + i]}; }
    }
    __syncthreads();
    half_t* kt = tb.ktab + (size_t)g * 33 * 256;
    if (part == 0 && tid < 256) kt[tid] = (_Float16)0.f;
#pragma unroll 1
    for (int j = part * 2; j < part * 2 + 2; ++j) {
        const int idx = j * 512 + tid, lag = idx >> 8, h = (idx >> 4) & 15, h2 = idx & 15;
        float acc = 0.f;
#pragma unroll 4
        for (int p = 0; p < 64; ++p) {
            const f32x2 c = cc[h * 64 + p], w = pw[lag * 64 + p], b = bb[p * 16 + h2];
            const float zr = c.x * w.x - c.y * w.y, zi = c.x * w.y + c.y * w.x;
            acc += zr * b.x - zi * b.y;
        }
        if (lag == 0 && h == h2) acc += d_skip[g * SG + h] * idt;
        kt[(lag + 1) * 256 + h * 16 + h2] = (_Float16)acc;
    }
    half_t* et = tb.et + (size_t)g * 128 * 512;
#pragma unroll 2
    for (int j = part * 4; j < part * 4 + 4; ++j) {
        const int idx = j * 512 + tid, hp = idx & 7, s = (idx >> 3) & 31, p = idx >> 8;
        const f32x2 w = pw[(31 - s) * 64 + p], b0 = bb[p * 16 + hp * 2], b1 = bb[p * 16 + hp * 2 + 1];
        *(unsigned*)(et + (size_t)p * 512 + s * 16 + hp * 2) = pk_h2(w.x * b0.x - w.y * b0.y, w.x * b1.x - w.y * b1.y);
        *(unsigned*)(et + (size_t)(64 + p) * 512 + s * 16 + hp * 2) = pk_h2(w.x * b0.y + w.y * b0.x, w.x * b1.y + w.y * b1.x);
    }
    half_t* ft = tb.ft + (size_t)g * 512 * 128;
#pragma unroll 2
    for (int j = part * 4; j < part * 4 + 4; ++j) {
        const int idx = j * 512 + tid, pp = idx & 31, h = (idx >> 5) & 15, t = idx >> 9;
        const f32x2 c0 = cc[h * 64 + pp * 2], c1 = cc[h * 64 + pp * 2 + 1], w0 = pw[(t + 1) * 64 + pp * 2], w1 = pw[(t + 1) * 64 + pp * 2 + 1];
        *(unsigned*)(ft + (size_t)(t * 16 + h) * 128 + pp * 2) = pk_h2(c0.x * w0.x - c0.y * w0.y, c1.x * w1.x - c1.y * w1.y);
        *(unsigned*)(ft + (size_t)(t * 16 + h) * 128 + 64 + pp * 2) = pk_h2(-(c0.x * w0.y + c0.y * w0.x), -(c1.x * w1.y + c1.y * w1.x));
    }
    __syncthreads();
}

__device__ __forceinline__ void ssm_pass1_item(const half_t* __restrict__ PROJ16, const SsmTabs& tb, int g, int q, int cbk, int lane) {
    asm volatile("" : "+v"(lane));
    const int c31 = lane & 31, hi = lane >> 5;
    const half_t* ap = tb.et + ((size_t)g * 128 + cbk * 32 + c31) * 512 + 8 * hi;
    const half_t* bp = PROJ16 + (size_t)((q * 32 + c31) * SL) * INC + g * SG + 8 * hi;
    f32x16 acc = {0.f, 0.f, 0.f, 0.f, 0.f, 0.f, 0.f, 0.f, 0.f, 0.f, 0.f, 0.f, 0.f, 0.f, 0.f, 0.f};
#pragma unroll 16
    for (int ks = 0; ks < 32; ++ks) {
        const f16x8 a = *(const f16x8*)(ap + 16 * ks);
        const f16x8 b = *(const f16x8*)(bp + (size_t)ks * INC);
        acc = __builtin_amdgcn_mfma_f32_32x32x16_f16(a, b, acc, 0, 0, 0);
    }
    float* xp = tb.xend + ((size_t)g * NCH + q * 32 + c31) * 128 + cbk * 32 + 4 * hi;
#pragma unroll
    for (int rg = 0; rg < 4; ++rg) *(f32x4*)(xp + 8 * rg) = (f32x4){acc[4 * rg], acc[4 * rg + 1], acc[4 * rg + 2], acc[4 * rg + 3]};
}

__device__ __forceinline__ void ssm_scan_wg(LAS unsigned char* lds, const float* lam_re, const float* lam_im, const float* log_dt, const SsmTabs& tb, int bg, int tid) {
    asm volatile("" : "+v"(tid));
    const int p = tid & 63, seg = tid >> 6, g = bg & 31, b = bg >> 5;
    LAS f32x2* tot = (LAS f32x2*)lds;
    const float are = lam_re[g * NP + p], aim = lam_im[g * NP + p];
    const float dt = expf(log_dt[g]);
    const double ang = (double)aim * (double)dt * 32.0;
    const float e = expf(are * dt * 32.f);
    const float Lr = e * (float)cos(ang), Li = e * (float)sin(ang);
    const float* xe = tb.xend + ((size_t)g * NCH + b * 128 + seg * 16) * 128 + p;
    half_t* xi = tb.xin + ((size_t)g * NCH + b * 128 + seg * 16) * 128 + p;
    float er[16], ei[16];
#pragma unroll
    for (int j = 0; j < 16; ++j) { er[j] = xe[(size_t)j * 128]; ei[j] = xe[(size_t)j * 128 + 64]; }
    float cr = 0.f, ci = 0.f;
#pragma unroll
    for (int j = 0; j < 16; ++j) {
        const float xr = er[j], xim = ei[j];
        er[j] = cr; ei[j] = ci;
        const float nr = Lr * cr - Li * ci + xr, ni = Lr * ci + Li * cr + xim;
        cr = nr; ci = ni;
    }
    tot[seg * 64 + p] = (f32x2){cr, ci};
    float Pr = Lr, Pi = Li;
#pragma unroll
    for (int k = 0; k < 4; ++k) { const float nr = Pr * Pr - Pi * Pi, ni = 2.f * Pr * Pi; Pr = nr; Pi = ni; }
    __syncthreads();
    float kr = 0.f, ki = 0.f;
    for (int s2 = 0; s2 < seg; ++s2) { const f32x2 t = tot[s2 * 64 + p]; const float nr = Pr * kr - Pi * ki + t.x, ni = Pr * ki + Pi * kr + t.y; kr = nr; ki = ni; }
#pragma unroll
    for (int j = 0; j < 16; ++j) {
        xi[(size_t)j * 128] = (_Float16)(er[j] + kr); xi[(size_t)j * 128 + 64] = (_Float16)(ei[j] + ki);
        const float nr = Lr * kr - Li * ki, ni = Lr * ki + Li * kr; kr = nr; ki = ni;
    }
    __syncthreads();
}

__device__ __forceinline__ void ssm_pass2_item(const LAS half_t* ktl, const half_t* __restrict__ PROJ16, const SsmTabs& tb, const float* log_dt, half_t* YSG16, int g, int q, int qq, int lane) {
    asm volatile("" : "+v"(lane));
    const int c31 = lane & 31, hi = lane >> 5;
    const int cbs[4] = {qq, 7 - qq, 8 + qq, 15 - qq};
    const int tl = c31 >> 4, h = c31 & 15;
    const LAS half_t* kt = ktl + h * 16 + 8 * hi;
    const half_t* bp = PROJ16 + (size_t)((q * 32 + c31) * SL) * INC + g * SG + 8 * hi;
    f32x16 acc[4];
#pragma unroll
    for (int j = 0; j < 4; ++j) acc[j] = (f32x16){0.f, 0.f, 0.f, 0.f, 0.f, 0.f, 0.f, 0.f, 0.f, 0.f, 0.f, 0.f, 0.f, 0.f, 0.f, 0.f};
#pragma unroll 8
    for (int ks = 0; ks < 32; ++ks) {
        const f16x8 b = *(const f16x8*)(bp + (size_t)ks * INC);
#pragma unroll
        for (int j = 0; j < 4; ++j) {
            int lag = 2 * cbs[j] + tl - ks; lag = lag < -1 ? -1 : lag;
            const f16x8 a = *(const LAS f16x8*)(kt + (lag + 1) * 256);
            acc[j] = __builtin_amdgcn_mfma_f32_32x32x16_f16(a, b, acc[j], 0, 0, 0);
        }
    }
    const half_t* xp = tb.xin + ((size_t)g * NCH + q * 32 + c31) * 128 + 8 * hi;
#pragma unroll
    for (int kk = 0; kk < 8; ++kk) {
        const f16x8 b = *(const f16x8*)(xp + 16 * kk);
#pragma unroll
        for (int j = 0; j < 4; ++j) {
            const f16x8 a = *(const f16x8*)(tb.ft + ((size_t)g * 512 + cbs[j] * 32 + c31) * 128 + 16 * kk + 8 * hi);
            acc[j] = __builtin_amdgcn_mfma_f32_32x32x16_f16(a, b, acc[j], 0, 0, 0);
        }
    }
    const float dt = expf(log_dt[g]);
    half_t* yp = YSG16 + (size_t)((q * 32 + c31) * SL) * SSMW + g * SG;
#pragma unroll
    for (int j = 0; j < 4; ++j)
#pragma unroll
        for (int rg = 0; rg < 4; ++rg) {
            const int t = 2 * cbs[j] + (rg >> 1), hh = 8 * (rg & 1) + 4 * hi;
            u32x2 o; o.x = pk_h2(fast_gelu(dt * acc[j][4 * rg]), fast_gelu(dt * acc[j][4 * rg + 1])); o.y = pk_h2(fast_gelu(dt * acc[j][4 * rg + 2]), fast_gelu(dt * acc[j][4 * rg + 3]));
            *(u32x2*)(yp + (size_t)t * SSMW + hh) = o;
        }
}

constexpr int MOE_TILES_OFF = RING_BYTES + 4096, MOE_MAXTILES = 192, MOE_NT_OFF = MOE_TILES_OFF + MOE_MAXTILES * 16, MOE_RIDX_OFF = MOE_NT_OFF + 256, MOE_RIDX_CAP = 8;
typedef int i32x4 __attribute__((ext_vector_type(4)));
struct RouteBufs { int* eid; float* ew; int* posOf; float* rsT; float* rsrow; int* wghist; const half_t* wrt_hi; const half_t* wrt_lo; };

__device__ __forceinline__ void route_block(LAS unsigned char* lds, const half_t* __restrict__ H16, const RouteBufs& rb, const float* b_group, const float* b_router, int tb, int tid, int wave, int lane) {
    asm volatile("" : "+v"(tid), "+v"(lane));
    LAS float* part = (LAS float*)lds;
    LAS float* lg   = (LAS float*)(lds + 32768);
    LAS float* rsl  = (LAS float*)(lds + 65536);
    LAS float* ssp  = (LAS float*)(lds + 65536 + 256);
    LAS int*   hist = (LAS int*)(lds + 65536 + 512);
    if (tid < 64) hist[tid] = 0;
    const int it = wave >> 1, kh = wave & 1, fr = lane & 15, fq = lane >> 4;
    const int tok0 = tb * 64 + it * 16;
    const half_t* hp = H16 + (size_t)(tok0 + fr) * DM + kh * 512 + 8 * fq;
    const half_t* wh = rb.wrt_hi + (size_t)fr * DM + kh * 512 + 8 * fq;
    const half_t* wl = rb.wrt_lo + (size_t)fr * DM + kh * 512 + 8 * fq;
    f32x4 acc[5];
#pragma unroll
    for (int nb = 0; nb < 5; ++nb) acc[nb] = (f32x4){0.f, 0.f, 0.f, 0.f};
    float ss = 0.f;
#pragma unroll 4
    for (int ks = 0; ks < 16; ++ks) {
        const f16x8 xh = *(const f16x8*)(hp + 32 * ks);
#pragma unroll
        for (int j = 0; j < 8; ++j) { const float f = (float)xh[j]; ss += f * f; }
#pragma unroll
        for (int nb = 0; nb < 5; ++nb) {
            const f16x8 bh = *(const f16x8*)(wh + (size_t)nb * 16 * DM + 32 * ks), bl = *(const f16x8*)(wl + (size_t)nb * 16 * DM + 32 * ks);
            acc[nb] = __builtin_amdgcn_mfma_f32_16x16x32_f16(xh, bh, acc[nb], 0, 0, 0);
            acc[nb] = __builtin_amdgcn_mfma_f32_16x16x32_f16(xh, bl, acc[nb], 0, 0, 0);
        }
    }
    ss += __shfl_xor(ss, 16); ss += __shfl_xor(ss, 32);
    if (kh == 1) {
        LAS float* pp = part + (it * 64 + lane) * 24;
#pragma unroll
        for (int nb = 0; nb < 5; ++nb) *(LAS f32x4*)(pp + 4 * nb) = acc[nb];
        if (fq == 0) ssp[it * 16 + fr] = ss;
    }
    __syncthreads();
    if (kh == 0) {
        const LAS float* pp = part + (it * 64 + lane) * 24;
#pragma unroll
        for (int nb = 0; nb < 5; ++nb) acc[nb] += *(const LAS f32x4*)(pp + 4 * nb);
        if (fq == 0) { const float tot = ss + ssp[it * 16 + fr]; const float rs = 1.0f / sqrtf(tot * (1.f / 1024.f) + EPS); rsl[it * 16 + fr] = rs; rb.rsT[tok0 + fr] = rs; }
        LDS_WAIT();
#pragma unroll
        for (int nb = 0; nb < 5; ++nb) {
            const int n = nb * 16 + fr;
            const float bias = (n < 64) ? b_router[n] : ((n < 72) ? b_group[n - 64] : 0.f);
#pragma unroll
            for (int r = 0; r < 4; ++r) { const int tk = 4 * fq + r; lg[(it * 16 + tk) * 80 + n] = acc[nb][r] * rsl[it * 16 + tk] * (1.f / 64.f) + bias; }
        }
        LDS_WAIT();
        if (lane < 16) {
            const LAS float* l = lg + (it * 16 + lane) * 80;
            int gi = 0; float gm = l[64];
#pragma unroll
            for (int g = 1; g < 8; ++g) { const float v = l[64 + g]; if (v > gm) { gm = v; gi = g; } }
            float den = 0.f;
#pragma unroll
            for (int g = 0; g < 8; ++g) den += expf(l[64 + g] - gm);
            const float gw = 1.f / den;
            const LAS float* el = l + gi * 8;
            int i0 = 0; float v0 = el[0];
#pragma unroll
            for (int e = 1; e < 8; ++e) { const float v = el[e]; if (v > v0) { v0 = v; i0 = e; } }
            int i1 = -1; float v1 = -3.0e38f;
#pragma unroll
            for (int e = 0; e < 8; ++e) { const float v = el[e]; if (e != i0 && v > v1) { v1 = v; i1 = e; } }
            const float w0 = 1.f / (1.f + expf(v1 - v0)), w1 = 1.f - w0;
            const int e0 = gi * 8 + i0, e1 = gi * 8 + i1, tok = tok0 + lane;
            rb.eid[tok * 2] = e0; rb.eid[tok * 2 + 1] = e1;
            rb.ew[tok * 2] = gw * w0; rb.ew[tok * 2 + 1] = gw * w1;
            __hip_atomic_fetch_add(&hist[e0], 1, __ATOMIC_RELAXED, __HIP_MEMORY_SCOPE_WORKGROUP); __hip_atomic_fetch_add(&hist[e1], 1, __ATOMIC_RELAXED, __HIP_MEMORY_SCOPE_WORKGROUP);
        }
    }
    __syncthreads();
    if (tid < 64) rb.wghist[tb * 64 + tid] = hist[tid];
    __syncthreads();
}

__device__ __forceinline__ void gather_block(LAS unsigned char* lds, const RouteBufs& rb, int* srcTok, int tb, bool do_rows, int tid, int wave, int lane) {
    asm volatile("" : "+v"(tid), "+v"(lane));
    LAS int* psumA = (LAS int*)lds;
    LAS int* psumP = psumA + 512;
    LAS int* base  = psumP + 512;
    LAS int* lcur  = base + 64;
    LAS i32x4* tiles = (LAS i32x4*)(lds + MOE_TILES_OFF);
    LAS int* ntl = (LAS int*)(lds + MOE_NT_OFF);
    {
        const int e = tid & 63, part = tid >> 6; int sa = 0, sp = 0;
#pragma unroll 4
        for (int w = part * 32; w < part * 32 + 32; ++w) { const int v = rb.wghist[w * 64 + e]; sa += v; sp += (w < tb) ? v : 0; }
        psumA[part * 64 + e] = sa; psumP[part * 64 + e] = sp;
    }
    __syncthreads();
    if (wave == 0) {
        int tot = 0, pre = 0;
#pragma unroll
        for (int p = 0; p < 8; ++p) { tot += psumA[p * 64 + lane]; pre += psumP[p * 64 + lane]; }
        const int nt = (tot + 255) >> 8;
        int rs_incl = tot, ts_incl = nt;
#pragma unroll
        for (int o = 1; o < 64; o <<= 1) { const int a = __shfl_up(rs_incl, o), b = __shfl_up(ts_incl, o); if (lane >= o) { rs_incl += a; ts_incl += b; } }
        const int rstart = rs_incl - tot, tstart = ts_incl - nt;
        base[lane] = rstart + pre; lcur[lane] = 0;
        for (int j = 0; j < nt; ++j) { const int rem = tot - 256 * j; if (tstart + j < MOE_MAXTILES) tiles[tstart + j] = (i32x4){lane, rstart + 256 * j, rem < 256 ? rem : 256, 0}; }
        if (lane == 63) ntl[0] = ts_incl < MOE_MAXTILES ? ts_incl : MOE_MAXTILES;
    }
    __syncthreads();
    if (do_rows) {
        if (lane < 16) {
            const int a = wave * 16 + lane, t = tb * 64 + (a >> 1), k = a & 1;
            const int e = rb.eid[t * 2 + k];
            const int pos = base[e] + __hip_atomic_fetch_add(&lcur[e], 1, __ATOMIC_RELAXED, __HIP_MEMORY_SCOPE_WORKGROUP);
            rb.posOf[t * 2 + k] = pos; rb.rsrow[pos] = rb.rsT[t]; srcTok[pos] = t;
        }
    }
    __syncthreads();
}

template <int NT>
__device__ __forceinline__ void final_tokens(const half_t* __restrict__ H16, const half_t* __restrict__ YS16, const RouteBufs& rb, const float* g_final, float* out, int tok0, int stride, int lane) {
    f32x4 hv[NT][4]; f16x4 hh[NT][4], av[NT][4], bv[NT][4]; float w0[NT], w1[NT];
#pragma unroll
    for (int i = 0; i < NT; ++i) {
        const int tok = tok0 + i * stride;
        const int p0 = rb.posOf[tok * 2], p1 = rb.posOf[tok * 2 + 1];
        w0[i] = rb.ew[tok * 2]; w1[i] = rb.ew[tok * 2 + 1];
#pragma unroll
        for (int j = 0; j < 4; ++j) { const int c = 4 * lane + 256 * j;
            hh[i][j] = *(const f16x4*)(H16 + (size_t)tok * DM + c);
            av[i][j] = *(const f16x4*)(YS16 + (size_t)p0 * DM + c); bv[i][j] = *(const f16x4*)(YS16 + (size_t)p1 * DM + c); }
    }
#pragma unroll
    for (int i = 0; i < NT; ++i) {
        const int tok = tok0 + i * stride; float s = 0.f;
#pragma unroll
        for (int j = 0; j < 4; ++j)
#pragma unroll
            for (int q = 0; q < 4; ++q) { hv[i][j][q] = (float)hh[i][j][q] + (w0[i] * (float)av[i][j][q] + w1[i] * (float)bv[i][j][q]); s += hv[i][j][q] * hv[i][j][q]; }
        const float rs = 1.0f / sqrtf(wave_sum(s) * (1.f / 1024.f) + EPS);
#pragma unroll
        for (int j = 0; j < 4; ++j) { const int c = 4 * lane + 256 * j; const f32x4 g = *(const f32x4*)(g_final + c); *(f32x4*)(out + (size_t)tok * DM + c) = hv[i][j] * rs * g; }
    }
}

namespace pg {
struct OrderMoe {
    const LAS i32x4* tiles; int nunits, G, c; const char* A; size_t rowA; const char* B; size_t expB, tileB; bool gather;
    __device__ bool next(int i, Unit& u) const {
        const int L = i * G + c; if (L >= nunits) return false;
        const i32x4 t = tiles[L >> 2];
        u.pm = t.y; u.pn = L & 3; u.aux = t.z;
        u.A = A + (size_t)(gather ? 0 : t.y) * rowA; u.B = B + (size_t)t.x * expB + (size_t)(L & 3) * tileB; return true;
    }
};
struct EpiUp {
    static constexpr bool PERM = true;
    half_t* O; const float* rsrow;
    __device__ __forceinline__ void operator()(const f32x4 (&acc)[2][2][4][2], const Unit& u, int wr, int wc, int fr, int fq) const {
        const int col0 = u.pn * HALF + wc * 32 + 8 * fq;
#pragma unroll
        for (int ai = 0; ai < 2; ++ai)
#pragma unroll
            for (int m = 0; m < 4; ++m) {
                const int rl = ai * HALF + wr * 64 + m * 16 + fr;
                if (rl < u.aux) {
                    const float rs = rsrow[u.pm + rl];
                    const f32x4 a0 = acc[ai][0][m][0] * rs, a1 = acc[ai][0][m][1] * rs, b0 = acc[ai][1][m][0] * rs, b1 = acc[ai][1][m][1] * rs;
                    u32x4 w; w.x = pk_h2(a0[0] * fast_sigmoid(a0[0]) * b0[0], a0[1] * fast_sigmoid(a0[1]) * b0[1]); w.y = pk_h2(a0[2] * fast_sigmoid(a0[2]) * b0[2], a0[3] * fast_sigmoid(a0[3]) * b0[3]);
                    w.z = pk_h2(a1[0] * fast_sigmoid(a1[0]) * b1[0], a1[1] * fast_sigmoid(a1[1]) * b1[1]); w.w = pk_h2(a1[2] * fast_sigmoid(a1[2]) * b1[2], a1[3] * fast_sigmoid(a1[3]) * b1[3]);
                    *(u32x4*)(O + (size_t)(u.pm + rl) * DFF + col0) = w; } }
    }
};
struct EpiDown {
    static constexpr bool PERM = true;
    half_t* O;
    __device__ __forceinline__ void operator()(const f32x4 (&acc)[2][2][4][2], const Unit& u, int wr, int wc, int fr, int fq) const {
        const int col0 = u.pn * BM + wc * 32 + 8 * fq;
#pragma unroll
        for (int ai = 0; ai < 2; ++ai)
#pragma unroll
            for (int m = 0; m < 4; ++m) {
                const int rl = ai * HALF + wr * 64 + m * 16 + fr;
                if (rl < u.aux) {
#pragma unroll
                    for (int bj = 0; bj < 2; ++bj) { const f32x4 v0 = acc[ai][bj][m][0], v1 = acc[ai][bj][m][1];
                        u32x4 w; w.x = pk_h2(v0[0], v0[1]); w.y = pk_h2(v0[2], v0[3]); w.z = pk_h2(v1[0], v1[1]); w.w = pk_h2(v1[2], v1[3]);
                        *(u32x4*)(O + (size_t)(u.pm + rl) * DM + col0 + bj * HALF) = w; } } }
    }
};
}

constexpr size_t MiB = 1u << 20;
constexpr int CW_BAR = 4096;
constexpr size_t WS_CTL = 0, CTL_ZERO_BYTES = 1 * MiB;
constexpr size_t WS_K16 = 1 * MiB, WS_VT16 = 2 * MiB, WS_KTAB = 3 * MiB;
constexpr size_t WS_ROUTE = 4 * MiB;
constexpr size_t WS_WRT = 5 * MiB;
constexpr size_t WS_VSQ = 5 * MiB + 384 * 1024, WS_WSP16 = 5 * MiB + 896 * 1024;
constexpr size_t WS_MEMN16 = 6 * MiB;
constexpr size_t WS_ET = 8 * MiB, WS_FT = 12 * MiB, WS_XEND = 16 * MiB, WS_XIN = 24 * MiB;
constexpr size_t WS_WINT = 28 * MiB, WS_WGATET = 32 * MiB, WS_WGLUT = 38 * MiB, WS_WKVT = 39 * MiB, WS_WBRT = 41 * MiB, WS_WOUTT = 44 * MiB;
constexpr size_t WS_W13T = 46 * MiB, WS_W2T = 174 * MiB;
constexpr size_t WS_PROJ16 = 238 * MiB, WS_XS16 = 238 * MiB;
constexpr size_t WS_G16 = 303 * MiB, WS_YS16 = 303 * MiB;
constexpr size_t WS_N16 = 399 * MiB, WS_MERGED16 = 399 * MiB, WS_H16 = 399 * MiB;
constexpr size_t WS_CAT16 = 432 * MiB, WS_YSG16 = 480 * MiB, WS_HT16 = 432 * MiB;
constexpr size_t WS_END = 496 * MiB;

struct Args { const float* in[32]; float* out; unsigned char* ws; int ph_lo, ph_hi, li, pad; };
struct Frame { LAS unsigned char* lds; volatile LAS unsigned* MISC; unsigned* ctl; int tid, lane, wave, vcu, G; };

__device__ __forceinline__ SsmTabs make_tabs(unsigned char* ws) { SsmTabs t; t.ktab = (half_t*)(ws + WS_KTAB); t.et = (half_t*)(ws + WS_ET); t.ft = (half_t*)(ws + WS_FT); t.xend = (float*)(ws + WS_XEND); t.xin = (half_t*)(ws + WS_XIN); return t; }
__device__ __forceinline__ RouteBufs make_route(unsigned char* ws) {
    RouteBufs r; unsigned char* b = ws + WS_ROUTE;
    r.eid = (int*)b; r.ew = (float*)(b + 131072); r.posOf = (int*)(b + 262144); r.rsT = (float*)(b + 393216); r.rsrow = (float*)(b + 458752); r.wghist = (int*)(b + 655360);
    r.wrt_hi = (const half_t*)(ws + WS_WRT); r.wrt_lo = (const half_t*)(ws + WS_WRT + 163840); return r;
}

__device__ __forceinline__ void p0_prologue(const Frame& F, const Args& a) {
    { const SsmTabs tb = make_tabs(a.ws);
#ifndef P0_REP_TAB
#define P0_REP_TAB 1
#endif
      for (int rr = 0; rr < P0_REP_TAB; ++rr) for (int wi = F.vcu; wi < NG * 8; wi += F.G) ssm_tables_item(F.lds, a.in[7], a.in[8], a.in[9], a.in[10], a.in[11], a.in[12], a.in[13], a.in[14], tb, wi >> 3, wi & 7, F.tid); }
    LAS float* scr = (LAS float*)(F.lds + RING_OFF + F.wave * 16384);
    const int gw = F.vcu * NWAVES + F.wave, NGW = F.G * NWAVES;
    {
        half_t* whi = (half_t*)(a.ws + WS_WRT); half_t* wlo = (half_t*)(a.ws + WS_WRT + 163840);
        for (int idx = gw * 64 + F.lane; idx < 80 * DM; idx += NGW * 64) {
            const int n = idx >> 10, k = idx & 1023;
            float w = 0.f;
            if (n < 64) w = a.in[26][k * NE + n]; else if (n < 72) w = a.in[24][k * NGRP + (n - 64)];
            w *= 64.f * a.in[23][k];
            const _Float16 h = (_Float16)w; whi[idx] = h; wlo[idx] = (_Float16)(w - (float)h);
        }
    }
    { half_t* wsp = (half_t*)(a.ws + WS_WSP16);
      for (int idx = gw * 64 + F.lane; idx < SH * CHUNK * CHUNK; idx += NGW * 64) { const int s = idx & 127, t = (idx >> 7) & 127; wsp[idx] = (_Float16)(s <= t ? a.in[18][idx] : 0.f); } }
#pragma unroll 1
    for (int j = 0; j < 8; ++j) {
        const float* W; int ldw, K, N, mode = 0; half_t* WT;
        switch (j) {
            case 0: W = a.in[4];  ldw = INC;  K = DM;  N = INC;  WT = (half_t*)(a.ws + WS_WINT); break;
            case 1: W = a.in[20]; ldw = 1024; K = DM;  N = 1024; WT = (half_t*)(a.ws + WS_WKVT); break;
            case 2: W = a.in[5];  ldw = 3072; K = DM;  N = 3072; WT = (half_t*)(a.ws + WS_WGATET); break;
            case 3: W = a.in[15]; ldw = 1024; K = 512; N = 1024; WT = (half_t*)(a.ws + WS_WGLUT); mode = 1; break;
            case 4: W = a.in[21];                     ldw = 1024; K = 512; N = 1024; WT = (half_t*)(a.ws + WS_WBRT); break;
            case 5: W = a.in[21] + 512 * 1024;        ldw = 1024; K = 512; N = 1024; WT = (half_t*)(a.ws + WS_WBRT) + 1024 * 512; break;
            case 6: W = a.in[21] + 2 * 512 * 1024;    ldw = 1024; K = 512; N = 1024; WT = (half_t*)(a.ws + WS_WBRT) + 2 * 1024 * 512; break;
            default: W = a.in[22]; ldw = 1024; K = DM; N = 1024; WT = (half_t*)(a.ws + WS_WOUTT); break;
        }
        const int nblk = N / 32, items = (K / 64) * nblk;
#pragma unroll 1
        for (int it = gw; it < items; it += NGW) {
            const int kb = it / nblk, nb = it % nblk, n0 = nb * 32;
            int drow = n0;
            if (mode == 1) { const int half = n0 >> 9, jj = n0 & 511; drow = (jj >> 7) * 256 + half * 128 + (jj & 127); }
            transpose_item(W, ldw, kb * 64, n0, WT, K, drow, scr, F.lane);
        }
    }
    half_t* MEMN16 = (half_t*)(a.ws + WS_MEMN16);
    for (int m = gw; m < MROWS; m += NGW) rms_row_to_f16(a.in[1] + (size_t)m * DM, a.in[3], MEMN16 + (size_t)m * DM, F.lane);
    half_t* N16 = (half_t*)(a.ws + WS_N16);
#ifndef P0_REP_N16
#define P0_REP_N16 1
#endif
    for (int m = gw; m < P0_REP_N16 * T; m += NGW) rms_row_to_f16(a.in[0] + (size_t)(m % T) * DM, a.in[2], N16 + (size_t)(m % T) * DM, F.lane);
    {
        half_t* W13T = (half_t*)(a.ws + WS_W13T); half_t* W2T = (half_t*)(a.ws + WS_W2T);
#ifndef P0_REP_EXP
#define P0_REP_EXP 1
#endif
#pragma unroll 1
        for (int it = gw; it < P0_REP_EXP * NE * 768; it += NGW) {
            const int e = (it / 768) % NE, r = it % 768, which = r >> 8, q = r & 255;
            if (which < 2) {
                const int kb = q >> 4, nb = q & 15, n0 = nb * 32;
                const float* W = (which == 0 ? a.in[28] : a.in[29]) + (size_t)e * DM * DFF;
                transpose_item(W, DFF, kb * 64, n0, W13T + (size_t)e * 1024 * 1024, 1024, (n0 >> 7) * 256 + which * 128 + (n0 & 127), scr, F.lane, a.in[23]);
            } else {
                const int kb = q >> 5, nb = q & 31, n0 = nb * 32;
                transpose_item(a.in[30] + (size_t)e * DFF * DM, DM, kb * 64, n0, W2T + (size_t)e * 1024 * 512, 512, n0, scr, F.lane);
            }
        }
    }
}

__global__ void __launch_bounds__(NWAVES * 64, 2) mk_fwd(Args args) {
    extern __shared__ __attribute__((aligned(16))) unsigned char lds[];
    Frame F;
    F.lds = (LAS unsigned char*)lds;
    F.MISC = (volatile LAS unsigned*)(F.lds + MISC_OFF);
    F.tid = threadIdx.x; F.lane = F.tid & 63; F.wave = __builtin_amdgcn_readfirstlane(F.tid >> 6);
    F.G = gridDim.x; { const int bx = blockIdx.x; F.vcu = (F.G % 8 == 0) ? (bx % 8) * (F.G / 8) + bx / 8 : bx; }
    F.ctl = (unsigned*)(args.ws + WS_CTL);
    for (int u = F.tid; u < (LDS_BYTES - LDSCTL_OFF) / 4; u += NWAVES * 64) ((LAS unsigned*)(F.lds + LDSCTL_OFF))[u] = 0u;
    __syncthreads();
    XcdBarrier bar = xcd_barrier_post(F.ctl + CW_BAR + args.li * XCD_BAR_WORDS, F.MISC + 8);
    const int lo = args.ph_lo, hi = args.ph_hi;
    unsigned char* ws = args.ws;
    const int gw = F.vcu * NWAVES + F.wave, NGW = F.G * NWAVES;
#define IN(k) (lo <= (k) && (k) < hi)
#define BOTH(k) (IN(k) && IN((k) + 1))
    if (IN(0)) { p0_prologue(F, args); if (BOTH(0)) xcd_barrier(bar); }
    if (IN(1)) {
        pg::OrderMN S; S.init(T, INC, F.G, (int)blockIdx.x, ws + WS_N16, DM, ws + WS_WINT, DM);
        pg::EpiProj E{(half_t*)(ws + WS_PROJ16), INC, (float*)(ws + WS_VSQ)};
        pg::gemm_phase<pg::EpiProj, pg::OrderMN, true, false>(F.lds + RING_OFF, DM, DM, DM / 64, S, E);
        for (int t = F.vcu; t < 256; t += F.G) kv_tile((const half_t*)(ws + WS_MEMN16), (const half_t*)(ws + WS_WKVT), (half_t*)(ws + WS_K16), (half_t*)(ws + WS_VT16), t, F.wave, F.lane);
        if (BOTH(1)) xcd_barrier(bar);
    }
    if (IN(2)) {
        const SsmTabs tb = make_tabs(ws);
        for (int gwi = gw; gwi < 2048; gwi += NGW) ssm_pass1_item((const half_t*)(ws + WS_PROJ16), tb, gwi >> 6, (gwi >> 2) & 15, gwi & 3, F.lane);
        if (BOTH(2)) xcd_barrier(bar);
    }
    if (IN(3)) {
        { const SsmTabs tb = make_tabs(ws);
          for (int bg = (F.G - 1 - F.vcu); bg < BATCH * NG; bg += F.G) ssm_scan_wg(F.lds, args.in[7], args.in[8], args.in[9], tb, bg, F.tid); }
#ifndef P3_REP_ATT
#define P3_REP_ATT 1
#endif
#ifndef P3_REP_SP
#define P3_REP_SP 1
#endif
        for (int rr = 0; rr < P3_REP_ATT; ++rr) for (int u = F.vcu; u < 256; u += F.G)
            attn_unit(F.lds, (const half_t*)(ws + WS_PROJ16), (const half_t*)(ws + WS_K16), (const half_t*)(ws + WS_VT16), (half_t*)(ws + WS_CAT16), (u >> 4) >> 2, (u >> 4) & 3, u & 15, F.tid, F.wave, F.lane);
        for (int rr = 0; rr < P3_REP_SP; ++rr) for (int u = F.vcu; u < 512; u += F.G)
            spatial_unit(F.lds, (const half_t*)(ws + WS_PROJ16), (const float*)(ws + WS_VSQ), (const half_t*)(ws + WS_WSP16), args.in[19], args.in[17], (half_t*)(ws + WS_CAT16), u >> 2, u & 3, F.tid, F.wave, F.lane);
        if (BOTH(3)) xcd_barrier(bar);
    }
    if (IN(4)) {
        const SsmTabs tb = make_tabs(ws);
        for (int wgi = F.vcu; wgi < 256; wgi += F.G) {
            const int g = wgi >> 3;
            for (int i = F.tid; i < 33 * 256 / 8; i += NWAVES * 64) *(LAS u32x4*)(F.lds + i * 16) = *(const u32x4*)(tb.ktab + (size_t)g * 33 * 256 + i * 8);
            __syncthreads();
            const int gwi = wgi * 8 + F.wave;
            ssm_pass2_item((const LAS half_t*)F.lds, (const half_t*)(ws + WS_PROJ16), tb, args.in[9], (half_t*)(ws + WS_YSG16), gwi >> 6, (gwi >> 2) & 15, gwi & 3, F.lane);
            __syncthreads();
        }
        if (BOTH(4)) xcd_barrier(bar);
    }
    if (IN(5)) {
        { pg::OrderMN S; S.init(T, 1024, F.G, (int)blockIdx.x, ws + WS_YSG16, 512, ws + WS_WGLUT, 512);
          pg::EpiGlu E{(half_t*)(ws + WS_CAT16), 1536, args.in[16]};
          pg::gemm_phase<pg::EpiGlu, pg::OrderMN, true, false>(F.lds + RING_OFF, 512, 512, 8, S, E); }
        { pg::OrderMN S; S.init(T, 3072, F.G, (int)blockIdx.x, ws + WS_N16, DM, ws + WS_WGATET, DM);
          pg::EpiGate E{(half_t*)(ws + WS_G16), 3072, args.in[6]};
          pg::gemm_phase<pg::EpiGate, pg::OrderMN, true, false>(F.lds + RING_OFF, DM, DM, 16, S, E); }
        if (BOTH(5)) xcd_barrier(bar);
    }
    if (IN(6)) {
        pg::OrderBr S; S.init(F.G, (int)blockIdx.x, ws + WS_CAT16, ws + WS_WBRT);
        pg::EpiBranch E{(half_t*)(ws + WS_MERGED16), (const half_t*)(ws + WS_G16)};
        pg::gemm_phase<pg::EpiBranch, pg::OrderBr, true, false>(F.lds + RING_OFF, 1536, 512, 8, S, E);
        if (BOTH(6)) xcd_barrier(bar);
    }
    if (IN(7)) {
        pg::OrderMN S; S.init(T, 1024, F.G, (int)blockIdx.x, ws + WS_MERGED16, DM, ws + WS_WOUTT, DM);
        pg::EpiOut E{(half_t*)(ws + WS_HT16), args.in[0], DM};
        pg::gemm_phase<pg::EpiOut, pg::OrderMN, true, false>(F.lds + RING_OFF, DM, DM, 16, S, E);
        if (BOTH(7)) xcd_barrier(bar);
    }
    if (IN(8)) {
        const RouteBufs rb = make_route(ws);
        for (int tb = F.vcu; tb < 256; tb += F.G) route_block(F.lds, (const half_t*)(ws + WS_HT16), rb, args.in[25], args.in[27], tb, F.tid, F.wave, F.lane);
        if (BOTH(8)) xcd_barrier(bar);
    }
    if (IN(9)) {
        const RouteBufs rb = make_route(ws);
        bool any = false;
        for (int tb = F.vcu; tb < 256; tb += F.G) { gather_block(F.lds, rb, (int*)(ws + WS_ROUTE + 786432), tb, true, F.tid, F.wave, F.lane); any = true; }
        if (!any) gather_block(F.lds, rb, (int*)(ws + WS_ROUTE + 786432), 0, false, F.tid, F.wave, F.lane);
        if (BOTH(9)) xcd_barrier(bar);
    }
    if (IN(10)) {
        const RouteBufs rb = make_route(ws);
        const int nunits = 4 * *(const LAS int*)(F.lds + MOE_NT_OFF);
        LAS int* ridxc = (LAS int*)(F.lds + MOE_RIDX_OFF);
        { const int* srcTok = (const int*)(ws + WS_ROUTE + 786432); const LAS i32x4* tiles = (const LAS i32x4*)(F.lds + MOE_TILES_OFF);
          for (int j = 0; j < MOE_RIDX_CAP; ++j) { const int L = j * F.G + (int)blockIdx.x; if (L >= nunits) break;
              const i32x4 t = tiles[L >> 2]; if (F.tid < 256) ridxc[j * 256 + F.tid] = srcTok[t.y + (F.tid < t.z ? F.tid : 0)]; }
          __syncthreads(); }
        pg::OrderMoe S{(const LAS i32x4*)(F.lds + MOE_TILES_OFF), nunits, F.G, (int)blockIdx.x, (const char*)(ws + WS_HT16), (size_t)DM * 2, (const char*)(ws + WS_W13T), (size_t)1024 * 1024 * 2, (size_t)256 * 1024 * 2, true};
        pg::EpiUp E{(half_t*)(ws + WS_H16), rb.rsrow};
        pg::gemm_phase<pg::EpiUp, pg::OrderMoe, true, true>(F.lds + RING_OFF, DM, DM, 16, S, E, ridxc);
        if (BOTH(10)) xcd_barrier(bar);
    }
    if (IN(11)) {
        pg::OrderMoe S{(const LAS i32x4*)(F.lds + MOE_TILES_OFF), 4 * *(const LAS int*)(F.lds + MOE_NT_OFF), F.G, (int)blockIdx.x, (const char*)(ws + WS_H16), (size_t)DFF * 2, (const char*)(ws + WS_W2T), (size_t)1024 * 512 * 2, (size_t)256 * 512 * 2, false};
        pg::EpiDown E{(half_t*)(ws + WS_YS16)};
        pg::gemm_phase<pg::EpiDown, pg::OrderMoe, true, false>(F.lds + RING_OFF, DFF, DFF, 8, S, E);
        if (BOTH(11)) xcd_barrier(bar);
    }
    if (IN(12)) {
        const RouteBufs rb = make_route(ws);
        for (int tok = gw; tok < T; tok += 4 * NGW) {
            if (tok + 3 * NGW < T) final_tokens<4>((const half_t*)(ws + WS_HT16), (const half_t*)(ws + WS_YS16), rb, args.in[31], args.out, tok, NGW, F.lane);
            else for (int t2 = tok; t2 < T; t2 += NGW) final_tokens<1>((const half_t*)(ws + WS_HT16), (const half_t*)(ws + WS_YS16), rb, args.in[31], args.out, t2, NGW, F.lane);
        }
    }
#undef IN
#undef BOTH
}

extern "C" void kernel_launch(void* const* d_in, const int* in_sizes, int n_in, void* d_out, int out_size, void* d_ws, size_t ws_size, hipStream_t stream) {
    static int grid = 0;
    if (grid == 0) {
        if (n_in != 32 || ws_size < WS_END) { fprintf(stderr, "kernel_launch: unexpected inputs (n_in %d, ws %zu)\n", n_in, ws_size); grid = -1; return; }
        int dev = 0, cus = 0;
        if (hipGetDevice(&dev) != hipSuccess || hipDeviceGetAttribute(&cus, hipDeviceAttributeMultiprocessorCount, dev) != hipSuccess) { grid = -1; return; }
        if (hipFuncSetAttribute((const void*)mk_fwd, hipFuncAttributeMaxDynamicSharedMemorySize, LDS_BYTES) != hipSuccess) { grid = -1; return; }
        int per_cu = 0;
        (void)hipOccupancyMaxActiveBlocksPerMultiprocessor(&per_cu, (const void*)mk_fwd, NWAVES * 64, LDS_BYTES);
        (void)hipGetLastError();
        grid = cus;
    }
    if (grid < 0) return;
    (void)hipMemsetAsync((char*)d_ws + WS_CTL, 0, CTL_ZERO_BYTES, stream);
    Args a{};
    for (int i = 0; i < 32; ++i) a.in[i] = (const float*)d_in[i];
    a.out = (float*)d_out; a.ws = (unsigned char*)d_ws; a.ph_lo = 0; a.ph_hi = 13; a.li = 0;
#ifdef SPLIT_A_HI
    a.ph_hi = SPLIT_A_HI;
    hipLaunchKernelGGL(mk_fwd, dim3(grid), dim3(NWAVES * 64), LDS_BYTES, stream, a);
    a.ph_lo = SPLIT_B_LO; a.ph_hi = 13; a.li = 1;
#endif
    hipLaunchKernelGGL(mk_fwd, dim3(grid), dim3(NWAVES * 64), LDS_BYTES, stream, a);
}
```

```cpp
#include <hip/hip_runtime.h>
#include <cstdio>
#include <cstdint>

constexpr int BATCH = 4, SEQ = 4096, DM = 1024, T = BATCH * SEQ;
constexpr int MEML = 256, MROWS = BATCH * MEML;
constexpr int SSMW = 512, SG = 16, NG = 32, NP = 64;
constexpr int SGUW = 512, SH = 4, SHD = 128, CHUNK = 128;
constexpr int XH = 4, XD = 128, XW = 512;
constexpr int INC = 2048;
constexpr int NGRP = 8, EPG = 8, NE = 64, DFF = 512;
constexpr float EPS = 1e-6f;
constexpr int SCH = 128;
constexpr int NSC = SEQ / SCH;

#define LAS __attribute__((address_space(3)))
#define GAS __attribute__((address_space(1)))
typedef _Float16 half_t;
typedef _Float16 f16x8 __attribute__((ext_vector_type(8)));
typedef _Float16 f16x4 __attribute__((ext_vector_type(4)));
typedef _Float16 f16x2 __attribute__((ext_vector_type(2)));
typedef float f32x4 __attribute__((ext_vector_type(4)));
typedef float f32x2 __attribute__((ext_vector_type(2)));
typedef unsigned u32x4 __attribute__((ext_vector_type(4)));
typedef unsigned u32x2 __attribute__((ext_vector_type(2)));

__device__ __forceinline__ unsigned pk_h2(float lo, float hi) { f16x2 v; v.x = (_Float16)lo; v.y = (_Float16)hi; return __builtin_bit_cast(unsigned, v); }
__device__ __forceinline__ float fast_sigmoid(float x) { return __builtin_amdgcn_rcpf(1.f + __builtin_amdgcn_exp2f(-1.4426950408889634f * x)); }
__device__ __forceinline__ float fast_gelu(float x) {
    const float u = 0.7978845608028654f * (x + 0.044715f * x * x * x);
    return x * __builtin_amdgcn_rcpf(1.f + __builtin_amdgcn_exp2f(-2.885390081777927f * u));
}

namespace pg {
constexpr int BM = 256, BK = 64, HALF = 128, HTB = HALF * BK * 2, STAGE_BYTES = 8 * HTB, NXCD = 8, WGM = 8;

__host__ __device__ __forceinline__ int lds_byte(int r, int c) { const int st = (r >> 4) * 2 + (c >> 5), rr = r & 15, cc = c & 31, ob = rr * 64 + cc * 2; return st * 1024 + (ob ^ (((ob >> 9) & 1) << 5)); }
__host__ __device__ __forceinline__ void stage_rc(int b, int& R, int& C) { const int st = b / 1024, sb = b % 1024, swz = sb ^ (((sb >> 9) & 1) << 5); R = (st >> 1) * 16 + swz / 64; C = (st & 1) * 32 + (swz % 64) / 2; }
__host__ __device__ __forceinline__ int perm32(int rho) { const int n = rho >> 4, i = rho & 15; return 8 * (i >> 2) + 4 * n + (i & 3); }

struct Unit { const char* A; const char* B; int pm, pn, aux, lda, ldb, nt; };

struct OrderMN {
    int nM, nN, nwg, G, c; const char* A; const char* B; size_t tA, tB;
    __device__ void init(int M, int N, int G_, int c_, const void* A_, size_t lda, const void* B_, size_t ldb) { nM = M / BM; nN = N / BM; nwg = nM * nN; G = G_; c = c_; A = (const char*)A_; B = (const char*)B_; tA = (size_t)BM * lda * 2; tB = (size_t)BM * ldb * 2; }
    __device__ bool next(int i, Unit& u) const {
        const long L = (long)i * G + c; if (L >= nwg) return false;
        int wgid = (int)L; { const int q = nwg / NXCD, r = nwg % NXCD, xcd = wgid % NXCD, off = wgid / NXCD; wgid = (xcd < r ? xcd * (q + 1) : r * (q + 1) + (xcd - r) * q) + off; }
        const int nig = WGM * nN, gid = wgid / nig, fm = gid * WGM, gsz = (nM - fm) < WGM ? (nM - fm) : WGM;
        u.pm = fm + ((wgid % nig) % gsz); u.pn = (wgid % nig) / gsz; u.aux = 0;
        u.A = A + (size_t)u.pm * tA; u.B = B + (size_t)u.pn * tB; return true;
    }
};

template <class Epi, class Sched, bool ALIGN_EPI, bool GATHER = false, bool SKIP = false, bool VARSHAPE = false>
__device__ __forceinline__ void gemm_phase(LAS unsigned char* lds, const int lda0, const int ldb0, const int nt0, const Sched& S, const Epi& E, const LAS int* ridxc = nullptr) {
    const int tid = threadIdx.x, wid = __builtin_amdgcn_readfirstlane(tid >> 6), lane = tid & 63, wr = wid >> 2, wc = wid & 3, fr = lane & 15, fq = lane >> 4;
    const size_t kstep = (size_t)(BK * 2);
    unsigned voffA[2][2], nvA[2][2], voffB[2], nvB[2]; int RA[2], RB[2], CA2[2];
    size_t hsA, hsB, nhsA, nhsB;
#pragma unroll
    for (int i = 0; i < 2; ++i) { int R, C; stage_rc(tid * 16 + i * 8192, R, C); RA[i] = R; RB[i] = Epi::PERM ? ((R & ~31) + perm32(R & 31)) : R; CA2[i] = C * 2; }
#define PG_SETV(dA, dB, hA, hB, lda_, ldb_) do { _Pragma("unroll") for (int _i = 0; _i < 2; ++_i) { \
        dA[0][_i] = (unsigned)(RA[_i] * (lda_)) * 2u + (unsigned)CA2[_i]; dA[1][_i] = dA[0][_i]; dB[_i] = (unsigned)(RB[_i] * (ldb_)) * 2u + (unsigned)CA2[_i]; } \
        hA = (size_t)HALF * (lda_) * 2; hB = (size_t)HALF * (ldb_) * 2; } while (0)
#define PG_GVOFF(dst, slot, lda_) do { _Pragma("unroll") for (int _h = 0; _h < 2; ++_h) _Pragma("unroll") for (int _i = 0; _i < 2; ++_i) \
        dst[_h][_i] = (unsigned)ridxc[(slot) * 256 + _h * HALF + RA[_i]] * (unsigned)((lda_) * 2) + (unsigned)CA2[_i]; } while (0)
#define PG_COPYA(d, s) do { _Pragma("unroll") for (int _h = 0; _h < 2; ++_h) _Pragma("unroll") for (int _i = 0; _i < 2; ++_i) d[_h][_i] = s[_h][_i]; } while (0)
    const unsigned ldsw = (unsigned)wid * 1024u;
    const int aoff = lds_byte(wr * 64 + fr, fq * 8), boff = lds_byte(wc * 32 + fr, fq * 8);
#define PG_SA(b, h) (((b) * 2 + (h)) * HTB)
#define PG_SB(b, h) ((4 + (b) * 2 + (h)) * HTB)
#define PG_STAGE(bufoff, gbase, voff) do { _Pragma("unroll") for (int _i = 0; _i < 2; ++_i) \
        __builtin_amdgcn_global_load_lds((const unsigned*)((const char*)(gbase) + (voff)[_i]), (LAS unsigned*)(lds + (bufoff) + ldsw + _i * 8192), 16, 0, 0); } while (0)
#define PG_STAGE_A(bufoff, gbase, h) PG_STAGE(bufoff, (gbase) + (GATHER ? (size_t)0 : (size_t)(h) * hsA), voffA[GATHER ? (h) : 0])
#define PG_STAGE_B(bufoff, gbase, h) PG_STAGE(bufoff, (gbase) + (size_t)(h) * hsB, voffB)
#define PG_LDA(dst, b, h) do { _Pragma("unroll") for (int m = 0; m < 4; ++m) _Pragma("unroll") for (int k = 0; k < 2; ++k) dst[m][k] = *(const LAS f16x8*)(lds + PG_SA(b, h) + aoff + m * 2048 + k * 1024); } while (0)
#define PG_LDB(dst, b, h) do { _Pragma("unroll") for (int n = 0; n < 2; ++n) _Pragma("unroll") for (int k = 0; k < 2; ++k) dst[n][k] = *(const LAS f16x8*)(lds + PG_SB(b, h) + boff + n * 2048 + k * 1024); } while (0)
#define PG_MMA(ai, bj, At, Bt) do { __builtin_amdgcn_s_setprio(1); _Pragma("unroll") for (int m = 0; m < 4; ++m) _Pragma("unroll") for (int n = 0; n < 2; ++n) _Pragma("unroll") for (int k = 0; k < 2; ++k) \
        acc[ai][bj][m][n] = __builtin_amdgcn_mfma_f32_16x16x32_f16(Bt[n][k], At[m][k], acc[ai][bj][m][n], 0, 0, 0); __builtin_amdgcn_s_setprio(0); } while (0)
#define PG_WAIT_V(n) asm volatile("s_waitcnt vmcnt(" #n ")" ::: "memory")
#define PG_WAIT_L(n) asm volatile("s_waitcnt lgkmcnt(" #n ")" ::: "memory")
#define PG_BAR __builtin_amdgcn_s_barrier()
#define PG_SCHED __builtin_amdgcn_sched_barrier(0)
    Unit cur, nxt; int ui = 0;
    if (!S.next(0, cur)) return;
    int nt = VARSHAPE ? cur.nt : nt0;
    PG_SETV(voffA, voffB, hsA, hsB, (VARSHAPE ? cur.lda : lda0), (VARSHAPE ? cur.ldb : ldb0));
    if constexpr (GATHER) PG_GVOFF(voffA, 0, lda0);
    f32x4 acc[2][2][4][2];
#pragma unroll
    for (int a = 0; a < 2; ++a)
#pragma unroll
        for (int b = 0; b < 2; ++b)
#pragma unroll
            for (int m = 0; m < 4; ++m)
#pragma unroll
                for (int n = 0; n < 2; ++n) acc[a][b][m][n] = (f32x4){0.f, 0.f, 0.f, 0.f};
    f16x8 At[4][2], B0[2][2], B1[2][2];
    const char* cA = cur.A; const char* cB = cur.B;
    PG_STAGE_B(PG_SB(0, 0), cB, 0); PG_STAGE_B(PG_SB(0, 1), cB, 1); PG_STAGE_A(PG_SA(0, 0), cA, 0); PG_STAGE_A(PG_SA(0, 1), cA, 1);
    if (wr == 1) PG_BAR;
    PG_WAIT_V(2); PG_BAR;
    PG_STAGE_B(PG_SB(1, 0), cB + kstep, 0); PG_STAGE_A(PG_SA(1, 0), cA + kstep, 0); PG_STAGE_B(PG_SB(1, 1), cB + kstep, 1);
    PG_WAIT_V(6); PG_BAR;
#ifdef PROBE_GEMM
    volatile LAS unsigned long long* tsg = (volatile LAS unsigned long long*)(lds + 131072 + 512);
#define GSTAMP(k) do { if (VARSHAPE && blockIdx.x == 0 && tid == 0) tsg[k] = __builtin_amdgcn_s_memrealtime(); } while (0)
#else
#define GSTAMP(k) do { } while (0)
#endif
    for (;;) {
        const bool has_next = S.next(ui + 1, nxt);
        if (ui == 2) GSTAMP(20);
        if (ui == 3) GSTAMP(24);
        const bool half_only = SKIP && (__builtin_amdgcn_readfirstlane(cur.aux) <= HALF);
        const char* nA = has_next ? nxt.A : cA; const char* nB = has_next ? nxt.B : cB;
        if constexpr (GATHER) { if (has_next) PG_GVOFF(nvA, ui + 1, lda0); else PG_COPYA(nvA, voffA); }
        if constexpr (VARSHAPE) { if (has_next) PG_SETV(nvA, nvB, nhsA, nhsB, nxt.lda, nxt.ldb); else { PG_COPYA(nvA, voffA); nvB[0] = voffB[0]; nvB[1] = voffB[1]; nhsA = hsA; nhsB = hsB; } }
        for (int t = 0; t < nt; t += 2) {
            const bool last = (t == nt - 2);
            const char* a1 = cA + (size_t)(t + 1) * kstep;
            const char* a2 = last ? nA : cA + (size_t)(t + 2) * kstep; const char* b2 = last ? nB : cB + (size_t)(t + 2) * kstep;
            const char* a3 = a2 + kstep; const char* b3 = b2 + kstep;
            PG_LDB(B0, 0, 0); PG_LDB(B1, 0, 1); PG_SCHED; PG_LDA(At, 0, 0); PG_STAGE_A(PG_SA(1, 1), a1, 1);
            if constexpr (GATHER || VARSHAPE) { if (last) { PG_COPYA(voffA, nvA); if constexpr (VARSHAPE) { voffB[0] = nvB[0]; voffB[1] = nvB[1]; hsA = nhsA; hsB = nhsB; } } }
            PG_WAIT_V(8); PG_WAIT_L(0); PG_BAR; PG_MMA(0, 0, At, B0); PG_MMA(0, 1, At, B1); PG_BAR; PG_SCHED;
            PG_LDA(At, 0, 1); PG_STAGE_B(PG_SB(0, 0), b2, 0); PG_STAGE_B(PG_SB(0, 1), b2, 1); PG_STAGE_A(PG_SA(0, 0), a2, 0);
            PG_WAIT_V(8); PG_WAIT_L(0); PG_BAR; if (!SKIP || !half_only) { PG_MMA(1, 0, At, B0); PG_MMA(1, 1, At, B1); } PG_BAR; PG_SCHED;
            PG_LDB(B0, 1, 0); PG_LDB(B1, 1, 1); PG_SCHED; PG_LDA(At, 1, 0); PG_STAGE_A(PG_SA(0, 1), a2, 1);
            PG_WAIT_V(8); PG_WAIT_L(0); PG_BAR; PG_MMA(0, 0, At, B0); PG_MMA(0, 1, At, B1); PG_BAR; PG_SCHED;
            PG_LDA(At, 1, 1); PG_STAGE_B(PG_SB(1, 0), b3, 0); PG_STAGE_B(PG_SB(1, 1), b3, 1); PG_STAGE_A(PG_SA(1, 0), a3, 0);
            PG_WAIT_V(8); PG_WAIT_L(0); PG_BAR; if (!SKIP || !half_only) { PG_MMA(1, 0, At, B0); PG_MMA(1, 1, At, B1); } PG_BAR; PG_SCHED;
        }
        if constexpr (ALIGN_EPI) { if (wr == 0) PG_BAR; }
        if (ui == 2) GSTAMP(21);
        if (ui == 3) GSTAMP(25);
        E(acc, cur, wr, wc, fr, fq);
        if (ui == 2) GSTAMP(22);
        if (ui == 3) GSTAMP(26);
        if (!has_next) break;
#pragma unroll
        for (int a = 0; a < 2; ++a)
#pragma unroll
            for (int b = 0; b < 2; ++b)
#pragma unroll
                for (int m = 0; m < 4; ++m)
#pragma unroll
                    for (int n = 0; n < 2; ++n) acc[a][b][m][n] = (f32x4){0.f, 0.f, 0.f, 0.f};
        cur = nxt; cA = nA; cB = nB; ++ui;
        if constexpr (VARSHAPE) nt = cur.nt;
        if constexpr (ALIGN_EPI) { if (wr == 1) PG_BAR; }
    }
    PG_WAIT_V(0);
    if constexpr (!ALIGN_EPI) { if (wr == 0) PG_BAR; }
    PG_BAR;
#undef PG_SETV
#undef PG_GVOFF
#undef PG_COPYA
#undef PG_SA
#undef PG_SB
#undef PG_STAGE
#undef PG_STAGE_A
#undef PG_STAGE_B
#undef PG_LDA
#undef PG_LDB
#undef PG_MMA
#undef PG_WAIT_V
#undef PG_WAIT_L
#undef PG_BAR
#undef PG_SCHED
}

struct EpiProj {
    static constexpr bool PERM = true;
    half_t* O; int ldc; float* vsq;
    __device__ __forceinline__ void operator()(const f32x4 (&acc)[2][2][4][2], const Unit& u, int wr, int wc, int fr, int fq) const {
        const int row0 = u.pm * BM + wr * 64 + fr, col0 = u.pn * BM + wc * 32 + 8 * fq;
        const bool act = (u.pn >= 2 && u.pn < 6), isv = (u.pn >= 4 && u.pn < 6);
#pragma unroll
        for (int ai = 0; ai < 2; ++ai)
#pragma unroll
            for (int m = 0; m < 4; ++m) { half_t* rowp = O + (size_t)(row0 + ai * HALF + m * 16) * ldc + col0; float sq = 0.f;
#pragma unroll
                for (int bj = 0; bj < 2; ++bj) { f32x4 v0 = acc[ai][bj][m][0], v1 = acc[ai][bj][m][1];
                    if (act) {
#pragma unroll
                        for (int j = 0; j < 4; ++j) { v0[j] = fast_gelu(v0[j]); v1[j] = fast_gelu(v1[j]); sq += v0[j] * v0[j] + v1[j] * v1[j]; } }
                    u32x4 w; w.x = pk_h2(v0[0], v0[1]); w.y = pk_h2(v0[2], v0[3]); w.z = pk_h2(v1[0], v1[1]); w.w = pk_h2(v1[2], v1[3]);
                    *(u32x4*)(rowp + bj * HALF) = w; }
                if (isv) { sq += __shfl_xor(sq, 16); sq += __shfl_xor(sq, 32); if (fq == 0) vsq[(size_t)(row0 + ai * HALF + m * 16) * 8 + (u.pn - 4) * 4 + wc] = sq; } }
    }
};

struct EpiGlu {
    static constexpr bool PERM = true;
    half_t* O; int ldc; const float* bias;
    __device__ __forceinline__ void operator()(const f32x4 (&acc)[2][2][4][2], const Unit& u, int wr, int wc, int fr, int fq) const {
        const int row0 = u.pm * BM + wr * 64 + fr, col0 = u.pn * HALF + wc * 32 + 8 * fq;
        const f32x4 ba0 = *(const f32x4*)(bias + col0), ba1 = *(const f32x4*)(bias + col0 + 4), bb0 = *(const f32x4*)(bias + 512 + col0), bb1 = *(const f32x4*)(bias + 512 + col0 + 4);
#pragma unroll
        for (int ai = 0; ai < 2; ++ai)
#pragma unroll
            for (int m = 0; m < 4; ++m) {
                const f32x4 a0 = acc[ai][0][m][0] + ba0, a1 = acc[ai][0][m][1] + ba1, b0 = acc[ai][1][m][0] + bb0, b1 = acc[ai][1][m][1] + bb1;
                u32x4 w; w.x = pk_h2(a0[0] * fast_sigmoid(b0[0]), a0[1] * fast_sigmoid(b0[1])); w.y = pk_h2(a0[2] * fast_sigmoid(b0[2]), a0[3] * fast_sigmoid(b0[3]));
                w.z = pk_h2(a1[0] * fast_sigmoid(b1[0]), a1[1] * fast_sigmoid(b1[1])); w.w = pk_h2(a1[2] * fast_sigmoid(b1[2]), a1[3] * fast_sigmoid(b1[3]));
                *(u32x4*)(O + (size_t)(row0 + ai * HALF + m * 16) * ldc + col0) = w; }
    }
};
struct EpiGate {
    static constexpr bool PERM = true;
    half_t* O; int ldc; const float* bias;
    __device__ __forceinline__ void operator()(const f32x4 (&acc)[2][2][4][2], const Unit& u, int wr, int wc, int fr, int fq) const {
        const int row0 = u.pm * BM + wr * 64 + fr, col0 = u.pn * BM + wc * 32 + 8 * fq;
        f32x4 bv[2][2];
#pragma unroll
        for (int bj = 0; bj < 2; ++bj)
#pragma unroll
            for (int n = 0; n < 2; ++n) bv[bj][n] = *(const f32x4*)(bias + col0 + bj * HALF + 4 * n);
#pragma unroll
        for (int ai = 0; ai < 2; ++ai)
#pragma unroll
            for (int m = 0; m < 4; ++m) { half_t* rowp = O + (size_t)(row0 + ai * HALF + m * 16) * ldc + col0;
#pragma unroll
                for (int bj = 0; bj < 2; ++bj) { const f32x4 v0 = acc[ai][bj][m][0] + bv[bj][0], v1 = acc[ai][bj][m][1] + bv[bj][1];
                    u32x4 w; w.x = pk_h2(fast_sigmoid(v0[0]), fast_sigmoid(v0[1])); w.y = pk_h2(fast_sigmoid(v0[2]), fast_sigmoid(v0[3])); w.z = pk_h2(fast_sigmoid(v1[0]), fast_sigmoid(v1[1])); w.w = pk_h2(fast_sigmoid(v1[2]), fast_sigmoid(v1[3]));
                    *(u32x4*)(rowp + bj * HALF) = w; } }
    }
};
struct EpiBranch {
    static constexpr bool PERM = true;
    half_t* O; const half_t* G;
    __device__ __forceinline__ void operator()(const f32x4 (&acc)[2][2][4][2], const Unit& u, int wr, int wc, int fr, int fq) const {
        const int row0 = u.pm * BM + wr * 64 + fr, col0 = u.pn * BM + wc * 32 + 8 * fq; const int i = u.aux;
#pragma unroll
        for (int ai = 0; ai < 2; ++ai)
#pragma unroll
            for (int m = 0; m < 4; ++m) { const size_t r = (size_t)(row0 + ai * HALF + m * 16);
#pragma unroll
                for (int bj = 0; bj < 2; ++bj) {
                    const f16x8 gv = *(const f16x8*)(G + r * 3072 + i * 1024 + col0 + bj * HALF);
                    f16x8 pv = {0, 0, 0, 0, 0, 0, 0, 0};
                    if (i > 0) pv = *(const f16x8*)(O + r * 1024 + col0 + bj * HALF);
                    const f32x4 v0 = acc[ai][bj][m][0], v1 = acc[ai][bj][m][1];
                    u32x4 w; w.x = pk_h2((float)pv[0] + (float)gv[0] * v0[0], (float)pv[1] + (float)gv[1] * v0[1]); w.y = pk_h2((float)pv[2] + (float)gv[2] * v0[2], (float)pv[3] + (float)gv[3] * v0[3]);
                    w.z = pk_h2((float)pv[4] + (float)gv[4] * v1[0], (float)pv[5] + (float)gv[5] * v1[1]); w.w = pk_h2((float)pv[6] + (float)gv[6] * v1[2], (float)pv[7] + (float)gv[7] * v1[3]);
                    *(u32x4*)(O + r * 1024 + col0 + bj * HALF) = w; } }
    }
};
struct EpiOut {
    static constexpr bool PERM = true;
    half_t* O; const float* X; int ldc;
    __device__ __forceinline__ void operator()(const f32x4 (&acc)[2][2][4][2], const Unit& u, int wr, int wc, int fr, int fq) const {
        const int row0 = u.pm * BM + wr * 64 + fr, col0 = u.pn * BM + wc * 32 + 8 * fq;
#pragma unroll
        for (int ai = 0; ai < 2; ++ai) {
            f32x4 xv[4][2][2];
#pragma unroll
            for (int m = 0; m < 4; ++m)
#pragma unroll
                for (int bj = 0; bj < 2; ++bj) { const size_t off = (size_t)(row0 + ai * HALF + m * 16) * ldc + col0 + bj * HALF; xv[m][bj][0] = *(const f32x4*)(X + off); xv[m][bj][1] = *(const f32x4*)(X + off + 4); }
#pragma unroll
            for (int m = 0; m < 4; ++m)
#pragma unroll
                for (int bj = 0; bj < 2; ++bj) { const size_t off = (size_t)(row0 + ai * HALF + m * 16) * ldc + col0 + bj * HALF;
                    const f32x4 v0 = xv[m][bj][0] + acc[ai][bj][m][0], v1 = xv[m][bj][1] + acc[ai][bj][m][1];
                    u32x4 w; w.x = pk_h2(v0[0], v0[1]); w.y = pk_h2(v0[2], v0[3]); w.z = pk_h2(v1[0], v1[1]); w.w = pk_h2(v1[2], v1[3]);
                    *(u32x4*)(O + off) = w; }
        }
    }
};
struct OrderBr {
    OrderMN base; const char* A; const char* B;
    __device__ void init(int G_, int c_, const void* cat, const void* wbr) { base.init(T, 1024, G_, c_, nullptr, 0, nullptr, 0); A = (const char*)cat; B = (const char*)wbr; }
    __device__ bool next(int j, Unit& u) const {
        const int r = j / 3, i = j - 3 * r;
        if (!base.next(r, u)) return false;
        u.aux = i;
        u.A = A + (size_t)i * T * 512 * 2 + (size_t)u.pm * BM * 512 * 2;
        u.B = B + (size_t)i * 1024 * 512 * 2 + (size_t)u.pn * BM * 512 * 2;
        return true;
    }
};

struct EpiGateBranch {
    static constexpr bool PERM = true;
    half_t* O; half_t* GS; const float* bias;
    __device__ __forceinline__ void operator()(const f32x4 (&acc)[2][2][4][2], const Unit& u, int wr, int wc, int fr, int fq) const {
        const int i = u.aux >> 1, kind = u.aux & 1;
        const int rl0 = wr * 64 + fr, cl0 = wc * 32 + 8 * fq;
        half_t* gs = GS + (size_t)(u.pm * 4 + u.pn) * 65536;
        if (kind == 0) {
            f32x4 bv[2][2];
#pragma unroll
            for (int bj = 0; bj < 2; ++bj)
#pragma unroll
                for (int n = 0; n < 2; ++n) bv[bj][n] = *(const f32x4*)(bias + i * 1024 + u.pn * BM + cl0 + bj * HALF + 4 * n);
#pragma unroll
            for (int ai = 0; ai < 2; ++ai)
#pragma unroll
                for (int m = 0; m < 4; ++m)
#pragma unroll
                    for (int bj = 0; bj < 2; ++bj) { const f32x4 v0 = acc[ai][bj][m][0] + bv[bj][0], v1 = acc[ai][bj][m][1] + bv[bj][1];
                        u32x4 w; w.x = pk_h2(fast_sigmoid(v0[0]), fast_sigmoid(v0[1])); w.y = pk_h2(fast_sigmoid(v0[2]), fast_sigmoid(v0[3])); w.z = pk_h2(fast_sigmoid(v1[0]), fast_sigmoid(v1[1])); w.w = pk_h2(fast_sigmoid(v1[2]), fast_sigmoid(v1[3]));
                        *(u32x4*)(gs + (size_t)(rl0 + ai * HALF + m * 16) * 256 + cl0 + bj * HALF) = w; }
        } else {
            const int row0 = u.pm * BM + rl0, col0 = u.pn * BM + cl0;
#pragma unroll
            for (int ai = 0; ai < 2; ++ai) {
                f16x8 gv[4][2], pv[4][2];
#pragma unroll
                for (int m = 0; m < 4; ++m)
#pragma unroll
                    for (int bj = 0; bj < 2; ++bj) {
                        gv[m][bj] = *(const f16x8*)(gs + (size_t)(rl0 + ai * HALF + m * 16) * 256 + cl0 + bj * HALF);
                        if (i > 0) pv[m][bj] = *(const f16x8*)(O + (size_t)(row0 + ai * HALF + m * 16) * 1024 + col0 + bj * HALF);
                        else pv[m][bj] = (f16x8){0, 0, 0, 0, 0, 0, 0, 0}; }
#pragma unroll
                for (int m = 0; m < 4; ++m)
#pragma unroll
                    for (int bj = 0; bj < 2; ++bj) {
                        const f32x4 v0 = acc[ai][bj][m][0], v1 = acc[ai][bj][m][1]; const f16x8 g8 = gv[m][bj], p8 = pv[m][bj];
                        u32x4 w; w.x = pk_h2((float)p8[0] + (float)g8[0] * v0[0], (float)p8[1] + (float)g8[1] * v0[1]); w.y = pk_h2((float)p8[2] + (float)g8[2] * v0[2], (float)p8[3] + (float)g8[3] * v0[3]);
                        w.z = pk_h2((float)p8[4] + (float)g8[4] * v1[0], (float)p8[5] + (float)g8[5] * v1[1]); w.w = pk_h2((float)p8[6] + (float)g8[6] * v1[2], (float)p8[7] + (float)g8[7] * v1[3]);
                        *(u32x4*)(O + (size_t)(row0 + ai * HALF + m * 16) * 1024 + col0 + bj * HALF) = w; }
            }
        }
    }
};
struct OrderGB {
    OrderMN base; const char* N16; const char* WG; const char* CAT; const char* WBR;
    __device__ void init(int G_, int c_, const void* n16, const void* wgate, const void* cat, const void* wbr) { base.init(T, 1024, G_, c_, nullptr, 0, nullptr, 0); N16 = (const char*)n16; WG = (const char*)wgate; CAT = (const char*)cat; WBR = (const char*)wbr; }
    __device__ bool next(int j, Unit& u) const {
        const int r = j / 6, k = j - 6 * r, i = k >> 1, kind = k & 1;
        if (!base.next(r, u)) return false;
        u.aux = 2 * i + kind;
        if (kind == 0) { u.A = N16 + (size_t)u.pm * BM * 1024 * 2; u.B = WG + ((size_t)i * 1024 + (size_t)u.pn * BM) * 1024 * 2; u.lda = 1024; u.ldb = 1024; u.nt = 16; }
        else { u.A = CAT + (size_t)i * T * 512 * 2 + (size_t)u.pm * BM * 512 * 2; u.B = WBR + (size_t)i * 1024 * 512 * 2 + (size_t)u.pn * BM * 512 * 2; u.lda = 512; u.ldb = 512; u.nt = 8; }
        return true;
    }
};
struct GbUnit { const char* A; const char* B; int pm, pn, i, kind, lda, ldb, nt; };
struct OrderGB128 {
    OrderMN base; const char* N16; const char* WG; const char* CAT; const char* WBR;
    __device__ void init(int G_, int c_, const void* n16, const void* wgate, const void* cat, const void* wbr) { base.init(T, 2048, G_, c_, nullptr, 0, nullptr, 0); N16 = (const char*)n16; WG = (const char*)wgate; CAT = (const char*)cat; WBR = (const char*)wbr; }
    __device__ bool next(int j, GbUnit& u) const {
        const int r = j / 6, k = j - 6 * r; Unit t;
        if (!base.next(r, t)) return false;
        u.pm = t.pm; u.pn = t.pn; u.i = k >> 1; u.kind = k & 1;
        if (u.kind == 0) { u.A = N16 + (size_t)u.pm * BM * 1024 * 2; u.B = WG + ((size_t)u.i * 1024 + (size_t)u.pn * HALF) * 1024 * 2; u.lda = 1024; u.ldb = 1024; u.nt = 16; }
        else { u.A = CAT + (size_t)u.i * T * 512 * 2 + (size_t)u.pm * BM * 512 * 2; u.B = WBR + (size_t)u.i * 1024 * 512 * 2 + (size_t)u.pn * HALF * 512 * 2; u.lda = 512; u.ldb = 512; u.nt = 8; }
        return true;
    }
};
__device__ __forceinline__ void gemm_phase_gb128(LAS unsigned char* lds, const OrderGB128& S, const float* __restrict__ bias  , half_t* __restrict__ MERGED) {
    const int tid = threadIdx.x, wid = __builtin_amdgcn_readfirstlane(tid >> 6), lane = tid & 63, wr = wid >> 2, wc = wid & 3, fr = lane & 15, fq = lane >> 4;
    const size_t kstep = (size_t)(BK * 2);
    unsigned voffA[2], nvA[2], voffB[2], nvB[2]; int RA[2], RB[2], CA2[2]; size_t hsA, nhsA;
#pragma unroll
    for (int i = 0; i < 2; ++i) { int R, C; stage_rc(tid * 16 + i * 8192, R, C); RA[i] = R; RB[i] = (R & ~31) + perm32(R & 31); CA2[i] = C * 2; }
#define HN_SETV(dA, dB, hA, lda_, ldb_) do { _Pragma("unroll") for (int _i = 0; _i < 2; ++_i) { dA[_i] = (unsigned)(RA[_i] * (lda_)) * 2u + (unsigned)CA2[_i]; dB[_i] = (unsigned)(RB[_i] * (ldb_)) * 2u + (unsigned)CA2[_i]; } hA = (size_t)HALF * (lda_) * 2; } while (0)
    const unsigned ldsw = (unsigned)wid * 1024u;
    const int aoff = lds_byte(wr * 64 + fr, fq * 8), boff = lds_byte(wc * 32 + fr, fq * 8);
#define HN_SA(b, h) (((b) * 2 + (h)) * HTB)
#define HN_SB(b) ((4 + (b)) * HTB)
#define HN_STAGE(bufoff, gbase, voff) do { _Pragma("unroll") for (int _i = 0; _i < 2; ++_i) \
        __builtin_amdgcn_global_load_lds((const unsigned*)((const char*)(gbase) + (voff)[_i]), (LAS unsigned*)(lds + (bufoff) + ldsw + _i * 8192), 16, 0, 0); } while (0)
#define HN_LDA(dst, b, h) do { _Pragma("unroll") for (int m = 0; m < 4; ++m) _Pragma("unroll") for (int k = 0; k < 2; ++k) dst[m][k] = *(const LAS f16x8*)(lds + HN_SA(b, h) + aoff + m * 2048 + k * 1024); } while (0)
#define HN_LDB(dst, b) do { _Pragma("unroll") for (int n = 0; n < 2; ++n) _Pragma("unroll") for (int k = 0; k < 2; ++k) dst[n][k] = *(const LAS f16x8*)(lds + HN_SB(b) + boff + n * 2048 + k * 1024); } while (0)
#define HN_MMA(ai) do { __builtin_amdgcn_s_setprio(1); _Pragma("unroll") for (int m = 0; m < 4; ++m) _Pragma("unroll") for (int n = 0; n < 2; ++n) _Pragma("unroll") for (int k = 0; k < 2; ++k) \
        acc[ai][m][n] = __builtin_amdgcn_mfma_f32_16x16x32_f16(B0[n][k], At[m][k], acc[ai][m][n], 0, 0, 0); __builtin_amdgcn_s_setprio(0); } while (0)
#define HN_WAIT_V(n) asm volatile("s_waitcnt vmcnt(" #n ")" ::: "memory")
#define HN_WAIT_L0 asm volatile("s_waitcnt lgkmcnt(0)" ::: "memory")
#define HN_BAR __builtin_amdgcn_s_barrier()
#define HN_SCHED __builtin_amdgcn_sched_barrier(0)
    GbUnit cur, nxt; int ui = 0;
    if (!S.next(0, cur)) return;
    int nt = cur.nt;
    HN_SETV(voffA, voffB, hsA, cur.lda, cur.ldb);
    f32x4 acc[2][4][2], mg[2][4][2]; unsigned gp[2][4][4];
#pragma unroll
    for (int a = 0; a < 2; ++a)
#pragma unroll
        for (int m = 0; m < 4; ++m)
#pragma unroll
            for (int n = 0; n < 2; ++n) { acc[a][m][n] = (f32x4){0.f, 0.f, 0.f, 0.f}; mg[a][m][n] = (f32x4){0.f, 0.f, 0.f, 0.f}; }
#pragma unroll
    for (int a = 0; a < 2; ++a)
#pragma unroll
        for (int m = 0; m < 4; ++m)
#pragma unroll
            for (int q = 0; q < 4; ++q) gp[a][m][q] = 0u;
    f16x8 At[4][2], B0[2][2];
    const char* cA = cur.A; const char* cB = cur.B;
    HN_STAGE(HN_SB(0), cB, voffB); HN_STAGE(HN_SA(0, 0), cA, voffA); HN_STAGE(HN_SA(0, 1), cA + hsA, voffA);
    if (wr == 1) HN_BAR;
    HN_WAIT_V(2); HN_BAR;
    HN_STAGE(HN_SB(1), cB + kstep, voffB); HN_STAGE(HN_SA(1, 0), cA + kstep, voffA);
    HN_WAIT_V(4); HN_BAR;
    for (;;) {
        const bool has_next = S.next(ui + 1, nxt);
        const char* nA = has_next ? nxt.A : cA; const char* nB = has_next ? nxt.B : cB;
        if (has_next) HN_SETV(nvA, nvB, nhsA, nxt.lda, nxt.ldb); else { nvA[0] = voffA[0]; nvA[1] = voffA[1]; nvB[0] = voffB[0]; nvB[1] = voffB[1]; nhsA = hsA; }
        for (int t = 0; t < nt; t += 2) {
            const bool last = (t == nt - 2);
            const char* a1 = cA + (size_t)(t + 1) * kstep;
            const char* a2 = last ? nA : cA + (size_t)(t + 2) * kstep; const char* b2 = last ? nB : cB + (size_t)(t + 2) * kstep;
            const char* a3 = a2 + kstep; const char* b3 = b2 + kstep;
            HN_LDB(B0, 0); HN_SCHED; HN_LDA(At, 0, 0); HN_STAGE(HN_SA(1, 1), a1 + hsA, voffA);
            if (last) { voffA[0] = nvA[0]; voffA[1] = nvA[1]; voffB[0] = nvB[0]; voffB[1] = nvB[1]; hsA = nhsA; }
            HN_WAIT_V(6); HN_WAIT_L0; HN_BAR; HN_MMA(0); HN_BAR; HN_SCHED;
            HN_LDA(At, 0, 1); HN_STAGE(HN_SB(0), b2, voffB); HN_STAGE(HN_SA(0, 0), a2, voffA);
            HN_WAIT_V(6); HN_WAIT_L0; HN_BAR; HN_MMA(1); HN_BAR; HN_SCHED;
            HN_LDB(B0, 1); HN_SCHED; HN_LDA(At, 1, 0); HN_STAGE(HN_SA(0, 1), a2 + hsA, voffA);
            HN_WAIT_V(6); HN_WAIT_L0; HN_BAR; HN_MMA(0); HN_BAR; HN_SCHED;
            HN_LDA(At, 1, 1); HN_STAGE(HN_SB(1), b3, voffB); HN_STAGE(HN_SA(1, 0), a3, voffA);
            HN_WAIT_V(6); HN_WAIT_L0; HN_BAR; HN_MMA(1); HN_BAR; HN_SCHED;
        }
        if (wr == 0) HN_BAR;
        if (cur.kind == 0) {
            const float* bp = bias + cur.i * 1024 + cur.pn * HALF + wc * 32 + 8 * fq;
            const f32x4 b0 = *(const f32x4*)bp, b1 = *(const f32x4*)(bp + 4);
#pragma unroll
            for (int ai = 0; ai < 2; ++ai)
#pragma unroll
                for (int m = 0; m < 4; ++m) { const f32x4 v0 = acc[ai][m][0] + b0, v1 = acc[ai][m][1] + b1;
                    gp[ai][m][0] = pk_h2(fast_sigmoid(v0[0]), fast_sigmoid(v0[1])); gp[ai][m][1] = pk_h2(fast_sigmoid(v0[2]), fast_sigmoid(v0[3]));
                    gp[ai][m][2] = pk_h2(fast_sigmoid(v1[0]), fast_sigmoid(v1[1])); gp[ai][m][3] = pk_h2(fast_sigmoid(v1[2]), fast_sigmoid(v1[3])); }
        } else {
#pragma unroll
            for (int ai = 0; ai < 2; ++ai)
#pragma unroll
                for (int m = 0; m < 4; ++m)
#pragma unroll
                    for (int q = 0; q < 4; ++q) { const f16x2 g2 = __builtin_bit_cast(f16x2, gp[ai][m][q]);
                        mg[ai][m][q >> 1][(q & 1) * 2] += (float)g2.x * acc[ai][m][q >> 1][(q & 1) * 2]; mg[ai][m][q >> 1][(q & 1) * 2 + 1] += (float)g2.y * acc[ai][m][q >> 1][(q & 1) * 2 + 1]; }
            if (cur.i == 2) {
                half_t* op = MERGED + (size_t)(cur.pm * BM + wr * 64 + fr) * 1024 + cur.pn * HALF + wc * 32 + 8 * fq;
#pragma unroll
                for (int ai = 0; ai < 2; ++ai)
#pragma unroll
                    for (int m = 0; m < 4; ++m) { const f32x4 v0 = mg[ai][m][0], v1 = mg[ai][m][1];
                        u32x4 w; w.x = pk_h2(v0[0], v0[1]); w.y = pk_h2(v0[2], v0[3]); w.z = pk_h2(v1[0], v1[1]); w.w = pk_h2(v1[2], v1[3]);
                        *(u32x4*)(op + (size_t)(ai * HALF + m * 16) * 1024) = w;
                        mg[ai][m][0] = (f32x4){0.f, 0.f, 0.f, 0.f}; mg[ai][m][1] = (f32x4){0.f, 0.f, 0.f, 0.f}; }
            }
        }
        if (!has_next) break;
#pragma unroll
        for (int a = 0; a < 2; ++a)
#pragma unroll
            for (int m = 0; m < 4; ++m)
#pragma unroll
                for (int n = 0; n < 2; ++n) acc[a][m][n] = (f32x4){0.f, 0.f, 0.f, 0.f};
        cur = nxt; cA = nA; cB = nB; ++ui; nt = cur.nt;
        if (wr == 1) HN_BAR;
    }
    HN_WAIT_V(0);
    HN_BAR;
#undef HN_SETV
#undef HN_SA
#undef HN_SB
#undef HN_STAGE
#undef HN_LDA
#undef HN_LDB
#undef HN_MMA
#undef HN_WAIT_V
#undef HN_WAIT_L0
#undef HN_BAR
#undef HN_SCHED
}
}

constexpr int NWAVES = 8;
constexpr int RING_OFF = 0, RING_BYTES = 131072;
constexpr int LDSCTL_OFF = RING_BYTES, MISC_OFF = LDSCTL_OFF + 320;
constexpr int LDS_BYTES = 147456;
typedef GAS unsigned gu32;
#define RLX_AGENT __ATOMIC_RELAXED, __HIP_MEMORY_SCOPE_AGENT
#define LDS_WAIT() asm volatile("s_waitcnt lgkmcnt(0)" ::: "memory")
#define VM_WAIT() asm volatile("s_waitcnt vmcnt(0)" ::: "memory")

#define XB_TMO      128
#define XB_XCNT(j)  (256  + 64 * (j))
#define XB_XSUB(j)  (1280 + 64 * (j))
#define XB_XGEN(j)  (2304 + 64 * (j))
#define XB_TOP      3328
#define XB_TOPGEN   3392
#define XCD_BAR_WORDS 3456
#define XB_SPIN_CAP (1u << 18)
__device__ __forceinline__ unsigned xb_ld(unsigned* p)              { return __hip_atomic_load(p, __ATOMIC_RELAXED, __HIP_MEMORY_SCOPE_AGENT); }
__device__ __forceinline__ unsigned xb_add(unsigned* p, unsigned v) { return __hip_atomic_fetch_add(p, v, __ATOMIC_RELAXED, __HIP_MEMORY_SCOPE_AGENT); }
__device__ __forceinline__ unsigned xb_xcc_id() { return (unsigned)__builtin_amdgcn_s_getreg((3 << 11) | 20) & 0xFu; }
#define XB_SPIN(cond, bar) do { unsigned _sp = 0; while (cond) { __builtin_amdgcn_s_sleep(1); \
    if ((++_sp & 255u) == 0u) { if (xb_ld(&(bar)[XB_TMO])) break; if (_sp > XB_SPIN_CAP) { atomicAdd(&(bar)[XB_TMO], 1u); break; } } } } while (0)
struct XcdBarrier { unsigned* bar; unsigned x; volatile LAS unsigned* st; };
__device__ __forceinline__ XcdBarrier xcd_barrier_post(unsigned* bar, volatile LAS unsigned* st) {
    XcdBarrier b; b.bar = bar; b.x = xb_xcc_id(); b.st = st;
    if (threadIdx.x == 0) (void)xb_add(&bar[XB_XCNT(b.x)], 1u);
    return b;
}
__device__ __forceinline__ void xcd_barrier_complete(unsigned* bar, unsigned x, unsigned& nloc, unsigned& nx) {
    const unsigned G = gridDim.x * gridDim.y * gridDim.z;
    unsigned sum, cnt, mine, sp = 0u;
    for (;;) {
        sum = 0u; cnt = 0u; mine = 0u;
#pragma unroll
        for (unsigned j = 0; j < 16; ++j) { const unsigned c = xb_ld(&bar[XB_XCNT(j)]); sum += c; cnt += (c > 0u) ? 1u : 0u; mine = (j == x) ? c : mine; }
        if (sum == G) break;
        __builtin_amdgcn_s_sleep(1);
        if ((++sp & 255u) == 0u) { if (xb_ld(&bar[XB_TMO])) break; if (sp > XB_SPIN_CAP) { atomicAdd(&bar[XB_TMO], 1u); break; } }
    }
    nloc = mine > 0u ? mine : 1u; nx = cnt > 0u ? cnt : 1u;
}
__device__ __forceinline__ void xcd_barrier1(const XcdBarrier& b) {
    asm volatile("s_waitcnt vmcnt(0)" ::: "memory");
    __syncthreads();
    if (threadIdx.x == 0) {
        unsigned* bar = b.bar;
        __builtin_amdgcn_s_waitcnt(0);
        unsigned nloc = b.st[0], nx = b.st[1];
        if (nloc == 0u) { xcd_barrier_complete(bar, b.x, nloc, nx); b.st[0] = nloc; b.st[1] = nx; }
        const unsigned old = xb_add(&bar[XB_XSUB(b.x)], 1u);
        const unsigned gen = old / nloc;
        if (old + 1u == (gen + 1u) * nloc) {
            __builtin_amdgcn_fence(__ATOMIC_RELEASE, "agent");
            asm volatile("s_waitcnt vmcnt(0)" ::: "memory");
            const unsigned og = xb_add(&bar[XB_TOP], 1u);
            const unsigned tg = og / nx;
            if (og + 1u == (tg + 1u) * nx) xb_add(&bar[XB_TOPGEN], 1u);
            else XB_SPIN(xb_ld(&bar[XB_TOPGEN]) == tg, bar);
            __builtin_amdgcn_fence(__ATOMIC_ACQUIRE, "agent");
            xb_add(&bar[XB_XGEN(b.x)], 1u);
            asm volatile("s_waitcnt vmcnt(0)" ::: "memory");
        } else {
            XB_SPIN(xb_ld(&bar[XB_XGEN(b.x)]) == gen, bar);
            __builtin_amdgcn_fence(__ATOMIC_ACQUIRE, "agent");
            asm volatile("s_waitcnt vmcnt(0)" ::: "memory");
        }
    }
    __syncthreads();
}

#ifndef XB_EXTRA
#define XB_EXTRA 0
#endif
__device__ __forceinline__ void xcd_barrier(const XcdBarrier& b) { xcd_barrier1(b); for (int i = 0; i < XB_EXTRA; ++i) xcd_barrier1(b); }

__device__ __forceinline__ float wave_sum(float v) {
#pragma unroll
    for (int o = 1; o < 64; o <<= 1) v += __shfl_xor(v, o);
    return v;
}

__device__ __forceinline__ void transpose_item(const float* W, int ldw, int k0, int n0, half_t* WT, int ldt, int drow0, LAS float* scr, int lane, const float* kscale = nullptr) {
    const int lk = lane >> 3, lc = (lane & 7) * 4;
    f32x4 v[8];
#pragma unroll
    for (int i = 0; i < 8; ++i) v[i] = *(const GAS f32x4*)(W + (size_t)(k0 + i * 8 + lk) * ldw + n0 + lc);
#pragma unroll
    for (int i = 0; i < 8; ++i) { LAS float* s = scr + (i * 8 + lk) * 33 + lc; s[0] = v[i].x; s[1] = v[i].y; s[2] = v[i].z; s[3] = v[i].w; }
    LDS_WAIT(); asm volatile("" ::: "memory");
    const int c = lane & 7;
    f32x4 g0 = {1.f, 1.f, 1.f, 1.f}, g1 = g0;
    if (kscale) { g0 = *(const GAS f32x4*)(kscale + k0 + 8 * c); g1 = *(const GAS f32x4*)(kscale + k0 + 8 * c + 4); }
#pragma unroll
    for (int j = 0; j < 4; ++j) { const int n = (lane >> 3) + 8 * j; const LAS float* s = scr + (8 * c) * 33 + n;
        u32x4 o; o.x = pk_h2(s[0 * 33] * g0[0], s[1 * 33] * g0[1]); o.y = pk_h2(s[2 * 33] * g0[2], s[3 * 33] * g0[3]); o.z = pk_h2(s[4 * 33] * g1[0], s[5 * 33] * g1[1]); o.w = pk_h2(s[6 * 33] * g1[2], s[7 * 33] * g1[3]);
        *(GAS u32x4*)(WT + (size_t)(drow0 + n) * ldt + k0 + 8 * c) = o; }
    LDS_WAIT(); asm volatile("" ::: "memory");
}
__device__ __forceinline__ void rms_row_to_f16(const float* xrow, const float* g, half_t* orow, int lane) {
    const GAS f32x4* xr = (const GAS f32x4*)xrow + lane;
    const GAS f32x4* gr = (const GAS f32x4*)g + lane;
    f32x4 v[4]; float s = 0.f;
#pragma unroll
    for (int j = 0; j < 4; ++j) { v[j] = xr[64 * j]; s += (v[j].x * v[j].x + v[j].y * v[j].y) + (v[j].z * v[j].z + v[j].w * v[j].w); }
    const float rs = 1.0f / sqrtf(wave_sum(s) * (1.f / 1024.f) + EPS);
    GAS u32x2* o8 = (GAS u32x2*)orow + lane;
#pragma unroll
    for (int j = 0; j < 4; ++j) { const f32x4 gg = gr[64 * j]; u32x2 w; w.x = pk_h2(v[j].x * rs * gg.x, v[j].y * rs * gg.y); w.y = pk_h2(v[j].z * rs * gg.z, v[j].w * rs * gg.w); o8[64 * j] = w; }
}

typedef float f32x16 __attribute__((ext_vector_type(16)));
__device__ __forceinline__ int crow(int r, int hi) { return (r & 3) + 8 * (r >> 2) + 4 * hi; }

__device__ __forceinline__ void kv_tile(const half_t* __restrict__ A  , const half_t* __restrict__ Bt  , half_t* K16, half_t* VT16, int tile, int wave, int lane) {
    const int m0 = (tile >> 4) * 64, n0 = (tile & 15) * 64;
    const int rb = wave >> 1, cb = (wave & 1) * 32;
    const int fr = lane & 15, fq = lane >> 4;
    const half_t* ap = A + (size_t)(m0 + 16 * rb + fr) * DM + 8 * fq;
    const half_t* bp0 = Bt + (size_t)(n0 + cb + fr) * DM + 8 * fq;
    const half_t* bp1 = bp0 + (size_t)16 * DM;
    f32x4 acc0 = {0.f, 0.f, 0.f, 0.f}, acc1 = {0.f, 0.f, 0.f, 0.f};
    const bool vpart = n0 >= 512;
#pragma unroll 16
    for (int k0 = 0; k0 < DM; k0 += 32) {
        const f16x8 a = *(const f16x8*)(ap + k0), b0 = *(const f16x8*)(bp0 + k0), b1 = *(const f16x8*)(bp1 + k0);
        if (vpart) { acc0 = __builtin_amdgcn_mfma_f32_16x16x32_f16(a, b0, acc0, 0, 0, 0); acc1 = __builtin_amdgcn_mfma_f32_16x16x32_f16(a, b1, acc1, 0, 0, 0); }
        else       { acc0 = __builtin_amdgcn_mfma_f32_16x16x32_f16(b0, a, acc0, 0, 0, 0); acc1 = __builtin_amdgcn_mfma_f32_16x16x32_f16(b1, a, acc1, 0, 0, 0); }
    }
    if (!vpart) {
        const int m = m0 + 16 * rb + fr;
        u32x2 w0, w1; w0.x = pk_h2(acc0[0], acc0[1]); w0.y = pk_h2(acc0[2], acc0[3]); w1.x = pk_h2(acc1[0], acc1[1]); w1.y = pk_h2(acc1[2], acc1[3]);
        *(u32x2*)(K16 + (size_t)m * 512 + n0 + cb + 4 * fq) = w0;
        *(u32x2*)(K16 + (size_t)m * 512 + n0 + cb + 16 + 4 * fq) = w1;
    } else {
        const int mb = m0 + 16 * rb + 4 * fq, b = mb >> 8, key = mb & 255;
        const int n = n0 - 512 + cb + fr;
        u32x2 w0, w1; w0.x = pk_h2(acc0[0], acc0[1]); w0.y = pk_h2(acc0[2], acc0[3]); w1.x = pk_h2(acc1[0], acc1[1]); w1.y = pk_h2(acc1[2], acc1[3]);
        *(u32x2*)(VT16 + ((size_t)b * 512 + n) * 256 + key) = w0;
        *(u32x2*)(VT16 + ((size_t)b * 512 + n + 16) * 256 + key) = w1;
    }
}

constexpr int ATT_K_OFF = 0, ATT_V_OFF = 65536, ATT_WS_OFF = RING_BYTES + 1024;
__device__ __forceinline__ void attn_unit(LAS unsigned char* lds, const half_t* __restrict__ PROJ16, const half_t* __restrict__ K16, const half_t* __restrict__ VT16, half_t* CAT16,
                                          int b, int h, int qb, int tid, int wave, int lane) {
    asm volatile("" : "+v"(tid), "+v"(lane));
    {
        const half_t* kg = K16 + (size_t)(b * 256) * 512 + h * 128;
        const half_t* vg = VT16 + ((size_t)b * 512 + h * 128) * 256;
        u32x4 kv[8], vv[8];
#pragma unroll
        for (int it = 0; it < 8; ++it) { const int idx = it * 512 + tid, key = idx >> 4, ch = idx & 15; kv[it] = *(const u32x4*)(kg + (size_t)key * 512 + ch * 8); }
#pragma unroll
        for (int it = 0; it < 8; ++it) { const int idx = it * 512 + tid, d = idx >> 5, ch = idx & 31; vv[it] = *(const u32x4*)(vg + (size_t)d * 256 + ch * 8); }
#pragma unroll
        for (int it = 0; it < 8; ++it) { const int idx = it * 512 + tid, key = idx >> 4, ch = idx & 15; *(LAS u32x4*)(lds + ATT_K_OFF + key * 256 + ((ch ^ (key & 15)) << 4)) = kv[it]; }
#pragma unroll
        for (int it = 0; it < 8; ++it) { const int idx = it * 512 + tid, d = idx >> 5, ch = idx & 31; const int m = (d & 31) << 3;
            u32x2 lo, hi2; lo.x = vv[it].x; lo.y = vv[it].y; hi2.x = vv[it].z; hi2.y = vv[it].w;
            *(LAS u32x2*)(lds + ATT_V_OFF + d * 512 + ((ch * 16) ^ m)) = lo;
            *(LAS u32x2*)(lds + ATT_V_OFF + d * 512 + ((ch * 16 + 8) ^ m)) = hi2; }
    }
    __syncthreads();
    const int c31 = lane & 31, hi = lane >> 5;
    const int tok0 = b * SEQ + qb * 256 + wave * 32;
    f16x8 qf[8];
    {
        const half_t* qp = PROJ16 + (size_t)(tok0 + c31) * INC + 1536 + h * 128 + 8 * hi;
#pragma unroll
        for (int s = 0; s < 8; ++s) qf[s] = *(const f16x8*)(qp + 16 * s);
    }
    __builtin_amdgcn_sched_barrier(0);
    f32x16 sb[8];
#pragma unroll
    for (int kb = 0; kb < 8; ++kb) {
        f32x16 a = {0.f, 0.f, 0.f, 0.f, 0.f, 0.f, 0.f, 0.f, 0.f, 0.f, 0.f, 0.f, 0.f, 0.f, 0.f, 0.f};
        const int key = kb * 32 + c31;
#pragma unroll
        for (int s = 0; s < 8; ++s) {
            const f16x8 kf = *(const LAS f16x8*)(lds + ATT_K_OFF + key * 256 + (((2 * s + hi) ^ (key & 15)) << 4));
            a = __builtin_amdgcn_mfma_f32_32x32x16_f16(kf, qf[s], a, 0, 0, 0);
        }
        sb[kb] = a;
    }
    __builtin_amdgcn_sched_barrier(0);
    float mx = -3.0e38f;
#pragma unroll
    for (int kb = 0; kb < 8; ++kb)
#pragma unroll
        for (int r = 0; r < 16; ++r) mx = fmaxf(mx, sb[kb][r]);
    mx = fmaxf(mx, __shfl_xor(mx, 32));
    const float c2 = 0.08838834764831845f * 1.4426950408889634f;
    const float mc = mx * c2;
    float l = 0.f;
    f16x8 pa[16];
#pragma unroll
    for (int kb = 0; kb < 8; ++kb)
#pragma unroll
        for (int s = 0; s < 2; ++s) {
#pragma unroll
            for (int j = 0; j < 8; ++j) { const float p = __builtin_amdgcn_exp2f(sb[kb][8 * s + j] * c2 - mc); l += p; pa[kb * 2 + s][j] = (_Float16)p; }
        }
    l += __shfl_xor(l, 32);
    LAS float* wsf = (LAS float*)(lds + ATT_WS_OFF) + wave * 32;
    if (hi == 0) wsf[c31] = l;
    __builtin_amdgcn_sched_barrier(0);
    f32x16 o[4];
#pragma unroll
    for (int db = 0; db < 4; ++db) o[db] = (f32x16){0.f, 0.f, 0.f, 0.f, 0.f, 0.f, 0.f, 0.f, 0.f, 0.f, 0.f, 0.f, 0.f, 0.f, 0.f, 0.f};
    const unsigned vbase = ATT_V_OFF + c31 * 512; const int m = c31 << 3;
#pragma unroll
    for (int ks = 0; ks < 16; ++ks) {
        const int kbyte = 32 * ks + 8 * hi;
#pragma unroll
        for (int db = 0; db < 4; ++db) {
            const f16x4 v0 = *(const LAS f16x4*)(lds + vbase + db * 16384 + (kbyte ^ m));
            const f16x4 v1 = *(const LAS f16x4*)(lds + vbase + db * 16384 + ((kbyte + 16) ^ m));
            const f16x8 vf = {v0[0], v0[1], v0[2], v0[3], v1[0], v1[1], v1[2], v1[3]};
            o[db] = __builtin_amdgcn_mfma_f32_32x32x16_f16(pa[ks], vf, o[db], 0, 0, 0);
        }
    }
    __builtin_amdgcn_sched_barrier(0);
    LDS_WAIT();
    half_t* op = CAT16 + (size_t)2 * T * 512 + (size_t)tok0 * 512 + h * 128 + c31;
#pragma unroll
    for (int r = 0; r < 16; ++r) {
        const int q = crow(r, hi);
        const float rl = __builtin_amdgcn_rcpf(wsf[q]);
#pragma unroll
        for (int db = 0; db < 4; ++db) op[(size_t)q * 512 + db * 32] = (_Float16)(o[db][r] * rl);
    }
    __syncthreads();
}

constexpr int SP_VT_OFF = 0, SP_W_OFF = 32768, SP_RS_OFF = 65536;
__device__ __forceinline__ void spatial_unit(LAS unsigned char* lds, const half_t* __restrict__ PROJ16, const float* __restrict__ VSQ, const half_t* __restrict__ WSP16, const float* __restrict__ b_sp, const float* __restrict__ g_sgu,
                                             half_t* CAT16, int bc, int h, int tid, int wave, int lane) {
    asm volatile("" : "+v"(tid), "+v"(lane));
    const int tok0 = bc * CHUNK;
    LAS float* rs = (LAS float*)(lds + SP_RS_OFF);
    if (tid < CHUNK) { const f32x4 a = *(const f32x4*)(VSQ + (size_t)(tok0 + tid) * 8), b = *(const f32x4*)(VSQ + (size_t)(tok0 + tid) * 8 + 4);
        const float q = ((a[0] + a[1]) + (a[2] + a[3])) + ((b[0] + b[1]) + (b[2] + b[3])); rs[tid] = 1.0f / sqrtf(q * (1.f / 512.f) + EPS); }
#pragma unroll
    for (int it = 0; it < 4; ++it) { const int idx = it * 512 + tid, t = idx >> 4, ch = idx & 15;
        *(LAS u32x4*)(lds + SP_W_OFF + t * 256 + ((ch ^ (t & 15)) << 4)) = *(const u32x4*)(WSP16 + ((size_t)h * CHUNK + t) * CHUNK + ch * 8); }
    __syncthreads();
#pragma unroll
    for (int it = 0; it < 4; ++it) {
        const int idx = it * 512 + tid, s = idx >> 4, ch = idx & 15;
        const f16x8 v = *(const f16x8*)(PROJ16 + (size_t)(tok0 + s) * INC + 1024 + h * SHD + ch * 8);
        const float r = rs[s];
#pragma unroll
        for (int j = 0; j < 8; ++j) { const int d = ch * 8 + j;
            *(LAS half_t*)(lds + SP_VT_OFF + d * 256 + ((((s >> 3) ^ (d & 15)) << 4) | ((s & 7) << 1))) = (_Float16)((float)v[j] * r); }
    }
    __syncthreads();
    const int c31 = lane & 31, hi = lane >> 5, tb = wave >> 1, dh = wave & 1;
    f32x16 acc[2];
    acc[0] = (f32x16){0.f, 0.f, 0.f, 0.f, 0.f, 0.f, 0.f, 0.f, 0.f, 0.f, 0.f, 0.f, 0.f, 0.f, 0.f, 0.f}; acc[1] = acc[0];
    const int t = tb * 32 + c31;
    const int nks = 2 * (tb + 1);
    for (int ks = 0; ks < nks; ++ks) {
        const f16x8 wf = *(const LAS f16x8*)(lds + SP_W_OFF + t * 256 + (((2 * ks + hi) ^ (t & 15)) << 4));
#pragma unroll
        for (int q = 0; q < 2; ++q) {
            const int d = (2 * dh + q) * 32 + c31;
            const f16x8 vf = *(const LAS f16x8*)(lds + SP_VT_OFF + d * 256 + (((2 * ks + hi) ^ (d & 15)) << 4));
            acc[q] = __builtin_amdgcn_mfma_f32_32x32x16_f16(vf, wf, acc[q], 0, 0, 0);
        }
    }
    const float bias = b_sp[h * CHUNK + t];
    const half_t* up = PROJ16 + (size_t)(tok0 + t) * INC + 512 + h * SHD;
    half_t* op = CAT16 + (size_t)T * 512 + (size_t)(tok0 + t) * 512 + h * SHD;
#pragma unroll
    for (int q = 0; q < 2; ++q)
#pragma unroll
        for (int rg = 0; rg < 4; ++rg) {
            const int d = (2 * dh + q) * 32 + 8 * rg + 4 * hi;
            const f16x4 u = *(const f16x4*)(up + d);
            const f32x4 g = *(const f32x4*)(g_sgu + h * SHD + d);
            u32x2 o;
            o.x = pk_h2((float)u[0] * (g[0] * acc[q][4 * rg + 0] + bias), (float)u[1] * (g[1] * acc[q][4 * rg + 1] + bias));
            o.y = pk_h2((float)u[2] * (g[2] * acc[q][4 * rg + 2] + bias), (float)u[3] * (g[3] * acc[q][4 * rg + 3] + bias));
            *(u32x2*)(op + d) = o;
        }
    __syncthreads();
}

constexpr int SL = 32, NCH = T / SL;
struct SsmTabs { half_t* ktab; half_t* et; half_t* ft; float* xend; half_t* xin; };

__device__ __forceinline__ void ssm_tables_item(LAS unsigned char* lds, const float* lam_re, const float* lam_im, const float* log_dt, const float* b_re, const float* b_im,
                                                const float* c_re, const float* c_im, const float* d_skip, const SsmTabs& tb, int g, int part, int tid) {
    LAS f32x2* pw = (LAS f32x2*)lds; LAS f32x2* bb = pw + 33 * 64; LAS f32x2* cc = bb + 64 * 16;
    const float dt = expf(log_dt[g]); const float idt = 1.0f / dt;
    {
        const int p = tid & 63, part = tid >> 6;
        const float are = lam_re[g * NP + p], aim = lam_im[g * NP + p];
#pragma unroll 1
        for (int k = part; k <= 32; k += 8) {
            const double ang = (double)aim * (double)dt * (double)k;
            const float e = expf(are * dt * (float)k);
            pw[k * 64 + p] = (f32x2){e * (float)cos(ang), e * (float)sin(ang)};
        }
        const double ang1 = (double)aim * (double)dt;
        const float e1 = expf(are * dt); const float lr = e1 * (float)cos(ang1), li = e1 * (float)sin(ang1);
        const float nr = lr - 1.f, ni = li, den = are * are + aim * aim;
        const float fr = (nr * are + ni * aim) / den * idt, fi = (ni * are - nr * aim) / den * idt;
#pragma unroll
        for (int q = 0; q < 2; ++q) { const int h = part * 2 + q; const float br = b_re[(g * NP + p) * SG + h], bi = b_im[(g * NP + p) * SG + h];
            bb[p * 16 + h] = (f32x2){fr * br - fi * bi, fr * bi + fi * br}; }
#pragma unroll
        for (int q = 0; q < 2; ++q) { const int i = tid * 2 + q; cc[i] = (f32x2){c_re[g * 1024 + i], c_im[g * 1024 + i]}; }
    }
    __syncthreads();
    half_t* kt = tb.ktab + (size_t)g * 33 * 256;
    if (part == 0 && tid < 256) kt[tid] = (_Float16)0.f;
#pragma unroll 1
    for (int j = part * 2; j < part * 2 + 2; ++j) {
        const int idx = j * 512 + tid, lag = idx >> 8, h = (idx >> 4) & 15, h2 = idx & 15;
        float acc = 0.f;
#pragma unroll 4
        for (int p = 0; p < 64; ++p) {
            const f32x2 c = cc[h * 64 + p], w = pw[lag * 64 + p], b = bb[p * 16 + h2];
            const float zr = c.x * w.x - c.y * w.y, zi = c.x * w.y + c.y * w.x;
            acc += zr * b.x - zi * b.y;
        }
        if (lag == 0 && h == h2) acc += d_skip[g * SG + h] * idt;
        kt[(lag + 1) * 256 + h * 16 + h2] = (_Float16)acc;
    }
    half_t* et = tb.et + (size_t)g * 128 * 512;
#pragma unroll 2
    for (int j = part * 4; j < part * 4 + 4; ++j) {
        const int idx = j * 512 + tid, hp = idx & 7, s = (idx >> 3) & 31, p = idx >> 8;
        const f32x2 w = pw[(31 - s) * 64 + p], b0 = bb[p * 16 + hp * 2], b1 = bb[p * 16 + hp * 2 + 1];
        *(unsigned*)(et + (size_t)p * 512 + s * 16 + hp * 2) = pk_h2(w.x * b0.x - w.y * b0.y, w.x * b1.x - w.y * b1.y);
        *(unsigned*)(et + (size_t)(64 + p) * 512 + s * 16 + hp * 2) = pk_h2(w.x * b0.y + w.y * b0.x, w.x * b1.y + w.y * b1.x);
    }
    half_t* ft = tb.ft + (size_t)g * 512 * 128;
#pragma unroll 2
    for (int j = part * 4; j < part * 4 + 4; ++j) {
        const int idx = j * 512 + tid, pp = idx & 31, h = (idx >> 5) & 15, t = idx >> 9;
        const f32x2 c0 = cc[h * 64 + pp * 2], c1 = cc[h * 64 + pp * 2 + 1], w0 = pw[(t + 1) * 64 + pp * 2], w1 = pw[(t + 1) * 64 + pp * 2 + 1];
        *(unsigned*)(ft + (size_t)(t * 16 + h) * 128 + pp * 2) = pk_h2(c0.x * w0.x - c0.y * w0.y, c1.x * w1.x - c1.y * w1.y);
        *(unsigned*)(ft + (size_t)(t * 16 + h) * 128 + 64 + pp * 2) = pk_h2(-(c0.x * w0.y + c0.y * w0.x), -(c1.x * w1.y + c1.y * w1.x));
    }
    __syncthreads();
}

__device__ __forceinline__ void ssm_stage_u(LAS unsigned char* ul, const half_t* __restrict__ PROJ16, int g, int q0, int tid) {
    u32x4 v[8];
#pragma unroll
    for (int i = 0; i < 8; ++i) { const int idx = i * 512 + tid, hh = idx & 1, tok = idx >> 1;
        v[i] = *(const u32x4*)(PROJ16 + (size_t)(q0 * 1024 + tok) * INC + g * SG + hh * 8); }
#pragma unroll
    for (int i = 0; i < 8; ++i) { const int idx = i * 512 + tid, hh = idx & 1, tok = idx >> 1, qi = tok >> 10, c = (tok >> 5) & 31, s = tok & 31;
        *(LAS u32x4*)(ul + qi * 32768 + s * 1024 + c * 32 + hh * 16) = v[i]; }
}
__device__ __forceinline__ void ssm_pass1_item(const LAS unsigned char* ul, const SsmTabs& tb, int g, int q, int cbk, int lane) {
    asm volatile("" : "+v"(lane));
    const int c31 = lane & 31, hi = lane >> 5;
    const half_t* ap = tb.et + ((size_t)g * 128 + cbk * 32 + c31) * 512 + 8 * hi;
    const LAS unsigned char* bp = ul + (q & 1) * 32768 + c31 * 32 + hi * 16;
    f32x16 acc = {0.f, 0.f, 0.f, 0.f, 0.f, 0.f, 0.f, 0.f, 0.f, 0.f, 0.f, 0.f, 0.f, 0.f, 0.f, 0.f};
#pragma unroll 16
    for (int ks = 0; ks < 32; ++ks) {
        const f16x8 a = *(const f16x8*)(ap + 16 * ks);
        const f16x8 b = *(const LAS f16x8*)(bp + ks * 1024);
        acc = __builtin_amdgcn_mfma_f32_32x32x16_f16(a, b, acc, 0, 0, 0);
    }
    float* xp = tb.xend + ((size_t)g * NCH + q * 32 + c31) * 128 + cbk * 32 + 4 * hi;
#pragma unroll
    for (int rg = 0; rg < 4; ++rg) *(f32x4*)(xp + 8 * rg) = (f32x4){acc[4 * rg], acc[4 * rg + 1], acc[4 * rg + 2], acc[4 * rg + 3]};
}

__device__ __forceinline__ void ssm_scan_wg(LAS unsigned char* lds, const float* lam_re, const float* lam_im, const float* log_dt, const SsmTabs& tb, int bg, int tid) {
    asm volatile("" : "+v"(tid));
    const int p = tid & 63, seg = tid >> 6, g = bg & 31, b = bg >> 5;
    LAS f32x2* tot = (LAS f32x2*)lds;
    const float are = lam_re[g * NP + p], aim = lam_im[g * NP + p];
    const float dt = expf(log_dt[g]);
    const double ang = (double)aim * (double)dt * 32.0;
    const float e = expf(are * dt * 32.f);
    const float Lr = e * (float)cos(ang), Li = e * (float)sin(ang);
    const float* xe = tb.xend + ((size_t)g * NCH + b * 128 + seg * 16) * 128 + p;
    half_t* xi = tb.xin + ((size_t)g * NCH + b * 128 + seg * 16) * 128 + p;
    float er[16], ei[16];
#pragma unroll
    for (int j = 0; j < 16; ++j) { er[j] = xe[(size_t)j * 128]; ei[j] = xe[(size_t)j * 128 + 64]; }
    float cr = 0.f, ci = 0.f;
#pragma unroll
    for (int j = 0; j < 16; ++j) {
        const float xr = er[j], xim = ei[j];
        er[j] = cr; ei[j] = ci;
        const float nr = Lr * cr - Li * ci + xr, ni = Lr * ci + Li * cr + xim;
        cr = nr; ci = ni;
    }
    tot[seg * 64 + p] = (f32x2){cr, ci};
    float Pr = Lr, Pi = Li;
#pragma unroll
    for (int k = 0; k < 4; ++k) { const float nr = Pr * Pr - Pi * Pi, ni = 2.f * Pr * Pi; Pr = nr; Pi = ni; }
    __syncthreads();
    float kr = 0.f, ki = 0.f;
    for (int s2 = 0; s2 < seg; ++s2) { const f32x2 t = tot[s2 * 64 + p]; const float nr = Pr * kr - Pi * ki + t.x, ni = Pr * ki + Pi * kr + t.y; kr = nr; ki = ni; }
#pragma unroll
    for (int j = 0; j < 16; ++j) {
        xi[(size_t)j * 128] = (_Float16)(er[j] + kr); xi[(size_t)j * 128 + 64] = (_Float16)(ei[j] + ki);
        const float nr = Lr * kr - Li * ki, ni = Lr * ki + Li * kr; kr = nr; ki = ni;
    }
    __syncthreads();
}

__device__ __forceinline__ void ssm_pass2_item(const LAS half_t* ktl, const LAS unsigned char* ul, const SsmTabs& tb, const float* log_dt, half_t* YSG16, int g, int q, int qq, int lane) {
    asm volatile("" : "+v"(lane));
    const int c31 = lane & 31, hi = lane >> 5;
    const int cbs[4] = {qq, 7 - qq, 8 + qq, 15 - qq};
    const int tl = c31 >> 4, h = c31 & 15;
    const LAS half_t* kt = ktl + h * 16 + 8 * hi;
    const LAS unsigned char* bp = ul + (q & 1) * 32768 + c31 * 32 + hi * 16;
    f32x16 acc[4];
#pragma unroll
    for (int j = 0; j < 4; ++j) acc[j] = (f32x16){0.f, 0.f, 0.f, 0.f, 0.f, 0.f, 0.f, 0.f, 0.f, 0.f, 0.f, 0.f, 0.f, 0.f, 0.f, 0.f};
#pragma unroll 16
    for (int ks = 0; ks < 32; ++ks) {
        const f16x8 b = *(const LAS f16x8*)(bp + ks * 1024);
#pragma unroll
        for (int j = 0; j < 4; ++j) {
            int lag = 2 * cbs[j] + tl - ks; lag = lag < -1 ? -1 : lag;
            const f16x8 a = *(const LAS f16x8*)(kt + (lag + 1) * 256);
            acc[j] = __builtin_amdgcn_mfma_f32_32x32x16_f16(a, b, acc[j], 0, 0, 0);
        }
    }
    const half_t* xp = tb.xin + ((size_t)g * NCH + q * 32 + c31) * 128 + 8 * hi;
#pragma unroll
    for (int kk = 0; kk < 8; ++kk) {
        const f16x8 b = *(const f16x8*)(xp + 16 * kk);
#pragma unroll
        for (int j = 0; j < 4; ++j) {
            const f16x8 a = *(const f16x8*)(tb.ft + ((size_t)g * 512 + cbs[j] * 32 + c31) * 128 + 16 * kk + 8 * hi);
            acc[j] = __builtin_amdgcn_mfma_f32_32x32x16_f16(a, b, acc[j], 0, 0, 0);
        }
    }
    const float dt = expf(log_dt[g]);
    half_t* yp = YSG16 + (size_t)((q * 32 + c31) * SL) * SSMW + g * SG;
#pragma unroll
    for (int j = 0; j < 4; ++j)
#pragma unroll
        for (int rg = 0; rg < 4; ++rg) {
            const int t = 2 * cbs[j] + (rg >> 1), hh = 8 * (rg & 1) + 4 * hi;
            u32x2 o; o.x = pk_h2(fast_gelu(dt * acc[j][4 * rg]), fast_gelu(dt * acc[j][4 * rg + 1])); o.y = pk_h2(fast_gelu(dt * acc[j][4 * rg + 2]), fast_gelu(dt * acc[j][4 * rg + 3]));
            *(u32x2*)(yp + (size_t)t * SSMW + hh) = o;
        }
}

constexpr int MOE_TILES_OFF = RING_BYTES + 4096, MOE_MAXTILES = 192, MOE_NT_OFF = MOE_TILES_OFF + MOE_MAXTILES * 16, MOE_RIDX_OFF = MOE_NT_OFF + 256, MOE_RIDX_CAP = 8;
typedef int i32x4 __attribute__((ext_vector_type(4)));
struct RouteBufs { int* eid; float* ew; int* posOf; float* rsT; float* rsrow; int* wghist; const half_t* wrt_hi; const half_t* wrt_lo; };

__device__ __forceinline__ void route_block(LAS unsigned char* lds, const half_t* __restrict__ H16, const RouteBufs& rb, const float* b_group, const float* b_router, int tb, int tid, int wave, int lane) {
    asm volatile("" : "+v"(tid), "+v"(lane));
    LAS float* part = (LAS float*)(lds + 81920);
    LAS float* lg   = (LAS float*)(lds + 106496);
    LAS float* rsl  = (LAS float*)(lds + 126976);
    LAS float* ssp  = (LAS float*)(lds + 127232);
    LAS int*   hist = (LAS int*)(lds + 127488);
    if (tid < 64) hist[tid] = 0;
    const int it = wave >> 1, kh = wave & 1, fr = lane & 15, fq = lane >> 4;
    const int tok0 = tb * 64 + it * 16;
    constexpr int RT_OFF = 0, RT_BUF = 40960, RT_LO = 20480;
    const half_t* hp = H16 + (size_t)(tok0 + fr) * DM + kh * 64 + 8 * fq;
    f32x4 acc[5];
#pragma unroll
    for (int nb = 0; nb < 5; ++nb) acc[nb] = (f32x4){0.f, 0.f, 0.f, 0.f};
    float ss = 0.f;
    u32x4 stg[5];
#define RT_LOAD(s) do { _Pragma("unroll") for (int _i = 0; _i < 5; ++_i) { const int idx = _i * 512 + tid, hl = idx >= 1280, r = hl ? idx - 1280 : idx, n = r >> 4, c = r & 15; \
        stg[_i] = *(const u32x4*)((hl ? rb.wrt_lo : rb.wrt_hi) + (size_t)n * DM + (s) * 128 + c * 8); } } while (0)
#define RT_STORE(buf) do { _Pragma("unroll") for (int _i = 0; _i < 5; ++_i) { const int idx = _i * 512 + tid, hl = idx >= 1280, r = hl ? idx - 1280 : idx, n = r >> 4, c = r & 15; \
        *(LAS u32x4*)(lds + RT_OFF + (buf) * RT_BUF + hl * RT_LO + n * 256 + ((c ^ (n & 15)) << 4)) = stg[_i]; } } while (0)
    RT_LOAD(0); RT_STORE(0);
    __syncthreads();
#pragma unroll 1
    for (int s = 0; s < 8; ++s) {
        if (s + 1 < 8) RT_LOAD(s + 1);
        const LAS unsigned char* tbuf = lds + RT_OFF + (s & 1) * RT_BUF;
#pragma unroll
        for (int kk = 0; kk < 2; ++kk) {
            const f16x8 xh = *(const f16x8*)(hp + s * 128 + kk * 32);
#pragma unroll
            for (int j = 0; j < 8; ++j) { const float f = (float)xh[j]; ss += f * f; }
            const int ch = (kh * 2 + kk) * 4 + fq;
#pragma unroll
            for (int nb = 0; nb < 5; ++nb) {
                const int n = nb * 16 + fr;
                const f16x8 bh = *(const LAS f16x8*)(tbuf + n * 256 + ((ch ^ (n & 15)) << 4)), bl = *(const LAS f16x8*)(tbuf + RT_LO + n * 256 + ((ch ^ (n & 15)) << 4));
                acc[nb] = __builtin_amdgcn_mfma_f32_16x16x32_f16(xh, bh, acc[nb], 0, 0, 0);
                acc[nb] = __builtin_amdgcn_mfma_f32_16x16x32_f16(xh, bl, acc[nb], 0, 0, 0);
            }
        }
        if (s + 1 < 8) RT_STORE((s + 1) & 1);
        __syncthreads();
    }
#undef RT_LOAD
#undef RT_STORE
    ss += __shfl_xor(ss, 16); ss += __shfl_xor(ss, 32);
    if (kh == 1) {
        LAS float* pp = part + (it * 64 + lane) * 24;
#pragma unroll
        for (int nb = 0; nb < 5; ++nb) *(LAS f32x4*)(pp + 4 * nb) = acc[nb];
        if (fq == 0) ssp[it * 16 + fr] = ss;
    }
    __syncthreads();
    if (kh == 0) {
        const LAS float* pp = part + (it * 64 + lane) * 24;
#pragma unroll
        for (int nb = 0; nb < 5; ++nb) acc[nb] += *(const LAS f32x4*)(pp + 4 * nb);
        if (fq == 0) { const float tot = ss + ssp[it * 16 + fr]; const float rs = 1.0f / sqrtf(tot * (1.f / 1024.f) + EPS); rsl[it * 16 + fr] = rs; rb.rsT[tok0 + fr] = rs; }
        LDS_WAIT();
#pragma unroll
        for (int nb = 0; nb < 5; ++nb) {
            const int n = nb * 16 + fr;
            const float bias = (n < 64) ? b_router[n] : ((n < 72) ? b_group[n - 64] : 0.f);
#pragma unroll
            for (int r = 0; r < 4; ++r) { const int tk = 4 * fq + r; lg[(it * 16 + tk) * 80 + n] = acc[nb][r] * rsl[it * 16 + tk] * (1.f / 64.f) + bias; }
        }
        LDS_WAIT();
        if (lane < 16) {
            const LAS float* l = lg + (it * 16 + lane) * 80;
            int gi = 0; float gm = l[64];
#pragma unroll
            for (int g = 1; g < 8; ++g) { const float v = l[64 + g]; if (v > gm) { gm = v; gi = g; } }
            float den = 0.f;
#pragma unroll
            for (int g = 0; g < 8; ++g) den += expf(l[64 + g] - gm);
            const float gw = 1.f / den;
            const LAS float* el = l + gi * 8;
            int i0 = 0; float v0 = el[0];
#pragma unroll
            for (int e = 1; e < 8; ++e) { const float v = el[e]; if (v > v0) { v0 = v; i0 = e; } }
            int i1 = -1; float v1 = -3.0e38f;
#pragma unroll
            for (int e = 0; e < 8; ++e) { const float v = el[e]; if (e != i0 && v > v1) { v1 = v; i1 = e; } }
            const float w0 = 1.f / (1.f + expf(v1 - v0)), w1 = 1.f - w0;
            const int e0 = gi * 8 + i0, e1 = gi * 8 + i1, tok = tok0 + lane;
            rb.eid[tok * 2] = e0; rb.eid[tok * 2 + 1] = e1;
            rb.ew[tok * 2] = gw * w0; rb.ew[tok * 2 + 1] = gw * w1;
            __hip_atomic_fetch_add(&hist[e0], 1, __ATOMIC_RELAXED, __HIP_MEMORY_SCOPE_WORKGROUP); __hip_atomic_fetch_add(&hist[e1], 1, __ATOMIC_RELAXED, __HIP_MEMORY_SCOPE_WORKGROUP);
        }
    }
    __syncthreads();
    if (tid < 64) rb.wghist[tb * 64 + tid] = hist[tid];
    __syncthreads();
}

__device__ __forceinline__ void gather_block(LAS unsigned char* lds, const RouteBufs& rb, int* srcTok, int tb, bool do_rows, int tid, int wave, int lane) {
    asm volatile("" : "+v"(tid), "+v"(lane));
    LAS int* psumA = (LAS int*)lds;
    LAS int* psumP = psumA + 512;
    LAS int* base  = psumP + 512;
    LAS int* lcur  = base + 64;
    LAS i32x4* tiles = (LAS i32x4*)(lds + MOE_TILES_OFF);
    LAS int* ntl = (LAS int*)(lds + MOE_NT_OFF);
    {
        const int e = tid & 63, part = tid >> 6; int sa = 0, sp = 0;
#pragma unroll 4
        for (int w = part * 32; w < part * 32 + 32; ++w) { const int v = rb.wghist[w * 64 + e]; sa += v; sp += (w < tb) ? v : 0; }
        psumA[part * 64 + e] = sa; psumP[part * 64 + e] = sp;
    }
    __syncthreads();
    if (wave == 0) {
        int tot = 0, pre = 0;
#pragma unroll
        for (int p = 0; p < 8; ++p) { tot += psumA[p * 64 + lane]; pre += psumP[p * 64 + lane]; }
        const int nfull = tot >> 8, rem = tot & 255;
        int rs_incl = tot, fs_incl = nfull;
#pragma unroll
        for (int o = 1; o < 64; o <<= 1) { const int a = __shfl_up(rs_incl, o), b = __shfl_up(fs_incl, o); if (lane >= o) { rs_incl += a; fs_incl += b; } }
        const int rstart = rs_incl - tot, fstart = fs_incl - nfull;
        const int totfull = __shfl(fs_incl, 63);
        int rank = 0, npart = 0;
        for (int e2 = 0; e2 < 64; ++e2) { const int r2 = __shfl(rem, e2); npart += (r2 > 0) ? 1 : 0; rank += (r2 > rem || (r2 == rem && e2 < lane)) ? 1 : 0; }
        base[lane] = rstart + pre; lcur[lane] = 0;
        for (int j = 0; j < nfull; ++j) if (fstart + j < MOE_MAXTILES) tiles[fstart + j] = (i32x4){lane, rstart + 256 * j, 256, 0};
        if (rem > 0 && totfull + rank < MOE_MAXTILES) tiles[totfull + rank] = (i32x4){lane, rstart + 256 * nfull, rem, 0};
        const int ts_incl = totfull + npart;
        if (lane == 63) ntl[0] = ts_incl < MOE_MAXTILES ? ts_incl : MOE_MAXTILES;
    }
    __syncthreads();
    if (do_rows) {
        if (lane < 16) {
            const int a = wave * 16 + lane, t = tb * 64 + (a >> 1), k = a & 1;
            const int e = rb.eid[t * 2 + k];
            const int pos = base[e] + __hip_atomic_fetch_add(&lcur[e], 1, __ATOMIC_RELAXED, __HIP_MEMORY_SCOPE_WORKGROUP);
            rb.posOf[t * 2 + k] = pos; rb.rsrow[pos] = rb.rsT[t]; srcTok[pos] = t;
        }
    }
    __syncthreads();
}

template <int NT>
__device__ __forceinline__ void final_tokens(const half_t* __restrict__ H16, const half_t* __restrict__ YS16, const RouteBufs& rb, const float* g_final, float* out, int tok0, int stride, int lane) {
    f32x4 hv[NT][4]; f16x4 hh[NT][4], av[NT][4], bv[NT][4]; float w0[NT], w1[NT];
#pragma unroll
    for (int i = 0; i < NT; ++i) {
        const int tok = tok0 + i * stride;
        const int p0 = rb.posOf[tok * 2], p1 = rb.posOf[tok * 2 + 1];
        w0[i] = rb.ew[tok * 2]; w1[i] = rb.ew[tok * 2 + 1];
#pragma unroll
        for (int j = 0; j < 4; ++j) { const int c = 4 * lane + 256 * j;
            hh[i][j] = *(const f16x4*)(H16 + (size_t)tok * DM + c);
            av[i][j] = *(const f16x4*)(YS16 + (size_t)p0 * DM + c); bv[i][j] = *(const f16x4*)(YS16 + (size_t)p1 * DM + c); }
    }
#pragma unroll
    for (int i = 0; i < NT; ++i) {
        const int tok = tok0 + i * stride; float s = 0.f;
#pragma unroll
        for (int j = 0; j < 4; ++j)
#pragma unroll
            for (int q = 0; q < 4; ++q) { hv[i][j][q] = (float)hh[i][j][q] + (w0[i] * (float)av[i][j][q] + w1[i] * (float)bv[i][j][q]); s += hv[i][j][q] * hv[i][j][q]; }
        const float rs = 1.0f / sqrtf(wave_sum(s) * (1.f / 1024.f) + EPS);
#pragma unroll
        for (int j = 0; j < 4; ++j) { const int c = 4 * lane + 256 * j; const f32x4 g = *(const f32x4*)(g_final + c); *(f32x4*)(out + (size_t)tok * DM + c) = hv[i][j] * rs * g; }
    }
}

namespace pg {
__device__ __forceinline__ bool moe_unit(int i, int G, int c, int ntiles, int& tile, int& pn) {
    if ((G & 31) == 0) { const int per = G >> 3, x = c & 7, slot = c >> 3; tile = i * (G >> 2) + x * (per >> 2) + (slot >> 2); pn = slot & 3; }
    else { const int L = i * G + c; tile = L >> 2; pn = L & 3; }
    return tile < ntiles;
}
struct OrderMoe {
    const LAS i32x4* tiles; int ntiles, G, c; const char* A; size_t rowA; const char* B; size_t expB, tileB; bool gather;
    __device__ bool next(int i, Unit& u) const {
        int tile, pn; if (!moe_unit(i, G, c, ntiles, tile, pn)) return false;
        const i32x4 t = tiles[tile];
        u.pm = t.y; u.pn = pn; u.aux = t.z;
        u.A = A + (size_t)(gather ? 0 : t.y) * rowA; u.B = B + (size_t)t.x * expB + (size_t)pn * tileB; return true;
    }
};
struct EpiUp {
    static constexpr bool PERM = true;
    half_t* O; const float* rsrow;
    __device__ __forceinline__ void operator()(const f32x4 (&acc)[2][2][4][2], const Unit& u, int wr, int wc, int fr, int fq) const {
        const int col0 = u.pn * HALF + wc * 32 + 8 * fq;
#pragma unroll
        for (int ai = 0; ai < 2; ++ai)
#pragma unroll
            for (int m = 0; m < 4; ++m) {
                const int rl = ai * HALF + wr * 64 + m * 16 + fr;
                if (rl < u.aux) {
                    const float rs = rsrow[u.pm + rl];
                    const f32x4 a0 = acc[ai][0][m][0] * rs, a1 = acc[ai][0][m][1] * rs, b0 = acc[ai][1][m][0] * rs, b1 = acc[ai][1][m][1] * rs;
                    u32x4 w; w.x = pk_h2(a0[0] * fast_sigmoid(a0[0]) * b0[0], a0[1] * fast_sigmoid(a0[1]) * b0[1]); w.y = pk_h2(a0[2] * fast_sigmoid(a0[2]) * b0[2], a0[3] * fast_sigmoid(a0[3]) * b0[3]);
                    w.z = pk_h2(a1[0] * fast_sigmoid(a1[0]) * b1[0], a1[1] * fast_sigmoid(a1[1]) * b1[1]); w.w = pk_h2(a1[2] * fast_sigmoid(a1[2]) * b1[2], a1[3] * fast_sigmoid(a1[3]) * b1[3]);
                    *(u32x4*)(O + (size_t)(u.pm + rl) * DFF + col0) = w; } }
    }
};
struct EpiDown {
    static constexpr bool PERM = true;
    half_t* O;
    __device__ __forceinline__ void operator()(const f32x4 (&acc)[2][2][4][2], const Unit& u, int wr, int wc, int fr, int fq) const {
        const int col0 = u.pn * BM + wc * 32 + 8 * fq;
#pragma unroll
        for (int ai = 0; ai < 2; ++ai)
#pragma unroll
            for (int m = 0; m < 4; ++m) {
                const int rl = ai * HALF + wr * 64 + m * 16 + fr;
                if (rl < u.aux) {
#pragma unroll
                    for (int bj = 0; bj < 2; ++bj) { const f32x4 v0 = acc[ai][bj][m][0], v1 = acc[ai][bj][m][1];
                        u32x4 w; w.x = pk_h2(v0[0], v0[1]); w.y = pk_h2(v0[2], v0[3]); w.z = pk_h2(v1[0], v1[1]); w.w = pk_h2(v1[2], v1[3]);
                        *(u32x4*)(O + (size_t)(u.pm + rl) * DM + col0 + bj * HALF) = w; } } }
    }
};
}

constexpr size_t MiB = 1u << 20;
constexpr int CW_BAR = 4096;
constexpr size_t WS_CTL = 0, CTL_ZERO_BYTES = 64 * 1024;
constexpr size_t WS_K16 = 1 * MiB, WS_VT16 = 2 * MiB, WS_KTAB = 3 * MiB;
constexpr size_t WS_ROUTE = 4 * MiB;
constexpr size_t WS_WRT = 5 * MiB;
constexpr size_t WS_VSQ = 5 * MiB + 384 * 1024, WS_WSP16 = 5 * MiB + 896 * 1024;
constexpr size_t WS_MEMN16 = 6 * MiB;
constexpr size_t WS_ET = 8 * MiB, WS_FT = 12 * MiB, WS_XEND = 16 * MiB, WS_XIN = 24 * MiB;
constexpr size_t WS_WINT = 28 * MiB, WS_WGATET = 32 * MiB, WS_WGLUT = 38 * MiB, WS_WKVT = 39 * MiB, WS_WBRT = 41 * MiB, WS_WOUTT = 44 * MiB;
constexpr size_t WS_W13T = 46 * MiB, WS_W2T = 174 * MiB;
constexpr size_t WS_PROJ16 = 238 * MiB, WS_XS16 = 238 * MiB;
constexpr size_t WS_G16 = 303 * MiB, WS_YS16 = 303 * MiB;
constexpr size_t WS_N16 = 399 * MiB, WS_H16 = 399 * MiB;
constexpr size_t WS_MERGED16 = 335 * MiB;
constexpr size_t WS_CAT16 = 432 * MiB, WS_YSG16 = 480 * MiB, WS_HT16 = 432 * MiB;
constexpr size_t WS_END = 496 * MiB;

struct Args { const float* in[32]; float* out; unsigned char* ws; int ph_lo, ph_hi, li, pad; };
struct Frame { LAS unsigned char* lds; volatile LAS unsigned* MISC; unsigned* ctl; int tid, lane, wave, vcu, G; };

__device__ __forceinline__ SsmTabs make_tabs(unsigned char* ws) { SsmTabs t; t.ktab = (half_t*)(ws + WS_KTAB); t.et = (half_t*)(ws + WS_ET); t.ft = (half_t*)(ws + WS_FT); t.xend = (float*)(ws + WS_XEND); t.xin = (half_t*)(ws + WS_XIN); return t; }
__device__ __forceinline__ RouteBufs make_route(unsigned char* ws) {
    RouteBufs r; unsigned char* b = ws + WS_ROUTE;
    r.eid = (int*)b; r.ew = (float*)(b + 131072); r.posOf = (int*)(b + 262144); r.rsT = (float*)(b + 393216); r.rsrow = (float*)(b + 458752); r.wghist = (int*)(b + 655360);
    r.wrt_hi = (const half_t*)(ws + WS_WRT); r.wrt_lo = (const half_t*)(ws + WS_WRT + 163840); return r;
}

__device__ __forceinline__ void p0_prologue(const Frame& F, const Args& a) {
    { const SsmTabs tb = make_tabs(a.ws);
#ifndef P0_REP_TAB
#define P0_REP_TAB 1
#endif
      for (int rr = 0; rr < P0_REP_TAB; ++rr) for (int wi = F.vcu; wi < NG * 8; wi += F.G) ssm_tables_item(F.lds, a.in[7], a.in[8], a.in[9], a.in[10], a.in[11], a.in[12], a.in[13], a.in[14], tb, wi >> 3, wi & 7, F.tid); }
    LAS float* scr = (LAS float*)(F.lds + RING_OFF + F.wave * 16384);
    const int gw = F.vcu * NWAVES + F.wave, NGW = F.G * NWAVES;
    {
        half_t* whi = (half_t*)(a.ws + WS_WRT); half_t* wlo = (half_t*)(a.ws + WS_WRT + 163840);
        for (int idx = gw * 64 + F.lane; idx < 80 * DM; idx += NGW * 64) {
            const int n = idx >> 10, k = idx & 1023;
            float w = 0.f;
            if (n < 64) w = a.in[26][k * NE + n]; else if (n < 72) w = a.in[24][k * NGRP + (n - 64)];
            w *= 64.f * a.in[23][k];
            const _Float16 h = (_Float16)w; whi[idx] = h; wlo[idx] = (_Float16)(w - (float)h);
        }
    }
    { half_t* wsp = (half_t*)(a.ws + WS_WSP16);
      for (int idx = gw * 64 + F.lane; idx < SH * CHUNK * CHUNK; idx += NGW * 64) { const int s = idx & 127, t = (idx >> 7) & 127; wsp[idx] = (_Float16)(s <= t ? a.in[18][idx] : 0.f); } }
#pragma unroll 1
    for (int j = 0; j < 8; ++j) {
        const float* W; int ldw, K, N, mode = 0; half_t* WT;
        switch (j) {
            case 0: W = a.in[4];  ldw = INC;  K = DM;  N = INC;  WT = (half_t*)(a.ws + WS_WINT); break;
            case 1: W = a.in[20]; ldw = 1024; K = DM;  N = 1024; WT = (half_t*)(a.ws + WS_WKVT); break;
            case 2: W = a.in[5];  ldw = 3072; K = DM;  N = 3072; WT = (half_t*)(a.ws + WS_WGATET); break;
            case 3: W = a.in[15]; ldw = 1024; K = 512; N = 1024; WT = (half_t*)(a.ws + WS_WGLUT); mode = 1; break;
            case 4: W = a.in[21];                     ldw = 1024; K = 512; N = 1024; WT = (half_t*)(a.ws + WS_WBRT); break;
            case 5: W = a.in[21] + 512 * 1024;        ldw = 1024; K = 512; N = 1024; WT = (half_t*)(a.ws + WS_WBRT) + 1024 * 512; break;
            case 6: W = a.in[21] + 2 * 512 * 1024;    ldw = 1024; K = 512; N = 1024; WT = (half_t*)(a.ws + WS_WBRT) + 2 * 1024 * 512; break;
            default: W = a.in[22]; ldw = 1024; K = DM; N = 1024; WT = (half_t*)(a.ws + WS_WOUTT); break;
        }
        const int nblk = N / 32, items = (K / 64) * nblk;
#pragma unroll 1
        for (int it = gw; it < items; it += NGW) {
            const int kb = it / nblk, nb = it % nblk, n0 = nb * 32;
            int drow = n0;
            if (mode == 1) { const int half = n0 >> 9, jj = n0 & 511; drow = (jj >> 7) * 256 + half * 128 + (jj & 127); }
            transpose_item(W, ldw, kb * 64, n0, WT, K, drow, scr, F.lane);
        }
    }
    half_t* MEMN16 = (half_t*)(a.ws + WS_MEMN16);
    for (int m = gw; m < MROWS; m += NGW) rms_row_to_f16(a.in[1] + (size_t)m * DM, a.in[3], MEMN16 + (size_t)m * DM, F.lane);
    half_t* N16 = (half_t*)(a.ws + WS_N16);
#ifndef P0_REP_N16
#define P0_REP_N16 1
#endif
    for (int m = gw; m < P0_REP_N16 * T; m += NGW) rms_row_to_f16(a.in[0] + (size_t)(m % T) * DM, a.in[2], N16 + (size_t)(m % T) * DM, F.lane);
    {
        half_t* W13T = (half_t*)(a.ws + WS_W13T); half_t* W2T = (half_t*)(a.ws + WS_W2T);
#ifndef P0_REP_EXP
#define P0_REP_EXP 1
#endif
#pragma unroll 1
        for (int it = gw; it < P0_REP_EXP * NE * 768; it += NGW) {
            const int e = (it / 768) % NE, r = it % 768, which = r >> 8, q = r & 255;
            if (which < 2) {
                const int kb = q >> 4, nb = q & 15, n0 = nb * 32;
                const float* W = (which == 0 ? a.in[28] : a.in[29]) + (size_t)e * DM * DFF;
                transpose_item(W, DFF, kb * 64, n0, W13T + (size_t)e * 1024 * 1024, 1024, (n0 >> 7) * 256 + which * 128 + (n0 & 127), scr, F.lane, a.in[23]);
            } else {
                const int kb = q >> 5, nb = q & 31, n0 = nb * 32;
                transpose_item(a.in[30] + (size_t)e * DFF * DM, DM, kb * 64, n0, W2T + (size_t)e * 1024 * 512, 512, n0, scr, F.lane);
            }
        }
    }
}

__global__ void __launch_bounds__(NWAVES * 64, 2) mk_fwd(Args args) {
    extern __shared__ __attribute__((aligned(16))) unsigned char lds[];
#ifdef PROBE_ENTRY
    const unsigned long long t_entry = __builtin_amdgcn_s_memrealtime();
#endif
    Frame F;
    F.lds = (LAS unsigned char*)lds;
    F.MISC = (volatile LAS unsigned*)(F.lds + MISC_OFF);
    F.tid = threadIdx.x; F.lane = F.tid & 63; F.wave = __builtin_amdgcn_readfirstlane(F.tid >> 6);
    F.G = gridDim.x; { const int bx = blockIdx.x; F.vcu = (F.G % 8 == 0) ? (bx % 8) * (F.G / 8) + bx / 8 : bx; }
    F.ctl = (unsigned*)(args.ws + WS_CTL);
    for (int u = F.tid; u < (LDS_BYTES - LDSCTL_OFF) / 4; u += NWAVES * 64) ((LAS unsigned*)(F.lds + LDSCTL_OFF))[u] = 0u;
    __syncthreads();
    XcdBarrier bar = xcd_barrier_post(F.ctl + CW_BAR + args.li * XCD_BAR_WORDS, F.MISC + 8);
    const int lo = args.ph_lo, hi = args.ph_hi;
    unsigned char* ws = args.ws;
    const int gw = F.vcu * NWAVES + F.wave, NGW = F.G * NWAVES;
#ifdef PROBE_PHASE
    volatile LAS unsigned long long* tsl = (volatile LAS unsigned long long*)(F.lds + LDSCTL_OFF + 512);
#define STAMP(k) do { if (blockIdx.x == 0 && F.tid == 0) tsl[k] = __builtin_amdgcn_s_memrealtime(); } while (0)
#else
#define STAMP(k) do { } while (0)
#endif
    STAMP(0);
#ifdef PROBE_ENTRY
    if (blockIdx.x == 0 && F.tid == 0) tsl[15] = t_entry;
#endif
#define IN(k) (lo <= (k) && (k) < hi)
#define BOTH(k) (IN(k) && IN((k) + 1))
    if (IN(0)) { p0_prologue(F, args); if (BOTH(0)) xcd_barrier(bar); }
    STAMP(1);
    if (IN(1)) {
        pg::OrderMN S; S.init(T, INC, F.G, (int)blockIdx.x, ws + WS_N16, DM, ws + WS_WINT, DM);
        pg::EpiProj E{(half_t*)(ws + WS_PROJ16), INC, (float*)(ws + WS_VSQ)};
        pg::gemm_phase<pg::EpiProj, pg::OrderMN, true, false>(F.lds + RING_OFF, DM, DM, DM / 64, S, E);
        for (int t = F.vcu; t < 256; t += F.G) kv_tile((const half_t*)(ws + WS_MEMN16), (const half_t*)(ws + WS_WKVT), (half_t*)(ws + WS_K16), (half_t*)(ws + WS_VT16), t, F.wave, F.lane);
        if (BOTH(1)) xcd_barrier(bar);
    }
    STAMP(2);
    if (IN(2)) {
        const SsmTabs tb = make_tabs(ws);
        for (int wgi = F.vcu; wgi < 256; wgi += F.G) {
            ssm_stage_u(F.lds, (const half_t*)(ws + WS_PROJ16), wgi >> 3, 2 * (wgi & 7), F.tid);
            __syncthreads();
            const int gwi = wgi * 8 + F.wave;
            ssm_pass1_item(F.lds, tb, gwi >> 6, (gwi >> 2) & 15, gwi & 3, F.lane);
            __syncthreads();
        }
        if (BOTH(2)) xcd_barrier(bar);
    }
    STAMP(3);
    if (IN(3)) {
        { const SsmTabs tb = make_tabs(ws);
          for (int bg = (F.G - 1 - F.vcu); bg < BATCH * NG; bg += F.G) ssm_scan_wg(F.lds, args.in[7], args.in[8], args.in[9], tb, bg, F.tid); }
#ifndef P3_REP_ATT
#define P3_REP_ATT 1
#endif
#ifndef P3_REP_SP
#define P3_REP_SP 1
#endif
        for (int rr = 0; rr < P3_REP_ATT; ++rr) for (int u = F.vcu; u < 256; u += F.G)
            attn_unit(F.lds, (const half_t*)(ws + WS_PROJ16), (const half_t*)(ws + WS_K16), (const half_t*)(ws + WS_VT16), (half_t*)(ws + WS_CAT16), (u >> 4) >> 2, (u >> 4) & 3, u & 15, F.tid, F.wave, F.lane);
        for (int rr = 0; rr < P3_REP_SP; ++rr) for (int u = F.vcu; u < 512; u += F.G)
            spatial_unit(F.lds, (const half_t*)(ws + WS_PROJ16), (const float*)(ws + WS_VSQ), (const half_t*)(ws + WS_WSP16), args.in[19], args.in[17], (half_t*)(ws + WS_CAT16), u >> 2, u & 3, F.tid, F.wave, F.lane);
        if (BOTH(3)) xcd_barrier(bar);
    }
    STAMP(4);
    if (IN(4)) {
        const SsmTabs tb = make_tabs(ws);
        for (int wgi = F.vcu; wgi < 256; wgi += F.G) {
            const int g = wgi >> 3;
            for (int i = F.tid; i < 33 * 256 / 8; i += NWAVES * 64) *(LAS u32x4*)(F.lds + 65536 + i * 16) = *(const u32x4*)(tb.ktab + (size_t)g * 33 * 256 + i * 8);
            ssm_stage_u(F.lds, (const half_t*)(ws + WS_PROJ16), g, 2 * (wgi & 7), F.tid);
            __syncthreads();
            const int gwi = wgi * 8 + F.wave;
            ssm_pass2_item((const LAS half_t*)(F.lds + 65536), F.lds, tb, args.in[9], (half_t*)(ws + WS_YSG16), gwi >> 6, (gwi >> 2) & 15, gwi & 3, F.lane);
            __syncthreads();
        }
        if (BOTH(4)) xcd_barrier(bar);
    }
    STAMP(5);
    if (IN(5)) {
        { pg::OrderMN S; S.init(T, 1024, F.G, (int)blockIdx.x, ws + WS_YSG16, 512, ws + WS_WGLUT, 512);
          pg::EpiGlu E{(half_t*)(ws + WS_CAT16), 512, args.in[16]};
          pg::gemm_phase<pg::EpiGlu, pg::OrderMN, true, false>(F.lds + RING_OFF, 512, 512, 8, S, E); }
        if (BOTH(5)) xcd_barrier(bar);
    }
    STAMP(6);
    if (IN(6)) {
        pg::OrderGB128 S; S.init(F.G, (int)blockIdx.x, ws + WS_N16, ws + WS_WGATET, ws + WS_CAT16, ws + WS_WBRT);
        pg::gemm_phase_gb128(F.lds + RING_OFF, S, args.in[6], (half_t*)(ws + WS_MERGED16));
        if (BOTH(6)) xcd_barrier(bar);
    }
    STAMP(7);
    if (IN(7)) {
        pg::OrderMN S; S.init(T, 1024, F.G, (int)blockIdx.x, ws + WS_MERGED16, DM, ws + WS_WOUTT, DM);
        pg::EpiOut E{(half_t*)(ws + WS_HT16), args.in[0], DM};
        pg::gemm_phase<pg::EpiOut, pg::OrderMN, true, false>(F.lds + RING_OFF, DM, DM, 16, S, E);
        if (BOTH(7)) xcd_barrier(bar);
    }
    STAMP(8);
    if (IN(8)) {
        const RouteBufs rb = make_route(ws);
        for (int tb = F.vcu; tb < 256; tb += F.G) route_block(F.lds, (const half_t*)(ws + WS_HT16), rb, args.in[25], args.in[27], tb, F.tid, F.wave, F.lane);
        if (BOTH(8)) xcd_barrier(bar);
    }
    STAMP(9);
    if (IN(9)) {
        const RouteBufs rb = make_route(ws);
        bool any = false;
        for (int tb = F.vcu; tb < 256; tb += F.G) { gather_block(F.lds, rb, (int*)(ws + WS_ROUTE + 786432), tb, true, F.tid, F.wave, F.lane); any = true; }
        if (!any) gather_block(F.lds, rb, (int*)(ws + WS_ROUTE + 786432), 0, false, F.tid, F.wave, F.lane);
        if (BOTH(9)) xcd_barrier(bar);
    }
    STAMP(10);
    if (IN(10)) {
        const RouteBufs rb = make_route(ws);
        const int ntiles = *(const LAS int*)(F.lds + MOE_NT_OFF);
        LAS int* ridxc = (LAS int*)(F.lds + MOE_RIDX_OFF);
        { const int* srcTok = (const int*)(ws + WS_ROUTE + 786432); const LAS i32x4* tiles = (const LAS i32x4*)(F.lds + MOE_TILES_OFF);
          for (int j = 0; j < MOE_RIDX_CAP; ++j) { int tile, pn; if (!pg::moe_unit(j, F.G, (int)blockIdx.x, ntiles, tile, pn)) break;
              const i32x4 t = tiles[tile]; if (F.tid < 256) ridxc[j * 256 + F.tid] = srcTok[t.y + (F.tid < t.z ? F.tid : 0)]; }
          __syncthreads(); }
        pg::OrderMoe S{(const LAS i32x4*)(F.lds + MOE_TILES_OFF), ntiles, F.G, (int)blockIdx.x, (const char*)(ws + WS_HT16), (size_t)DM * 2, (const char*)(ws + WS_W13T), (size_t)1024 * 1024 * 2, (size_t)256 * 1024 * 2, true};
        pg::EpiUp E{(half_t*)(ws + WS_H16), rb.rsrow};
        pg::gemm_phase<pg::EpiUp, pg::OrderMoe, true, true, true>(F.lds + RING_OFF, DM, DM, 16, S, E, ridxc);
        if (BOTH(10)) xcd_barrier(bar);
    }
    STAMP(11);
    if (IN(11)) {
        pg::OrderMoe S{(const LAS i32x4*)(F.lds + MOE_TILES_OFF), *(const LAS int*)(F.lds + MOE_NT_OFF), F.G, (int)blockIdx.x, (const char*)(ws + WS_H16), (size_t)DFF * 2, (const char*)(ws + WS_W2T), (size_t)1024 * 512 * 2, (size_t)256 * 512 * 2, false};
        pg::EpiDown E{(half_t*)(ws + WS_YS16)};
        pg::gemm_phase<pg::EpiDown, pg::OrderMoe, true, false, true>(F.lds + RING_OFF, DFF, DFF, 8, S, E);
        if (BOTH(11)) xcd_barrier(bar);
    }
    STAMP(12);
    if (IN(12)) {
        const RouteBufs rb = make_route(ws);
        for (int tok = gw; tok < T; tok += 4 * NGW) {
            if (tok + 3 * NGW < T) final_tokens<4>((const half_t*)(ws + WS_HT16), (const half_t*)(ws + WS_YS16), rb, args.in[31], args.out, tok, NGW, F.lane);
            else for (int t2 = tok; t2 < T; t2 += NGW) final_tokens<1>((const half_t*)(ws + WS_HT16), (const half_t*)(ws + WS_YS16), rb, args.in[31], args.out, t2, NGW, F.lane);
        }
    }
#ifdef PROBE_ENDBAR
    xcd_barrier(bar);
#endif
    STAMP(13);
#ifdef PROBE_PHASE
    if (blockIdx.x == 0 && F.tid == 0) { const unsigned long long d =
#ifdef PROBE_ENTRY
        10 * (tsl[0] - tsl[15]),
#elif defined(PROBE_GIDX)
        10 * (tsl[PROBE_GIDX + 1] - tsl[PROBE_GIDX]),
#else
        tsl[PROBE_PHASE + 1] - tsl[PROBE_PHASE],
#endif
 t0 = __builtin_amdgcn_s_memrealtime(); while (__builtin_amdgcn_s_memrealtime() - t0 < d) __builtin_amdgcn_s_sleep(8); }
#endif
#undef IN
#undef BOTH
}

extern "C" void kernel_launch(void* const* d_in, const int* in_sizes, int n_in, void* d_out, int out_size, void* d_ws, size_t ws_size, hipStream_t stream) {
    static int grid = 0;
    if (grid == 0) {
        if (n_in != 32 || ws_size < WS_END) { fprintf(stderr, "kernel_launch: unexpected inputs (n_in %d, ws %zu)\n", n_in, ws_size); grid = -1; return; }
        int dev = 0, cus = 0;
        if (hipGetDevice(&dev) != hipSuccess || hipDeviceGetAttribute(&cus, hipDeviceAttributeMultiprocessorCount, dev) != hipSuccess) { grid = -1; return; }
        if (hipFuncSetAttribute((const void*)mk_fwd, hipFuncAttributeMaxDynamicSharedMemorySize, LDS_BYTES) != hipSuccess) { grid = -1; return; }
        int per_cu = 0;
        (void)hipOccupancyMaxActiveBlocksPerMultiprocessor(&per_cu, (const void*)mk_fwd, NWAVES * 64, LDS_BYTES);
        (void)hipGetLastError();
        grid = cus;
    }
    if (grid < 0) return;
    (void)hipMemsetAsync((char*)d_ws + WS_CTL, 0, CTL_ZERO_BYTES, stream);
#ifdef PROBE_MEMSET2
    (void)hipMemsetAsync((char*)d_ws + WS_CTL + 512 * 1024, 0, CTL_ZERO_BYTES, stream);
#endif
    Args a{};
    for (int i = 0; i < 32; ++i) a.in[i] = (const float*)d_in[i];
    a.out = (float*)d_out; a.ws = (unsigned char*)d_ws; a.ph_lo = 0; a.ph_hi = 13; a.li = 0;
#ifdef SPLIT_A_HI
    a.ph_hi = SPLIT_A_HI;
    hipLaunchKernelGGL(mk_fwd, dim3(grid), dim3(NWAVES * 64), LDS_BYTES, stream, a);
    a.ph_lo = SPLIT_B_LO; a.ph_hi = 13; a.li = 1;
#endif
    hipLaunchKernelGGL(mk_fwd, dim3(grid), dim3(NWAVES * 64), LDS_BYTES, stream, a);
}
```

```cpp
#include <hip/hip_runtime.h>
#include <cstdio>
#include <cstdint>

constexpr int BATCH = 4, SEQ = 4096, DM = 1024, T = BATCH * SEQ;
constexpr int MEML = 256, MROWS = BATCH * MEML;
constexpr int SSMW = 512, SG = 16, NG = 32, NP = 64;
constexpr int SGUW = 512, SH = 4, SHD = 128, CHUNK = 128;
constexpr int XH = 4, XD = 128, XW = 512;
constexpr int INC = 2048;
constexpr int NGRP = 8, EPG = 8, NE = 64, DFF = 512;
constexpr float EPS = 1e-6f;
constexpr int SCH = 128;
constexpr int NSC = SEQ / SCH;

#define LAS __attribute__((address_space(3)))
#define GAS __attribute__((address_space(1)))
typedef _Float16 half_t;
typedef _Float16 f16x8 __attribute__((ext_vector_type(8)));
typedef _Float16 f16x4 __attribute__((ext_vector_type(4)));
typedef _Float16 f16x2 __attribute__((ext_vector_type(2)));
typedef float f32x4 __attribute__((ext_vector_type(4)));
typedef float f32x2 __attribute__((ext_vector_type(2)));
typedef unsigned u32x4 __attribute__((ext_vector_type(4)));
typedef unsigned u32x2 __attribute__((ext_vector_type(2)));

__device__ __forceinline__ unsigned pk_h2(float lo, float hi) { f16x2 v; v.x = (_Float16)lo; v.y = (_Float16)hi; return __builtin_bit_cast(unsigned, v); }
__device__ __forceinline__ float fast_sigmoid(float x) { return __builtin_amdgcn_rcpf(1.f + __builtin_amdgcn_exp2f(-1.4426950408889634f * x)); }
__device__ __forceinline__ float fast_gelu(float x) {
    const float u = 0.7978845608028654f * (x + 0.044715f * x * x * x);
    return x * __builtin_amdgcn_rcpf(1.f + __builtin_amdgcn_exp2f(-2.885390081777927f * u));
}

namespace pg {
constexpr int BM = 256, BK = 64, HALF = 128, HTB = HALF * BK * 2, STAGE_BYTES = 8 * HTB, NXCD = 8, WGM = 8;

__host__ __device__ __forceinline__ int lds_byte(int r, int c) { const int st = (r >> 4) * 2 + (c >> 5), rr = r & 15, cc = c & 31, ob = rr * 64 + cc * 2; return st * 1024 + (ob ^ (((ob >> 9) & 1) << 5)); }
__host__ __device__ __forceinline__ void stage_rc(int b, int& R, int& C) { const int st = b / 1024, sb = b % 1024, swz = sb ^ (((sb >> 9) & 1) << 5); R = (st >> 1) * 16 + swz / 64; C = (st & 1) * 32 + (swz % 64) / 2; }
__host__ __device__ __forceinline__ int perm32(int rho) { const int n = rho >> 4, i = rho & 15; return 8 * (i >> 2) + 4 * n + (i & 3); }

struct Unit { const char* A; const char* B; int pm, pn, aux, lda, ldb, nt, tile; };

struct OrderMN {
    int nM, nN, nwg, G, c; const char* A; const char* B; size_t tA, tB;
    __device__ void init(int M, int N, int G_, int c_, const void* A_, size_t lda, const void* B_, size_t ldb) { nM = M / BM; nN = N / BM; nwg = nM * nN; G = G_; c = c_; A = (const char*)A_; B = (const char*)B_; tA = (size_t)BM * lda * 2; tB = (size_t)BM * ldb * 2; }
    __device__ bool next(int i, Unit& u) const {
        const long L = (long)i * G + c; if (L >= nwg) return false;
        int wgid = (int)L; { const int q = nwg / NXCD, r = nwg % NXCD, xcd = wgid % NXCD, off = wgid / NXCD; wgid = (xcd < r ? xcd * (q + 1) : r * (q + 1) + (xcd - r) * q) + off; }
        const int nig = WGM * nN, gid = wgid / nig, fm = gid * WGM, gsz = (nM - fm) < WGM ? (nM - fm) : WGM;
        u.pm = fm + ((wgid % nig) % gsz); u.pn = (wgid % nig) / gsz; u.aux = 0;
        u.A = A + (size_t)u.pm * tA; u.B = B + (size_t)u.pn * tB; return true;
    }
};

template <class Epi, class Sched, bool ALIGN_EPI, bool GATHER = false, bool SKIP = false, bool VARSHAPE = false>
__device__ __forceinline__ void gemm_phase(LAS unsigned char* lds, const int lda0, const int ldb0, const int nt0, const Sched& S, const Epi& E, const LAS int* ridxc = nullptr) {
    const int tid = threadIdx.x, wid = __builtin_amdgcn_readfirstlane(tid >> 6), lane = tid & 63, wr = wid >> 2, wc = wid & 3, fr = lane & 15, fq = lane >> 4;
    const size_t kstep = (size_t)(BK * 2);
    unsigned voffA[2][2], nvA[2][2], voffB[2], nvB[2]; int RA[2], RB[2], CA2[2];
    size_t hsA, hsB, nhsA, nhsB;
#pragma unroll
    for (int i = 0; i < 2; ++i) { int R, C; stage_rc(tid * 16 + i * 8192, R, C); RA[i] = R; RB[i] = Epi::PERM ? ((R & ~31) + perm32(R & 31)) : R; CA2[i] = C * 2; }
#define PG_SETV(dA, dB, hA, hB, lda_, ldb_) do { _Pragma("unroll") for (int _i = 0; _i < 2; ++_i) { \
        dA[0][_i] = (unsigned)(RA[_i] * (lda_)) * 2u + (unsigned)CA2[_i]; dA[1][_i] = dA[0][_i]; dB[_i] = (unsigned)(RB[_i] * (ldb_)) * 2u + (unsigned)CA2[_i]; } \
        hA = (size_t)HALF * (lda_) * 2; hB = (size_t)HALF * (ldb_) * 2; } while (0)
#define PG_GVOFF(dst, slot, lda_) do { _Pragma("unroll") for (int _h = 0; _h < 2; ++_h) _Pragma("unroll") for (int _i = 0; _i < 2; ++_i) \
        dst[_h][_i] = (unsigned)ridxc[(slot) * 256 + _h * HALF + RA[_i]] * (unsigned)((lda_) * 2) + (unsigned)CA2[_i]; } while (0)
#define PG_COPYA(d, s) do { _Pragma("unroll") for (int _h = 0; _h < 2; ++_h) _Pragma("unroll") for (int _i = 0; _i < 2; ++_i) d[_h][_i] = s[_h][_i]; } while (0)
    const unsigned ldsw = (unsigned)wid * 1024u;
    const int aoff = lds_byte(wr * 64 + fr, fq * 8), boff = lds_byte(wc * 32 + fr, fq * 8);
#define PG_SA(b, h) (((b) * 2 + (h)) * HTB)
#define PG_SB(b, h) ((4 + (b) * 2 + (h)) * HTB)
#define PG_STAGE(bufoff, gbase, voff) do { _Pragma("unroll") for (int _i = 0; _i < 2; ++_i) \
        __builtin_amdgcn_global_load_lds((const unsigned*)((const char*)(gbase) + (voff)[_i]), (LAS unsigned*)(lds + (bufoff) + ldsw + _i * 8192), 16, 0, 0); } while (0)
#define PG_STAGE_A(bufoff, gbase, h) PG_STAGE(bufoff, (gbase) + (GATHER ? (size_t)0 : (size_t)(h) * hsA), voffA[GATHER ? (h) : 0])
#define PG_STAGE_B(bufoff, gbase, h) PG_STAGE(bufoff, (gbase) + (size_t)(h) * hsB, voffB)
#define PG_LDA(dst, b, h) do { _Pragma("unroll") for (int m = 0; m < 4; ++m) _Pragma("unroll") for (int k = 0; k < 2; ++k) dst[m][k] = *(const LAS f16x8*)(lds + PG_SA(b, h) + aoff + m * 2048 + k * 1024); } while (0)
#define PG_LDB(dst, b, h) do { _Pragma("unroll") for (int n = 0; n < 2; ++n) _Pragma("unroll") for (int k = 0; k < 2; ++k) dst[n][k] = *(const LAS f16x8*)(lds + PG_SB(b, h) + boff + n * 2048 + k * 1024); } while (0)
#define PG_MMA(ai, bj, At, Bt) do { __builtin_amdgcn_s_setprio(1); _Pragma("unroll") for (int m = 0; m < 4; ++m) _Pragma("unroll") for (int n = 0; n < 2; ++n) _Pragma("unroll") for (int k = 0; k < 2; ++k) \
        acc[ai][bj][m][n] = __builtin_amdgcn_mfma_f32_16x16x32_f16(Bt[n][k], At[m][k], acc[ai][bj][m][n], 0, 0, 0); __builtin_amdgcn_s_setprio(0); } while (0)
#define PG_WAIT_V(n) asm volatile("s_waitcnt vmcnt(" #n ")" ::: "memory")
#define PG_WAIT_L(n) asm volatile("s_waitcnt lgkmcnt(" #n ")" ::: "memory")
#define PG_BAR __builtin_amdgcn_s_barrier()
#define PG_SCHED __builtin_amdgcn_sched_barrier(0)
    Unit cur, nxt; int ui = 0;
    if (!S.next(0, cur)) return;
    int nt = VARSHAPE ? cur.nt : nt0;
    PG_SETV(voffA, voffB, hsA, hsB, (VARSHAPE ? cur.lda : lda0), (VARSHAPE ? cur.ldb : ldb0));
    if constexpr (GATHER) PG_GVOFF(voffA, 0, lda0);
    f32x4 acc[2][2][4][2];
#pragma unroll
    for (int a = 0; a < 2; ++a)
#pragma unroll
        for (int b = 0; b < 2; ++b)
#pragma unroll
            for (int m = 0; m < 4; ++m)
#pragma unroll
                for (int n = 0; n < 2; ++n) acc[a][b][m][n] = (f32x4){0.f, 0.f, 0.f, 0.f};
    f16x8 At[4][2], B0[2][2], B1[2][2];
    const char* cA = cur.A; const char* cB = cur.B;
    PG_STAGE_B(PG_SB(0, 0), cB, 0); PG_STAGE_B(PG_SB(0, 1), cB, 1); PG_STAGE_A(PG_SA(0, 0), cA, 0); PG_STAGE_A(PG_SA(0, 1), cA, 1);
    if (wr == 1) PG_BAR;
    PG_WAIT_V(2); PG_BAR;
    PG_STAGE_B(PG_SB(1, 0), cB + kstep, 0); PG_STAGE_A(PG_SA(1, 0), cA + kstep, 0); PG_STAGE_B(PG_SB(1, 1), cB + kstep, 1);
    PG_WAIT_V(6); PG_BAR;
#ifdef PROBE_GEMM
    volatile LAS unsigned long long* tsg = (volatile LAS unsigned long long*)(lds + 131072 + 512);
#define GSTAMP(k) do { if (VARSHAPE && blockIdx.x == 0 && tid == 0) tsg[k] = __builtin_amdgcn_s_memrealtime(); } while (0)
#else
#define GSTAMP(k) do { } while (0)
#endif
    for (;;) {
        const bool has_next = S.next(ui + 1, nxt);
        if (ui == 2) GSTAMP(20);
        if (ui == 3) GSTAMP(24);
        const bool half_only = SKIP && (__builtin_amdgcn_readfirstlane(cur.aux) <= HALF);
        const char* nA = has_next ? nxt.A : cA; const char* nB = has_next ? nxt.B : cB;
        if constexpr (GATHER) { if (has_next) PG_GVOFF(nvA, ui + 1, lda0); else PG_COPYA(nvA, voffA); }
        if constexpr (VARSHAPE) { if (has_next) PG_SETV(nvA, nvB, nhsA, nhsB, nxt.lda, nxt.ldb); else { PG_COPYA(nvA, voffA); nvB[0] = voffB[0]; nvB[1] = voffB[1]; nhsA = hsA; nhsB = hsB; } }
        for (int t = 0; t < nt; t += 2) {
            const bool last = (t == nt - 2);
            const char* a1 = cA + (size_t)(t + 1) * kstep;
            const char* a2 = last ? nA : cA + (size_t)(t + 2) * kstep; const char* b2 = last ? nB : cB + (size_t)(t + 2) * kstep;
            const char* a3 = a2 + kstep; const char* b3 = b2 + kstep;
            PG_LDB(B0, 0, 0); PG_LDB(B1, 0, 1); PG_SCHED; PG_LDA(At, 0, 0); PG_STAGE_A(PG_SA(1, 1), a1, 1);
            if constexpr (GATHER || VARSHAPE) { if (last) { PG_COPYA(voffA, nvA); if constexpr (VARSHAPE) { voffB[0] = nvB[0]; voffB[1] = nvB[1]; hsA = nhsA; hsB = nhsB; } } }
            PG_WAIT_V(8); PG_WAIT_L(0); PG_BAR; PG_MMA(0, 0, At, B0); PG_MMA(0, 1, At, B1); PG_BAR; PG_SCHED;
            PG_LDA(At, 0, 1); PG_STAGE_B(PG_SB(0, 0), b2, 0); PG_STAGE_B(PG_SB(0, 1), b2, 1); PG_STAGE_A(PG_SA(0, 0), a2, 0);
            PG_WAIT_V(8); PG_WAIT_L(0); PG_BAR; if (!SKIP || !half_only) { PG_MMA(1, 0, At, B0); PG_MMA(1, 1, At, B1); } PG_BAR; PG_SCHED;
            PG_LDB(B0, 1, 0); PG_LDB(B1, 1, 1); PG_SCHED; PG_LDA(At, 1, 0); PG_STAGE_A(PG_SA(0, 1), a2, 1);
            PG_WAIT_V(8); PG_WAIT_L(0); PG_BAR; PG_MMA(0, 0, At, B0); PG_MMA(0, 1, At, B1); PG_BAR; PG_SCHED;
            PG_LDA(At, 1, 1); PG_STAGE_B(PG_SB(1, 0), b3, 0); PG_STAGE_B(PG_SB(1, 1), b3, 1); PG_STAGE_A(PG_SA(1, 0), a3, 0);
            PG_WAIT_V(8); PG_WAIT_L(0); PG_BAR; if (!SKIP || !half_only) { PG_MMA(1, 0, At, B0); PG_MMA(1, 1, At, B1); } PG_BAR; PG_SCHED;
        }
        if constexpr (ALIGN_EPI) { if (wr == 0) PG_BAR; }
        if (ui == 2) GSTAMP(21);
        if (ui == 3) GSTAMP(25);
        E(acc, cur, wr, wc, fr, fq);
        if (ui == 2) GSTAMP(22);
        if (ui == 3) GSTAMP(26);
        if (!has_next) break;
#pragma unroll
        for (int a = 0; a < 2; ++a)
#pragma unroll
            for (int b = 0; b < 2; ++b)
#pragma unroll
                for (int m = 0; m < 4; ++m)
#pragma unroll
                    for (int n = 0; n < 2; ++n) acc[a][b][m][n] = (f32x4){0.f, 0.f, 0.f, 0.f};
        cur = nxt; cA = nA; cB = nB; ++ui;
        if constexpr (VARSHAPE) nt = cur.nt;
        if constexpr (ALIGN_EPI) { if (wr == 1) PG_BAR; }
    }
    PG_WAIT_V(0);
    if constexpr (!ALIGN_EPI) { if (wr == 0) PG_BAR; }
    PG_BAR;
#undef PG_SETV
#undef PG_GVOFF
#undef PG_COPYA
#undef PG_SA
#undef PG_SB
#undef PG_STAGE
#undef PG_STAGE_A
#undef PG_STAGE_B
#undef PG_LDA
#undef PG_LDB
#undef PG_MMA
#undef PG_WAIT_V
#undef PG_WAIT_L
#undef PG_BAR
#undef PG_SCHED
}

struct EpiProj {
    static constexpr bool PERM = true;
    half_t* O; int ldc; float* vsq;
    __device__ __forceinline__ void operator()(const f32x4 (&acc)[2][2][4][2], const Unit& u, int wr, int wc, int fr, int fq) const {
        const int row0 = u.pm * BM + wr * 64 + fr, col0 = u.pn * BM + wc * 32 + 8 * fq;
        const bool act = (u.pn >= 2 && u.pn < 6), isv = (u.pn >= 4 && u.pn < 6);
#pragma unroll
        for (int ai = 0; ai < 2; ++ai)
#pragma unroll
            for (int m = 0; m < 4; ++m) { half_t* rowp = O + (size_t)(row0 + ai * HALF + m * 16) * ldc + col0; float sq = 0.f;
#pragma unroll
                for (int bj = 0; bj < 2; ++bj) { f32x4 v0 = acc[ai][bj][m][0], v1 = acc[ai][bj][m][1];
                    if (act) {
#pragma unroll
                        for (int j = 0; j < 4; ++j) { v0[j] = fast_gelu(v0[j]); v1[j] = fast_gelu(v1[j]); sq += v0[j] * v0[j] + v1[j] * v1[j]; } }
                    u32x4 w; w.x = pk_h2(v0[0], v0[1]); w.y = pk_h2(v0[2], v0[3]); w.z = pk_h2(v1[0], v1[1]); w.w = pk_h2(v1[2], v1[3]);
                    *(u32x4*)(rowp + bj * HALF) = w; }
                if (isv) { sq += __shfl_xor(sq, 16); sq += __shfl_xor(sq, 32); if (fq == 0) vsq[(size_t)(row0 + ai * HALF + m * 16) * 8 + (u.pn - 4) * 4 + wc] = sq; } }
    }
};

struct EpiGlu {
    static constexpr bool PERM = true;
    half_t* O; int ldc; const float* bias;
    __device__ __forceinline__ void operator()(const f32x4 (&acc)[2][2][4][2], const Unit& u, int wr, int wc, int fr, int fq) const {
        const int row0 = u.pm * BM + wr * 64 + fr, col0 = u.pn * HALF + wc * 32 + 8 * fq;
        const f32x4 ba0 = *(const f32x4*)(bias + col0), ba1 = *(const f32x4*)(bias + col0 + 4), bb0 = *(const f32x4*)(bias + 512 + col0), bb1 = *(const f32x4*)(bias + 512 + col0 + 4);
#pragma unroll
        for (int ai = 0; ai < 2; ++ai)
#pragma unroll
            for (int m = 0; m < 4; ++m) {
                const f32x4 a0 = acc[ai][0][m][0] + ba0, a1 = acc[ai][0][m][1] + ba1, b0 = acc[ai][1][m][0] + bb0, b1 = acc[ai][1][m][1] + bb1;
                u32x4 w; w.x = pk_h2(a0[0] * fast_sigmoid(b0[0]), a0[1] * fast_sigmoid(b0[1])); w.y = pk_h2(a0[2] * fast_sigmoid(b0[2]), a0[3] * fast_sigmoid(b0[3]));
                w.z = pk_h2(a1[0] * fast_sigmoid(b1[0]), a1[1] * fast_sigmoid(b1[1])); w.w = pk_h2(a1[2] * fast_sigmoid(b1[2]), a1[3] * fast_sigmoid(b1[3]));
                *(u32x4*)(O + (size_t)(row0 + ai * HALF + m * 16) * ldc + col0) = w; }
    }
};
struct EpiGate {
    static constexpr bool PERM = true;
    half_t* O; int ldc; const float* bias;
    __device__ __forceinline__ void operator()(const f32x4 (&acc)[2][2][4][2], const Unit& u, int wr, int wc, int fr, int fq) const {
        const int row0 = u.pm * BM + wr * 64 + fr, col0 = u.pn * BM + wc * 32 + 8 * fq;
        f32x4 bv[2][2];
#pragma unroll
        for (int bj = 0; bj < 2; ++bj)
#pragma unroll
            for (int n = 0; n < 2; ++n) bv[bj][n] = *(const f32x4*)(bias + col0 + bj * HALF + 4 * n);
#pragma unroll
        for (int ai = 0; ai < 2; ++ai)
#pragma unroll
            for (int m = 0; m < 4; ++m) { half_t* rowp = O + (size_t)(row0 + ai * HALF + m * 16) * ldc + col0;
#pragma unroll
                for (int bj = 0; bj < 2; ++bj) { const f32x4 v0 = acc[ai][bj][m][0] + bv[bj][0], v1 = acc[ai][bj][m][1] + bv[bj][1];
                    u32x4 w; w.x = pk_h2(fast_sigmoid(v0[0]), fast_sigmoid(v0[1])); w.y = pk_h2(fast_sigmoid(v0[2]), fast_sigmoid(v0[3])); w.z = pk_h2(fast_sigmoid(v1[0]), fast_sigmoid(v1[1])); w.w = pk_h2(fast_sigmoid(v1[2]), fast_sigmoid(v1[3]));
                    *(u32x4*)(rowp + bj * HALF) = w; } }
    }
};
struct EpiBranch {
    static constexpr bool PERM = true;
    half_t* O; const half_t* G;
    __device__ __forceinline__ void operator()(const f32x4 (&acc)[2][2][4][2], const Unit& u, int wr, int wc, int fr, int fq) const {
        const int row0 = u.pm * BM + wr * 64 + fr, col0 = u.pn * BM + wc * 32 + 8 * fq; const int i = u.aux;
#pragma unroll
        for (int ai = 0; ai < 2; ++ai)
#pragma unroll
            for (int m = 0; m < 4; ++m) { const size_t r = (size_t)(row0 + ai * HALF + m * 16);
#pragma unroll
                for (int bj = 0; bj < 2; ++bj) {
                    const f16x8 gv = *(const f16x8*)(G + r * 3072 + i * 1024 + col0 + bj * HALF);
                    f16x8 pv = {0, 0, 0, 0, 0, 0, 0, 0};
                    if (i > 0) pv = *(const f16x8*)(O + r * 1024 + col0 + bj * HALF);
                    const f32x4 v0 = acc[ai][bj][m][0], v1 = acc[ai][bj][m][1];
                    u32x4 w; w.x = pk_h2((float)pv[0] + (float)gv[0] * v0[0], (float)pv[1] + (float)gv[1] * v0[1]); w.y = pk_h2((float)pv[2] + (float)gv[2] * v0[2], (float)pv[3] + (float)gv[3] * v0[3]);
                    w.z = pk_h2((float)pv[4] + (float)gv[4] * v1[0], (float)pv[5] + (float)gv[5] * v1[1]); w.w = pk_h2((float)pv[6] + (float)gv[6] * v1[2], (float)pv[7] + (float)gv[7] * v1[3]);
                    *(u32x4*)(O + r * 1024 + col0 + bj * HALF) = w; } }
    }
};
struct EpiOut {
    static constexpr bool PERM = true;
    half_t* O; const float* X; int ldc;
    __device__ __forceinline__ void operator()(const f32x4 (&acc)[2][2][4][2], const Unit& u, int wr, int wc, int fr, int fq) const {
        const int row0 = u.pm * BM + wr * 64 + fr, col0 = u.pn * BM + wc * 32 + 8 * fq;
#pragma unroll
        for (int ai = 0; ai < 2; ++ai) {
            f32x4 xv[4][2][2];
#pragma unroll
            for (int m = 0; m < 4; ++m)
#pragma unroll
                for (int bj = 0; bj < 2; ++bj) { const size_t off = (size_t)(row0 + ai * HALF + m * 16) * ldc + col0 + bj * HALF; xv[m][bj][0] = *(const f32x4*)(X + off); xv[m][bj][1] = *(const f32x4*)(X + off + 4); }
#pragma unroll
            for (int m = 0; m < 4; ++m)
#pragma unroll
                for (int bj = 0; bj < 2; ++bj) { const size_t off = (size_t)(row0 + ai * HALF + m * 16) * ldc + col0 + bj * HALF;
                    const f32x4 v0 = xv[m][bj][0] + acc[ai][bj][m][0], v1 = xv[m][bj][1] + acc[ai][bj][m][1];
                    u32x4 w; w.x = pk_h2(v0[0], v0[1]); w.y = pk_h2(v0[2], v0[3]); w.z = pk_h2(v1[0], v1[1]); w.w = pk_h2(v1[2], v1[3]);
                    *(u32x4*)(O + off) = w; }
        }
    }
};
struct OrderBr {
    OrderMN base; const char* A; const char* B;
    __device__ void init(int G_, int c_, const void* cat, const void* wbr) { base.init(T, 1024, G_, c_, nullptr, 0, nullptr, 0); A = (const char*)cat; B = (const char*)wbr; }
    __device__ bool next(int j, Unit& u) const {
        const int r = j / 3, i = j - 3 * r;
        if (!base.next(r, u)) return false;
        u.aux = i;
        u.A = A + (size_t)i * T * 512 * 2 + (size_t)u.pm * BM * 512 * 2;
        u.B = B + (size_t)i * 1024 * 512 * 2 + (size_t)u.pn * BM * 512 * 2;
        return true;
    }
};

struct EpiGateBranch {
    static constexpr bool PERM = true;
    half_t* O; half_t* GS; const float* bias;
    __device__ __forceinline__ void operator()(const f32x4 (&acc)[2][2][4][2], const Unit& u, int wr, int wc, int fr, int fq) const {
        const int i = u.aux >> 1, kind = u.aux & 1;
        const int rl0 = wr * 64 + fr, cl0 = wc * 32 + 8 * fq;
        half_t* gs = GS + (size_t)(u.pm * 4 + u.pn) * 65536;
        if (kind == 0) {
            f32x4 bv[2][2];
#pragma unroll
            for (int bj = 0; bj < 2; ++bj)
#pragma unroll
                for (int n = 0; n < 2; ++n) bv[bj][n] = *(const f32x4*)(bias + i * 1024 + u.pn * BM + cl0 + bj * HALF + 4 * n);
#pragma unroll
            for (int ai = 0; ai < 2; ++ai)
#pragma unroll
                for (int m = 0; m < 4; ++m)
#pragma unroll
                    for (int bj = 0; bj < 2; ++bj) { const f32x4 v0 = acc[ai][bj][m][0] + bv[bj][0], v1 = acc[ai][bj][m][1] + bv[bj][1];
                        u32x4 w; w.x = pk_h2(fast_sigmoid(v0[0]), fast_sigmoid(v0[1])); w.y = pk_h2(fast_sigmoid(v0[2]), fast_sigmoid(v0[3])); w.z = pk_h2(fast_sigmoid(v1[0]), fast_sigmoid(v1[1])); w.w = pk_h2(fast_sigmoid(v1[2]), fast_sigmoid(v1[3]));
                        *(u32x4*)(gs + (size_t)(rl0 + ai * HALF + m * 16) * 256 + cl0 + bj * HALF) = w; }
        } else {
            const int row0 = u.pm * BM + rl0, col0 = u.pn * BM + cl0;
#pragma unroll
            for (int ai = 0; ai < 2; ++ai) {
                f16x8 gv[4][2], pv[4][2];
#pragma unroll
                for (int m = 0; m < 4; ++m)
#pragma unroll
                    for (int bj = 0; bj < 2; ++bj) {
                        gv[m][bj] = *(const f16x8*)(gs + (size_t)(rl0 + ai * HALF + m * 16) * 256 + cl0 + bj * HALF);
                        if (i > 0) pv[m][bj] = *(const f16x8*)(O + (size_t)(row0 + ai * HALF + m * 16) * 1024 + col0 + bj * HALF);
                        else pv[m][bj] = (f16x8){0, 0, 0, 0, 0, 0, 0, 0}; }
#pragma unroll
                for (int m = 0; m < 4; ++m)
#pragma unroll
                    for (int bj = 0; bj < 2; ++bj) {
                        const f32x4 v0 = acc[ai][bj][m][0], v1 = acc[ai][bj][m][1]; const f16x8 g8 = gv[m][bj], p8 = pv[m][bj];
                        u32x4 w; w.x = pk_h2((float)p8[0] + (float)g8[0] * v0[0], (float)p8[1] + (float)g8[1] * v0[1]); w.y = pk_h2((float)p8[2] + (float)g8[2] * v0[2], (float)p8[3] + (float)g8[3] * v0[3]);
                        w.z = pk_h2((float)p8[4] + (float)g8[4] * v1[0], (float)p8[5] + (float)g8[5] * v1[1]); w.w = pk_h2((float)p8[6] + (float)g8[6] * v1[2], (float)p8[7] + (float)g8[7] * v1[3]);
                        *(u32x4*)(O + (size_t)(row0 + ai * HALF + m * 16) * 1024 + col0 + bj * HALF) = w; }
            }
        }
    }
};
struct OrderGB {
    OrderMN base; const char* N16; const char* WG; const char* CAT; const char* WBR;
    __device__ void init(int G_, int c_, const void* n16, const void* wgate, const void* cat, const void* wbr) { base.init(T, 1024, G_, c_, nullptr, 0, nullptr, 0); N16 = (const char*)n16; WG = (const char*)wgate; CAT = (const char*)cat; WBR = (const char*)wbr; }
    __device__ bool next(int j, Unit& u) const {
        const int r = j / 6, k = j - 6 * r, i = k >> 1, kind = k & 1;
        if (!base.next(r, u)) return false;
        u.aux = 2 * i + kind;
        if (kind == 0) { u.A = N16 + (size_t)u.pm * BM * 1024 * 2; u.B = WG + ((size_t)i * 1024 + (size_t)u.pn * BM) * 1024 * 2; u.lda = 1024; u.ldb = 1024; u.nt = 16; }
        else { u.A = CAT + (size_t)i * T * 512 * 2 + (size_t)u.pm * BM * 512 * 2; u.B = WBR + (size_t)i * 1024 * 512 * 2 + (size_t)u.pn * BM * 512 * 2; u.lda = 512; u.ldb = 512; u.nt = 8; }
        return true;
    }
};
struct GbUnit { const char* A; const char* B; int pm, pn, i, kind, lda, ldb, nt; };
struct OrderGB128 {
    OrderMN base; const char* N16; const char* WG; const char* CAT; const char* WBR;
    __device__ void init(int G_, int c_, const void* n16, const void* wgate, const void* cat, const void* wbr) { base.init(T, 2048, G_, c_, nullptr, 0, nullptr, 0); N16 = (const char*)n16; WG = (const char*)wgate; CAT = (const char*)cat; WBR = (const char*)wbr; }
    __device__ bool next(int j, GbUnit& u) const {
        const int r = j / 6, k = j - 6 * r; Unit t;
        if (!base.next(r, t)) return false;
        u.pm = t.pm; u.pn = t.pn; u.i = k >> 1; u.kind = k & 1;
        if (u.kind == 0) { u.A = N16 + (size_t)u.pm * BM * 1024 * 2; u.B = WG + ((size_t)u.i * 1024 + (size_t)u.pn * HALF) * 1024 * 2; u.lda = 1024; u.ldb = 1024; u.nt = 16; }
        else { u.A = CAT + (size_t)u.i * T * 512 * 2 + (size_t)u.pm * BM * 512 * 2; u.B = WBR + (size_t)u.i * 1024 * 512 * 2 + (size_t)u.pn * HALF * 512 * 2; u.lda = 512; u.ldb = 512; u.nt = 8; }
        return true;
    }
};
__device__ __forceinline__ void gemm_phase_gb128(LAS unsigned char* lds, const OrderGB128& S, const float* __restrict__ bias  , half_t* __restrict__ MERGED) {
    const int tid = threadIdx.x, wid = __builtin_amdgcn_readfirstlane(tid >> 6), lane = tid & 63, wr = wid >> 2, wc = wid & 3, fr = lane & 15, fq = lane >> 4;
    const size_t kstep = (size_t)(BK * 2);
    unsigned voffA[2], nvA[2], voffB[2], nvB[2]; int RA[2], RB[2], CA2[2]; size_t hsA, nhsA;
#pragma unroll
    for (int i = 0; i < 2; ++i) { int R, C; stage_rc(tid * 16 + i * 8192, R, C); RA[i] = R; RB[i] = (R & ~31) + perm32(R & 31); CA2[i] = C * 2; }
#define HN_SETV(dA, dB, hA, lda_, ldb_) do { _Pragma("unroll") for (int _i = 0; _i < 2; ++_i) { dA[_i] = (unsigned)(RA[_i] * (lda_)) * 2u + (unsigned)CA2[_i]; dB[_i] = (unsigned)(RB[_i] * (ldb_)) * 2u + (unsigned)CA2[_i]; } hA = (size_t)HALF * (lda_) * 2; } while (0)
    const unsigned ldsw = (unsigned)wid * 1024u;
    const int aoff = lds_byte(wr * 64 + fr, fq * 8), boff = lds_byte(wc * 32 + fr, fq * 8);
#define HN_SA(b, h) (((b) * 2 + (h)) * HTB)
#define HN_SB(b) ((4 + (b)) * HTB)
#define HN_STAGE(bufoff, gbase, voff) do { _Pragma("unroll") for (int _i = 0; _i < 2; ++_i) \
        __builtin_amdgcn_global_load_lds((const unsigned*)((const char*)(gbase) + (voff)[_i]), (LAS unsigned*)(lds + (bufoff) + ldsw + _i * 8192), 16, 0, 0); } while (0)
#define HN_LDA(dst, b, h) do { _Pragma("unroll") for (int m = 0; m < 4; ++m) _Pragma("unroll") for (int k = 0; k < 2; ++k) dst[m][k] = *(const LAS f16x8*)(lds + HN_SA(b, h) + aoff + m * 2048 + k * 1024); } while (0)
#define HN_LDB(dst, b) do { _Pragma("unroll") for (int n = 0; n < 2; ++n) _Pragma("unroll") for (int k = 0; k < 2; ++k) dst[n][k] = *(const LAS f16x8*)(lds + HN_SB(b) + boff + n * 2048 + k * 1024); } while (0)
#define HN_MMA(ai) do { __builtin_amdgcn_s_setprio(1); _Pragma("unroll") for (int m = 0; m < 4; ++m) _Pragma("unroll") for (int n = 0; n < 2; ++n) _Pragma("unroll") for (int k = 0; k < 2; ++k) \
        acc[ai][m][n] = __builtin_amdgcn_mfma_f32_16x16x32_f16(B0[n][k], At[m][k], acc[ai][m][n], 0, 0, 0); __builtin_amdgcn_s_setprio(0); } while (0)
#define HN_WAIT_V(n) asm volatile("s_waitcnt vmcnt(" #n ")" ::: "memory")
#define HN_WAIT_L0 asm volatile("s_waitcnt lgkmcnt(0)" ::: "memory")
#define HN_BAR __builtin_amdgcn_s_barrier()
#define HN_SCHED __builtin_amdgcn_sched_barrier(0)
    GbUnit cur, nxt; int ui = 0;
    if (!S.next(0, cur)) return;
    int nt = cur.nt;
    HN_SETV(voffA, voffB, hsA, cur.lda, cur.ldb);
    f32x4 acc[2][4][2], mg[2][4][2]; unsigned gp[2][4][4];
#pragma unroll
    for (int a = 0; a < 2; ++a)
#pragma unroll
        for (int m = 0; m < 4; ++m)
#pragma unroll
            for (int n = 0; n < 2; ++n) { acc[a][m][n] = (f32x4){0.f, 0.f, 0.f, 0.f}; mg[a][m][n] = (f32x4){0.f, 0.f, 0.f, 0.f}; }
#pragma unroll
    for (int a = 0; a < 2; ++a)
#pragma unroll
        for (int m = 0; m < 4; ++m)
#pragma unroll
            for (int q = 0; q < 4; ++q) gp[a][m][q] = 0u;
    f16x8 At[4][2], B0[2][2];
    const char* cA = cur.A; const char* cB = cur.B;
    HN_STAGE(HN_SB(0), cB, voffB); HN_STAGE(HN_SA(0, 0), cA, voffA); HN_STAGE(HN_SA(0, 1), cA + hsA, voffA);
    if (wr == 1) HN_BAR;
    HN_WAIT_V(2); HN_BAR;
    HN_STAGE(HN_SB(1), cB + kstep, voffB); HN_STAGE(HN_SA(1, 0), cA + kstep, voffA);
    HN_WAIT_V(4); HN_BAR;
    for (;;) {
        const bool has_next = S.next(ui + 1, nxt);
        const char* nA = has_next ? nxt.A : cA; const char* nB = has_next ? nxt.B : cB;
        if (has_next) HN_SETV(nvA, nvB, nhsA, nxt.lda, nxt.ldb); else { nvA[0] = voffA[0]; nvA[1] = voffA[1]; nvB[0] = voffB[0]; nvB[1] = voffB[1]; nhsA = hsA; }
        for (int t = 0; t < nt; t += 2) {
            const bool last = (t == nt - 2);
            const char* a1 = cA + (size_t)(t + 1) * kstep;
            const char* a2 = last ? nA : cA + (size_t)(t + 2) * kstep; const char* b2 = last ? nB : cB + (size_t)(t + 2) * kstep;
            const char* a3 = a2 + kstep; const char* b3 = b2 + kstep;
            HN_LDB(B0, 0); HN_SCHED; HN_LDA(At, 0, 0); HN_STAGE(HN_SA(1, 1), a1 + hsA, voffA);
            if (last) { voffA[0] = nvA[0]; voffA[1] = nvA[1]; voffB[0] = nvB[0]; voffB[1] = nvB[1]; hsA = nhsA; }
            HN_WAIT_V(6); HN_WAIT_L0; HN_BAR; HN_MMA(0); HN_BAR; HN_SCHED;
            HN_LDA(At, 0, 1); HN_STAGE(HN_SB(0), b2, voffB); HN_STAGE(HN_SA(0, 0), a2, voffA);
            HN_WAIT_V(6); HN_WAIT_L0; HN_BAR; HN_MMA(1); HN_BAR; HN_SCHED;
            HN_LDB(B0, 1); HN_SCHED; HN_LDA(At, 1, 0); HN_STAGE(HN_SA(0, 1), a2 + hsA, voffA);
            HN_WAIT_V(6); HN_WAIT_L0; HN_BAR; HN_MMA(0); HN_BAR; HN_SCHED;
            HN_LDA(At, 1, 1); HN_STAGE(HN_SB(1), b3, voffB); HN_STAGE(HN_SA(1, 0), a3, voffA);
            HN_WAIT_V(6); HN_WAIT_L0; HN_BAR; HN_MMA(1); HN_BAR; HN_SCHED;
        }
        if (wr == 0) HN_BAR;
        if (cur.kind == 0) {
            const float* bp = bias + cur.i * 1024 + cur.pn * HALF + wc * 32 + 8 * fq;
            const f32x4 b0 = *(const f32x4*)bp, b1 = *(const f32x4*)(bp + 4);
#pragma unroll
            for (int ai = 0; ai < 2; ++ai)
#pragma unroll
                for (int m = 0; m < 4; ++m) { const f32x4 v0 = acc[ai][m][0] + b0, v1 = acc[ai][m][1] + b1;
                    gp[ai][m][0] = pk_h2(fast_sigmoid(v0[0]), fast_sigmoid(v0[1])); gp[ai][m][1] = pk_h2(fast_sigmoid(v0[2]), fast_sigmoid(v0[3]));
                    gp[ai][m][2] = pk_h2(fast_sigmoid(v1[0]), fast_sigmoid(v1[1])); gp[ai][m][3] = pk_h2(fast_sigmoid(v1[2]), fast_sigmoid(v1[3])); }
        } else {
#pragma unroll
            for (int ai = 0; ai < 2; ++ai)
#pragma unroll
                for (int m = 0; m < 4; ++m)
#pragma unroll
                    for (int q = 0; q < 4; ++q) { const f16x2 g2 = __builtin_bit_cast(f16x2, gp[ai][m][q]);
                        mg[ai][m][q >> 1][(q & 1) * 2] += (float)g2.x * acc[ai][m][q >> 1][(q & 1) * 2]; mg[ai][m][q >> 1][(q & 1) * 2 + 1] += (float)g2.y * acc[ai][m][q >> 1][(q & 1) * 2 + 1]; }
            if (cur.i == 2) {
                half_t* op = MERGED + (size_t)(cur.pm * BM + wr * 64 + fr) * 1024 + cur.pn * HALF + wc * 32 + 8 * fq;
#pragma unroll
                for (int ai = 0; ai < 2; ++ai)
#pragma unroll
                    for (int m = 0; m < 4; ++m) { const f32x4 v0 = mg[ai][m][0], v1 = mg[ai][m][1];
                        u32x4 w; w.x = pk_h2(v0[0], v0[1]); w.y = pk_h2(v0[2], v0[3]); w.z = pk_h2(v1[0], v1[1]); w.w = pk_h2(v1[2], v1[3]);
                        *(u32x4*)(op + (size_t)(ai * HALF + m * 16) * 1024) = w;
                        mg[ai][m][0] = (f32x4){0.f, 0.f, 0.f, 0.f}; mg[ai][m][1] = (f32x4){0.f, 0.f, 0.f, 0.f}; }
            }
        }
        if (!has_next) break;
#pragma unroll
        for (int a = 0; a < 2; ++a)
#pragma unroll
            for (int m = 0; m < 4; ++m)
#pragma unroll
                for (int n = 0; n < 2; ++n) acc[a][m][n] = (f32x4){0.f, 0.f, 0.f, 0.f};
        cur = nxt; cA = nA; cB = nB; ++ui; nt = cur.nt;
        if (wr == 1) HN_BAR;
    }
    HN_WAIT_V(0);
    HN_BAR;
#undef HN_SETV
#undef HN_SA
#undef HN_SB
#undef HN_STAGE
#undef HN_LDA
#undef HN_LDB
#undef HN_MMA
#undef HN_WAIT_V
#undef HN_WAIT_L0
#undef HN_BAR
#undef HN_SCHED
}
}

constexpr int NWAVES = 8;
constexpr int RING_OFF = 0, RING_BYTES = 131072;
constexpr int LDSCTL_OFF = RING_BYTES, MISC_OFF = LDSCTL_OFF + 320;
constexpr int LDS_BYTES = 147456;
typedef GAS unsigned gu32;
#define RLX_AGENT __ATOMIC_RELAXED, __HIP_MEMORY_SCOPE_AGENT
#define LDS_WAIT() asm volatile("s_waitcnt lgkmcnt(0)" ::: "memory")
#define VM_WAIT() asm volatile("s_waitcnt vmcnt(0)" ::: "memory")

#define XB_TMO      128
#define XB_XCNT(j)  (256  + 64 * (j))
#define XB_XSUB(j)  (1280 + 64 * (j))
#define XB_XGEN(j)  (2304 + 64 * (j))
#define XB_TOP      3328
#define XB_TOPGEN   3392
#define XCD_BAR_WORDS 3456
#define XB_SPIN_CAP (1u << 18)
__device__ __forceinline__ unsigned xb_ld(unsigned* p)              { return __hip_atomic_load(p, __ATOMIC_RELAXED, __HIP_MEMORY_SCOPE_AGENT); }
__device__ __forceinline__ unsigned xb_add(unsigned* p, unsigned v) { return __hip_atomic_fetch_add(p, v, __ATOMIC_RELAXED, __HIP_MEMORY_SCOPE_AGENT); }
__device__ __forceinline__ unsigned xb_xcc_id() { return (unsigned)__builtin_amdgcn_s_getreg((3 << 11) | 20) & 0xFu; }
#define XB_SPIN(cond, bar) do { unsigned _sp = 0; while (cond) { __builtin_amdgcn_s_sleep(1); \
    if ((++_sp & 255u) == 0u) { if (xb_ld(&(bar)[XB_TMO])) break; if (_sp > XB_SPIN_CAP) { atomicAdd(&(bar)[XB_TMO], 1u); break; } } } } while (0)
struct XcdBarrier { unsigned* bar; unsigned x; volatile LAS unsigned* st; };
__device__ __forceinline__ XcdBarrier xcd_barrier_post(unsigned* bar, volatile LAS unsigned* st) {
    XcdBarrier b; b.bar = bar; b.x = xb_xcc_id(); b.st = st;
    if (threadIdx.x == 0) (void)xb_add(&bar[XB_XCNT(b.x)], 1u);
    return b;
}
__device__ __forceinline__ void xcd_barrier_complete(unsigned* bar, unsigned x, unsigned& nloc, unsigned& nx) {
    const unsigned G = gridDim.x * gridDim.y * gridDim.z;
    unsigned sum, cnt, mine, sp = 0u;
    for (;;) {
        sum = 0u; cnt = 0u; mine = 0u;
#pragma unroll
        for (unsigned j = 0; j < 16; ++j) { const unsigned c = xb_ld(&bar[XB_XCNT(j)]); sum += c; cnt += (c > 0u) ? 1u : 0u; mine = (j == x) ? c : mine; }
        if (sum == G) break;
        __builtin_amdgcn_s_sleep(1);
        if ((++sp & 255u) == 0u) { if (xb_ld(&bar[XB_TMO])) break; if (sp > XB_SPIN_CAP) { atomicAdd(&bar[XB_TMO], 1u); break; } }
    }
    nloc = mine > 0u ? mine : 1u; nx = cnt > 0u ? cnt : 1u;
}
__device__ __forceinline__ void xcd_barrier1(const XcdBarrier& b) {
    asm volatile("s_waitcnt vmcnt(0)" ::: "memory");
    __syncthreads();
    if (threadIdx.x == 0) {
        unsigned* bar = b.bar;
        __builtin_amdgcn_s_waitcnt(0);
        unsigned nloc = b.st[0], nx = b.st[1];
        if (nloc == 0u) { xcd_barrier_complete(bar, b.x, nloc, nx); b.st[0] = nloc; b.st[1] = nx; }
        const unsigned old = xb_add(&bar[XB_XSUB(b.x)], 1u);
        const unsigned gen = old / nloc;
        if (old + 1u == (gen + 1u) * nloc) {
            __builtin_amdgcn_fence(__ATOMIC_RELEASE, "agent");
            asm volatile("s_waitcnt vmcnt(0)" ::: "memory");
            const unsigned og = xb_add(&bar[XB_TOP], 1u);
            const unsigned tg = og / nx;
            if (og + 1u == (tg + 1u) * nx) xb_add(&bar[XB_TOPGEN], 1u);
            else XB_SPIN(xb_ld(&bar[XB_TOPGEN]) == tg, bar);
            __builtin_amdgcn_fence(__ATOMIC_ACQUIRE, "agent");
            xb_add(&bar[XB_XGEN(b.x)], 1u);
            asm volatile("s_waitcnt vmcnt(0)" ::: "memory");
        } else {
            XB_SPIN(xb_ld(&bar[XB_XGEN(b.x)]) == gen, bar);
            __builtin_amdgcn_fence(__ATOMIC_ACQUIRE, "agent");
            asm volatile("s_waitcnt vmcnt(0)" ::: "memory");
        }
    }
    __syncthreads();
}

#ifndef XB_EXTRA
#define XB_EXTRA 0
#endif
__device__ __forceinline__ void xcd_barrier(const XcdBarrier& b) { xcd_barrier1(b); for (int i = 0; i < XB_EXTRA; ++i) xcd_barrier1(b); }

__device__ __forceinline__ float wave_sum(float v) {
#pragma unroll
    for (int o = 1; o < 64; o <<= 1) v += __shfl_xor(v, o);
    return v;
}

__device__ __forceinline__ void transpose_item(const float* W, int ldw, int k0, int n0, half_t* WT, int ldt, int drow0, LAS float* scr, int lane, const float* kscale = nullptr) {
    const int lk = lane >> 3, lc = (lane & 7) * 4;
    f32x4 v[8];
#pragma unroll
    for (int i = 0; i < 8; ++i) v[i] = *(const GAS f32x4*)(W + (size_t)(k0 + i * 8 + lk) * ldw + n0 + lc);
#pragma unroll
    for (int i = 0; i < 8; ++i) { LAS float* s = scr + (i * 8 + lk) * 33 + lc; s[0] = v[i].x; s[1] = v[i].y; s[2] = v[i].z; s[3] = v[i].w; }
    LDS_WAIT(); asm volatile("" ::: "memory");
    const int c = lane & 7;
    f32x4 g0 = {1.f, 1.f, 1.f, 1.f}, g1 = g0;
    if (kscale) { g0 = *(const GAS f32x4*)(kscale + k0 + 8 * c); g1 = *(const GAS f32x4*)(kscale + k0 + 8 * c + 4); }
#pragma unroll
    for (int j = 0; j < 4; ++j) { const int n = (lane >> 3) + 8 * j; const LAS float* s = scr + (8 * c) * 33 + n;
        u32x4 o; o.x = pk_h2(s[0 * 33] * g0[0], s[1 * 33] * g0[1]); o.y = pk_h2(s[2 * 33] * g0[2], s[3 * 33] * g0[3]); o.z = pk_h2(s[4 * 33] * g1[0], s[5 * 33] * g1[1]); o.w = pk_h2(s[6 * 33] * g1[2], s[7 * 33] * g1[3]);
        *(GAS u32x4*)(WT + (size_t)(drow0 + n) * ldt + k0 + 8 * c) = o; }
    LDS_WAIT(); asm volatile("" ::: "memory");
}
__device__ __forceinline__ void rms_row_to_f16(const float* xrow, const float* g, half_t* orow, int lane) {
    const GAS f32x4* xr = (const GAS f32x4*)xrow + lane;
    const GAS f32x4* gr = (const GAS f32x4*)g + lane;
    f32x4 v[4]; float s = 0.f;
#pragma unroll
    for (int j = 0; j < 4; ++j) { v[j] = xr[64 * j]; s += (v[j].x * v[j].x + v[j].y * v[j].y) + (v[j].z * v[j].z + v[j].w * v[j].w); }
    const float rs = 1.0f / sqrtf(wave_sum(s) * (1.f / 1024.f) + EPS);
    GAS u32x2* o8 = (GAS u32x2*)orow + lane;
#pragma unroll
    for (int j = 0; j < 4; ++j) { const f32x4 gg = gr[64 * j]; u32x2 w; w.x = pk_h2(v[j].x * rs * gg.x, v[j].y * rs * gg.y); w.y = pk_h2(v[j].z * rs * gg.z, v[j].w * rs * gg.w); o8[64 * j] = w; }
}

template <int NR>
__device__ __forceinline__ void rms_rows_to_f16(const float* x, const float* g, half_t* o, int r0, int rstride, int lane) {
    f32x4 v[NR][4]; float s[NR];
#pragma unroll
    for (int i = 0; i < NR; ++i) { const GAS f32x4* xr = (const GAS f32x4*)(x + (size_t)(r0 + i * rstride) * 1024) + lane;
#pragma unroll
        for (int j = 0; j < 4; ++j) v[i][j] = xr[64 * j]; }
    const GAS f32x4* gr = (const GAS f32x4*)g + lane;
    f32x4 gg[4];
#pragma unroll
    for (int j = 0; j < 4; ++j) gg[j] = gr[64 * j];
#pragma unroll
    for (int i = 0; i < NR; ++i) { float q = 0.f;
#pragma unroll
        for (int j = 0; j < 4; ++j) q += (v[i][j].x * v[i][j].x + v[i][j].y * v[i][j].y) + (v[i][j].z * v[i][j].z + v[i][j].w * v[i][j].w);
        s[i] = q; }
#pragma unroll
    for (int i = 0; i < NR; ++i) { const float rs = 1.0f / sqrtf(wave_sum(s[i]) * (1.f / 1024.f) + EPS);
        GAS u32x2* o8 = (GAS u32x2*)(o + (size_t)(r0 + i * rstride) * 1024) + lane;
#pragma unroll
        for (int j = 0; j < 4; ++j) { u32x2 w; w.x = pk_h2(v[i][j].x * rs * gg[j].x, v[i][j].y * rs * gg[j].y); w.y = pk_h2(v[i][j].z * rs * gg[j].z, v[i][j].w * rs * gg[j].w); o8[64 * j] = w; } }
}

typedef float f32x16 __attribute__((ext_vector_type(16)));
__device__ __forceinline__ int crow(int r, int hi) { return (r & 3) + 8 * (r >> 2) + 4 * hi; }

__device__ __forceinline__ void kv_tile(LAS unsigned char* lds, const half_t* __restrict__ A  , const half_t* __restrict__ Bt  , half_t* K16, half_t* VT16, int tile, int tid, int wave, int lane) {
    asm volatile("" : "+v"(tid), "+v"(lane));
    const int m0 = (tile >> 4) * 64, n0 = (tile & 15) * 64;
    const int rb = wave >> 1, cb = (wave & 1) * 32;
    const int fr = lane & 15, fq = lane >> 4;
    f32x4 acc0 = {0.f, 0.f, 0.f, 0.f}, acc1 = {0.f, 0.f, 0.f, 0.f};
    const bool vpart = n0 >= 512;
    u32x4 va[8], vb[8];
#define KV_LOAD(kh) do { _Pragma("unroll") for (int i = 0; i < 8; ++i) { const int idx = i * 512 + tid, r = idx >> 6, c = idx & 63; \
        va[i] = *(const u32x4*)(A + (size_t)(m0 + r) * DM + (kh) * 512 + c * 8); vb[i] = *(const u32x4*)(Bt + (size_t)(n0 + r) * DM + (kh) * 512 + c * 8); } } while (0)
#define KV_STORE() do { _Pragma("unroll") for (int i = 0; i < 8; ++i) { const int idx = i * 512 + tid, r = idx >> 6, c = idx & 63; \
        *(LAS u32x4*)(lds + r * 1024 + ((c ^ (r & 15)) << 4)) = va[i]; *(LAS u32x4*)(lds + 65536 + r * 1024 + ((c ^ (r & 15)) << 4)) = vb[i]; } } while (0)
#define KV_MMA() do { const int ra = 16 * rb + fr, rb0 = cb + fr, rb1 = cb + 16 + fr; _Pragma("unroll 4") for (int ks = 0; ks < 16; ++ks) { const int ch = ks * 4 + fq; \
        const f16x8 a = *(const LAS f16x8*)(lds + ra * 1024 + ((ch ^ (ra & 15)) << 4)); \
        const f16x8 b0 = *(const LAS f16x8*)(lds + 65536 + rb0 * 1024 + ((ch ^ (rb0 & 15)) << 4)), b1 = *(const LAS f16x8*)(lds + 65536 + rb1 * 1024 + ((ch ^ (rb1 & 15)) << 4)); \
        if (vpart) { acc0 = __builtin_amdgcn_mfma_f32_16x16x32_f16(a, b0, acc0, 0, 0, 0); acc1 = __builtin_amdgcn_mfma_f32_16x16x32_f16(a, b1, acc1, 0, 0, 0); } \
        else       { acc0 = __builtin_amdgcn_mfma_f32_16x16x32_f16(b0, a, acc0, 0, 0, 0); acc1 = __builtin_amdgcn_mfma_f32_16x16x32_f16(b1, a, acc1, 0, 0, 0); } } } while (0)
    KV_LOAD(0);
    __syncthreads();
    KV_STORE();
    __syncthreads();
    KV_LOAD(1);
    KV_MMA();
    __syncthreads();
    KV_STORE();
    __syncthreads();
    KV_MMA();
#undef KV_LOAD
#undef KV_STORE
#undef KV_MMA
    if (!vpart) {
        const int m = m0 + 16 * rb + fr;
        u32x2 w0, w1; w0.x = pk_h2(acc0[0], acc0[1]); w0.y = pk_h2(acc0[2], acc0[3]); w1.x = pk_h2(acc1[0], acc1[1]); w1.y = pk_h2(acc1[2], acc1[3]);
        *(u32x2*)(K16 + (size_t)m * 512 + n0 + cb + 4 * fq) = w0;
        *(u32x2*)(K16 + (size_t)m * 512 + n0 + cb + 16 + 4 * fq) = w1;
    } else {
        const int mb = m0 + 16 * rb + 4 * fq, b = mb >> 8, key = mb & 255;
        const int n = n0 - 512 + cb + fr;
        u32x2 w0, w1; w0.x = pk_h2(acc0[0], acc0[1]); w0.y = pk_h2(acc0[2], acc0[3]); w1.x = pk_h2(acc1[0], acc1[1]); w1.y = pk_h2(acc1[2], acc1[3]);
        *(u32x2*)(VT16 + ((size_t)b * 512 + n) * 256 + key) = w0;
        *(u32x2*)(VT16 + ((size_t)b * 512 + n + 16) * 256 + key) = w1;
    }
    __syncthreads();
}

constexpr int ATT_K_OFF = 0, ATT_V_OFF = 65536, ATT_WS_OFF = RING_BYTES + 1024;
__device__ __forceinline__ void attn_unit(LAS unsigned char* lds, const half_t* __restrict__ PROJ16, const half_t* __restrict__ K16, const half_t* __restrict__ VT16, half_t* CAT16,
                                          int b, int h, int qb, int tid, int wave, int lane) {
    asm volatile("" : "+v"(tid), "+v"(lane));
    {
        const half_t* kg = K16 + (size_t)(b * 256) * 512 + h * 128;
        const half_t* vg = VT16 + ((size_t)b * 512 + h * 128) * 256;
        u32x4 kv[8], vv[8];
#pragma unroll
        for (int it = 0; it < 8; ++it) { const int idx = it * 512 + tid, key = idx >> 4, ch = idx & 15; kv[it] = *(const u32x4*)(kg + (size_t)key * 512 + ch * 8); }
#pragma unroll
        for (int it = 0; it < 8; ++it) { const int idx = it * 512 + tid, d = idx >> 5, ch = idx & 31; vv[it] = *(const u32x4*)(vg + (size_t)d * 256 + ch * 8); }
#pragma unroll
        for (int it = 0; it < 8; ++it) { const int idx = it * 512 + tid, key = idx >> 4, ch = idx & 15; *(LAS u32x4*)(lds + ATT_K_OFF + key * 256 + ((ch ^ (key & 15)) << 4)) = kv[it]; }
#pragma unroll
        for (int it = 0; it < 8; ++it) { const int idx = it * 512 + tid, d = idx >> 5, ch = idx & 31; const int m = (d & 31) << 3;
            u32x2 lo, hi2; lo.x = vv[it].x; lo.y = vv[it].y; hi2.x = vv[it].z; hi2.y = vv[it].w;
            *(LAS u32x2*)(lds + ATT_V_OFF + d * 512 + ((ch * 16) ^ m)) = lo;
            *(LAS u32x2*)(lds + ATT_V_OFF + d * 512 + ((ch * 16 + 8) ^ m)) = hi2; }
    }
    __syncthreads();
    const int c31 = lane & 31, hi = lane >> 5;
    const int tok0 = b * SEQ + qb * 256 + wave * 32;
    f16x8 qf[8];
    {
        const half_t* qp = PROJ16 + (size_t)(tok0 + c31) * INC + 1536 + h * 128 + 8 * hi;
#pragma unroll
        for (int s = 0; s < 8; ++s) qf[s] = *(const f16x8*)(qp + 16 * s);
    }
    __builtin_amdgcn_sched_barrier(0);
    f32x16 sb[8];
#pragma unroll
    for (int kb = 0; kb < 8; ++kb) {
        f32x16 a = {0.f, 0.f, 0.f, 0.f, 0.f, 0.f, 0.f, 0.f, 0.f, 0.f, 0.f, 0.f, 0.f, 0.f, 0.f, 0.f};
        const int key = kb * 32 + c31;
#pragma unroll
        for (int s = 0; s < 8; ++s) {
            const f16x8 kf = *(const LAS f16x8*)(lds + ATT_K_OFF + key * 256 + (((2 * s + hi) ^ (key & 15)) << 4));
            a = __builtin_amdgcn_mfma_f32_32x32x16_f16(kf, qf[s], a, 0, 0, 0);
        }
        sb[kb] = a;
    }
    __builtin_amdgcn_sched_barrier(0);
    float mx = -3.0e38f;
#pragma unroll
    for (int kb = 0; kb < 8; ++kb)
#pragma unroll
        for (int r = 0; r < 16; ++r) mx = fmaxf(mx, sb[kb][r]);
    mx = fmaxf(mx, __shfl_xor(mx, 32));
    const float c2 = 0.08838834764831845f * 1.4426950408889634f;
    const float mc = mx * c2;
    float l = 0.f;
    f16x8 pa[16];
#pragma unroll
    for (int kb = 0; kb < 8; ++kb)
#pragma unroll
        for (int s = 0; s < 2; ++s) {
#pragma unroll
            for (int j = 0; j < 8; ++j) { const float p = __builtin_amdgcn_exp2f(sb[kb][8 * s + j] * c2 - mc); l += p; pa[kb * 2 + s][j] = (_Float16)p; }
        }
    l += __shfl_xor(l, 32);
    LAS float* wsf = (LAS float*)(lds + ATT_WS_OFF) + wave * 32;
    if (hi == 0) wsf[c31] = l;
    __builtin_amdgcn_sched_barrier(0);
    f32x16 o[4];
#pragma unroll
    for (int db = 0; db < 4; ++db) o[db] = (f32x16){0.f, 0.f, 0.f, 0.f, 0.f, 0.f, 0.f, 0.f, 0.f, 0.f, 0.f, 0.f, 0.f, 0.f, 0.f, 0.f};
    const unsigned vbase = ATT_V_OFF + c31 * 512; const int m = c31 << 3;
#pragma unroll
    for (int ks = 0; ks < 16; ++ks) {
        const int kbyte = 32 * ks + 8 * hi;
#pragma unroll
        for (int db = 0; db < 4; ++db) {
            const f16x4 v0 = *(const LAS f16x4*)(lds + vbase + db * 16384 + (kbyte ^ m));
            const f16x4 v1 = *(const LAS f16x4*)(lds + vbase + db * 16384 + ((kbyte + 16) ^ m));
            const f16x8 vf = {v0[0], v0[1], v0[2], v0[3], v1[0], v1[1], v1[2], v1[3]};
            o[db] = __builtin_amdgcn_mfma_f32_32x32x16_f16(pa[ks], vf, o[db], 0, 0, 0);
        }
    }
    __builtin_amdgcn_sched_barrier(0);
    LDS_WAIT();
    half_t* op = CAT16 + (size_t)2 * T * 512 + (size_t)tok0 * 512 + h * 128 + c31;
#pragma unroll
    for (int r = 0; r < 16; ++r) {
        const int q = crow(r, hi);
        const float rl = __builtin_amdgcn_rcpf(wsf[q]);
#pragma unroll
        for (int db = 0; db < 4; ++db) op[(size_t)q * 512 + db * 32] = (_Float16)(o[db][r] * rl);
    }
    __syncthreads();
}

constexpr int SP_VT_OFF = 0, SP_W_OFF = 32768, SP_RS_OFF = 65536;
__device__ __forceinline__ void spatial_unit(LAS unsigned char* lds, const half_t* __restrict__ PROJ16, const float* __restrict__ VSQ, const half_t* __restrict__ WSP16, const float* __restrict__ b_sp, const float* __restrict__ g_sgu,
                                             half_t* CAT16, int bc, int h, int tid, int wave, int lane) {
    asm volatile("" : "+v"(tid), "+v"(lane));
    const int tok0 = bc * CHUNK;
    LAS float* rs = (LAS float*)(lds + SP_RS_OFF);
    if (tid < CHUNK) { const f32x4 a = *(const f32x4*)(VSQ + (size_t)(tok0 + tid) * 8), b = *(const f32x4*)(VSQ + (size_t)(tok0 + tid) * 8 + 4);
        const float q = ((a[0] + a[1]) + (a[2] + a[3])) + ((b[0] + b[1]) + (b[2] + b[3])); rs[tid] = 1.0f / sqrtf(q * (1.f / 512.f) + EPS); }
#pragma unroll
    for (int it = 0; it < 4; ++it) { const int idx = it * 512 + tid, t = idx >> 4, ch = idx & 15;
        *(LAS u32x4*)(lds + SP_W_OFF + t * 256 + ((ch ^ (t & 15)) << 4)) = *(const u32x4*)(WSP16 + ((size_t)h * CHUNK + t) * CHUNK + ch * 8); }
    __syncthreads();
#pragma unroll
    for (int it = 0; it < 4; ++it) {
        const int idx = it * 512 + tid, s = idx >> 4, ch = idx & 15;
        const f16x8 v = *(const f16x8*)(PROJ16 + (size_t)(tok0 + s) * INC + 1024 + h * SHD + ch * 8);
        const float r = rs[s];
#pragma unroll
        for (int j = 0; j < 8; ++j) { const int d = ch * 8 + j;
            *(LAS half_t*)(lds + SP_VT_OFF + d * 256 + ((((s >> 3) ^ (d & 15)) << 4) | ((s & 7) << 1))) = (_Float16)((float)v[j] * r); }
    }
    __syncthreads();
    const int c31 = lane & 31, hi = lane >> 5, tb = wave >> 1, dh = wave & 1;
    f32x16 acc[2];
    acc[0] = (f32x16){0.f, 0.f, 0.f, 0.f, 0.f, 0.f, 0.f, 0.f, 0.f, 0.f, 0.f, 0.f, 0.f, 0.f, 0.f, 0.f}; acc[1] = acc[0];
    const int t = tb * 32 + c31;
    const int nks = 2 * (tb + 1);
    for (int ks = 0; ks < nks; ++ks) {
        const f16x8 wf = *(const LAS f16x8*)(lds + SP_W_OFF + t * 256 + (((2 * ks + hi) ^ (t & 15)) << 4));
#pragma unroll
        for (int q = 0; q < 2; ++q) {
            const int d = (2 * dh + q) * 32 + c31;
            const f16x8 vf = *(const LAS f16x8*)(lds + SP_VT_OFF + d * 256 + (((2 * ks + hi) ^ (d & 15)) << 4));
            acc[q] = __builtin_amdgcn_mfma_f32_32x32x16_f16(vf, wf, acc[q], 0, 0, 0);
        }
    }
    const float bias = b_sp[h * CHUNK + t];
    const half_t* up = PROJ16 + (size_t)(tok0 + t) * INC + 512 + h * SHD;
    half_t* op = CAT16 + (size_t)T * 512 + (size_t)(tok0 + t) * 512 + h * SHD;
#pragma unroll
    for (int q = 0; q < 2; ++q)
#pragma unroll
        for (int rg = 0; rg < 4; ++rg) {
            const int d = (2 * dh + q) * 32 + 8 * rg + 4 * hi;
            const f16x4 u = *(const f16x4*)(up + d);
            const f32x4 g = *(const f32x4*)(g_sgu + h * SHD + d);
            u32x2 o;
            o.x = pk_h2((float)u[0] * (g[0] * acc[q][4 * rg + 0] + bias), (float)u[1] * (g[1] * acc[q][4 * rg + 1] + bias));
            o.y = pk_h2((float)u[2] * (g[2] * acc[q][4 * rg + 2] + bias), (float)u[3] * (g[3] * acc[q][4 * rg + 3] + bias));
            *(u32x2*)(op + d) = o;
        }
    __syncthreads();
}

constexpr int SL = 32, NCH = T / SL;
struct SsmTabs { half_t* ktab; half_t* et; half_t* ft; float* xend; half_t* xin; };

__device__ __forceinline__ void ssm_tables_item(LAS unsigned char* lds, const float* lam_re, const float* lam_im, const float* log_dt, const float* b_re, const float* b_im,
                                                const float* c_re, const float* c_im, const float* d_skip, const SsmTabs& tb, int g, int part, int tid) {
    LAS f32x2* pw = (LAS f32x2*)lds; LAS f32x2* bb = pw + 33 * 64; LAS f32x2* cc = bb + 64 * 16;
    const float dt = expf(log_dt[g]); const float idt = 1.0f / dt;
    {
        const int p = tid & 63, part = tid >> 6;
        const float are = lam_re[g * NP + p], aim = lam_im[g * NP + p];
#pragma unroll 1
        for (int k = part; k <= 32; k += 8) {
            const double ang = (double)aim * (double)dt * (double)k;
            const float e = expf(are * dt * (float)k);
            pw[k * 64 + p] = (f32x2){e * (float)cos(ang), e * (float)sin(ang)};
        }
        const double ang1 = (double)aim * (double)dt;
        const float e1 = expf(are * dt); const float lr = e1 * (float)cos(ang1), li = e1 * (float)sin(ang1);
        const float nr = lr - 1.f, ni = li, den = are * are + aim * aim;
        const float fr = (nr * are + ni * aim) / den * idt, fi = (ni * are - nr * aim) / den * idt;
#pragma unroll
        for (int q = 0; q < 2; ++q) { const int h = part * 2 + q; const float br = b_re[(g * NP + p) * SG + h], bi = b_im[(g * NP + p) * SG + h];
            bb[p * 16 + h] = (f32x2){fr * br - fi * bi, fr * bi + fi * br}; }
#pragma unroll
        for (int q = 0; q < 2; ++q) { const int i = tid * 2 + q; cc[i] = (f32x2){c_re[g * 1024 + i], c_im[g * 1024 + i]}; }
    }
    __syncthreads();
    half_t* kt = tb.ktab + (size_t)g * 33 * 256;
    if (part == 0 && tid < 256) kt[tid] = (_Float16)0.f;
#pragma unroll 1
    for (int j = part * 2; j < part * 2 + 2; ++j) {
        const int idx = j * 512 + tid, lag = idx >> 8, h = (idx >> 4) & 15, h2 = idx & 15;
        float acc = 0.f;
#pragma unroll 4
        for (int p = 0; p < 64; ++p) {
            const f32x2 c = cc[h * 64 + p], w = pw[lag * 64 + p], b = bb[p * 16 + h2];
            const float zr = c.x * w.x - c.y * w.y, zi = c.x * w.y + c.y * w.x;
            acc += zr * b.x - zi * b.y;
        }
        if (lag == 0 && h == h2) acc += d_skip[g * SG + h] * idt;
        kt[(lag + 1) * 256 + h * 16 + h2] = (_Float16)acc;
    }
    half_t* et = tb.et + (size_t)g * 128 * 512;
#pragma unroll 2
    for (int j = part * 4; j < part * 4 + 4; ++j) {
        const int idx = j * 512 + tid, hp = idx & 7, s = (idx >> 3) & 31, p = idx >> 8;
        const f32x2 w = pw[(31 - s) * 64 + p], b0 = bb[p * 16 + hp * 2], b1 = bb[p * 16 + hp * 2 + 1];
        *(unsigned*)(et + (size_t)p * 512 + s * 16 + hp * 2) = pk_h2(w.x * b0.x - w.y * b0.y, w.x * b1.x - w.y * b1.y);
        *(unsigned*)(et + (size_t)(64 + p) * 512 + s * 16 + hp * 2) = pk_h2(w.x * b0.y + w.y * b0.x, w.x * b1.y + w.y * b1.x);
    }
    half_t* ft = tb.ft + (size_t)g * 512 * 128;
#pragma unroll 2
    for (int j = part * 4; j < part * 4 + 4; ++j) {
        const int idx = j * 512 + tid, pp = idx & 31, h = (idx >> 5) & 15, t = idx >> 9;
        const f32x2 c0 = cc[h * 64 + pp * 2], c1 = cc[h * 64 + pp * 2 + 1], w0 = pw[(t + 1) * 64 + pp * 2], w1 = pw[(t + 1) * 64 + pp * 2 + 1];
        *(unsigned*)(ft + (size_t)(t * 16 + h) * 128 + pp * 2) = pk_h2(c0.x * w0.x - c0.y * w0.y, c1.x * w1.x - c1.y * w1.y);
        *(unsigned*)(ft + (size_t)(t * 16 + h) * 128 + 64 + pp * 2) = pk_h2(-(c0.x * w0.y + c0.y * w0.x), -(c1.x * w1.y + c1.y * w1.x));
    }
    __syncthreads();
}

__device__ __forceinline__ void ssm_stage_u(LAS unsigned char* ul, const half_t* __restrict__ PROJ16, int g, int q0, int tid) {
    u32x4 v[8];
#pragma unroll
    for (int i = 0; i < 8; ++i) { const int idx = i * 512 + tid, hh = idx & 1, tok = idx >> 1;
        v[i] = *(const u32x4*)(PROJ16 + (size_t)(q0 * 1024 + tok) * INC + g * SG + hh * 8); }
#pragma unroll
    for (int i = 0; i < 8; ++i) { const int idx = i * 512 + tid, hh = idx & 1, tok = idx >> 1, qi = tok >> 10, c = (tok >> 5) & 31, s = tok & 31;
        *(LAS u32x4*)(ul + qi * 32768 + s * 1024 + c * 32 + hh * 16) = v[i]; }
}
__device__ __forceinline__ void ssm_pass1_item(const LAS unsigned char* ul, const SsmTabs& tb, int g, int q, int cbk, int lane) {
    asm volatile("" : "+v"(lane));
    const int c31 = lane & 31, hi = lane >> 5;
    const half_t* ap = tb.et + ((size_t)g * 128 + cbk * 32 + c31) * 512 + 8 * hi;
    const LAS unsigned char* bp = ul + (q & 1) * 32768 + c31 * 32 + hi * 16;
    f32x16 acc = {0.f, 0.f, 0.f, 0.f, 0.f, 0.f, 0.f, 0.f, 0.f, 0.f, 0.f, 0.f, 0.f, 0.f, 0.f, 0.f};
#pragma unroll 16
    for (int ks = 0; ks < 32; ++ks) {
        const f16x8 a = *(const f16x8*)(ap + 16 * ks);
        const f16x8 b = *(const LAS f16x8*)(bp + ks * 1024);
        acc = __builtin_amdgcn_mfma_f32_32x32x16_f16(a, b, acc, 0, 0, 0);
    }
    float* xp = tb.xend + ((size_t)g * NCH + q * 32 + c31) * 128 + cbk * 32 + 4 * hi;
#pragma unroll
    for (int rg = 0; rg < 4; ++rg) *(f32x4*)(xp + 8 * rg) = (f32x4){acc[4 * rg], acc[4 * rg + 1], acc[4 * rg + 2], acc[4 * rg + 3]};
}

__device__ __forceinline__ void ssm_scan_wg(LAS unsigned char* lds, const float* lam_re, const float* lam_im, const float* log_dt, const SsmTabs& tb, int bg, int tid) {
    asm volatile("" : "+v"(tid));
    const int p = tid & 63, seg = tid >> 6, g = bg & 31, b = bg >> 5;
    LAS f32x2* tot = (LAS f32x2*)lds;
    const float are = lam_re[g * NP + p], aim = lam_im[g * NP + p];
    const float dt = expf(log_dt[g]);
    const double ang = (double)aim * (double)dt * 32.0;
    const float e = expf(are * dt * 32.f);
    const float Lr = e * (float)cos(ang), Li = e * (float)sin(ang);
    const float* xe = tb.xend + ((size_t)g * NCH + b * 128 + seg * 16) * 128 + p;
    half_t* xi = tb.xin + ((size_t)g * NCH + b * 128 + seg * 16) * 128 + p;
    float er[16], ei[16];
#pragma unroll
    for (int j = 0; j < 16; ++j) { er[j] = xe[(size_t)j * 128]; ei[j] = xe[(size_t)j * 128 + 64]; }
    float cr = 0.f, ci = 0.f;
#pragma unroll
    for (int j = 0; j < 16; ++j) {
        const float xr = er[j], xim = ei[j];
        er[j] = cr; ei[j] = ci;
        const float nr = Lr * cr - Li * ci + xr, ni = Lr * ci + Li * cr + xim;
        cr = nr; ci = ni;
    }
    tot[seg * 64 + p] = (f32x2){cr, ci};
    float Pr = Lr, Pi = Li;
#pragma unroll
    for (int k = 0; k < 4; ++k) { const float nr = Pr * Pr - Pi * Pi, ni = 2.f * Pr * Pi; Pr = nr; Pi = ni; }
    __syncthreads();
    float kr = 0.f, ki = 0.f;
    for (int s2 = 0; s2 < seg; ++s2) { const f32x2 t = tot[s2 * 64 + p]; const float nr = Pr * kr - Pi * ki + t.x, ni = Pr * ki + Pi * kr + t.y; kr = nr; ki = ni; }
#pragma unroll
    for (int j = 0; j < 16; ++j) {
        xi[(size_t)j * 128] = (_Float16)(er[j] + kr); xi[(size_t)j * 128 + 64] = (_Float16)(ei[j] + ki);
        const float nr = Lr * kr - Li * ki, ni = Lr * ki + Li * kr; kr = nr; ki = ni;
    }
    __syncthreads();
}

#ifdef PROBE_PHASE
#define SSTAMP(k) do { if (blockIdx.x == 0 && threadIdx.x == 0) ((volatile LAS unsigned long long*)((LAS unsigned char*)0 + 131072 + 512))[k] = __builtin_amdgcn_s_memrealtime(); } while (0)
#else
#define SSTAMP(k) do { } while (0)
#endif
__device__ __forceinline__ void ssm_pass2_item(const LAS half_t* ktl, const LAS unsigned char* ul, const SsmTabs& tb, const float* log_dt, half_t* YSG16, int g, int q, int qq, int lane) {
    asm volatile("" : "+v"(lane));
    const int c31 = lane & 31, hi = lane >> 5;
    const int cbs[4] = {qq, 7 - qq, 8 + qq, 15 - qq};
    const int tl = c31 >> 4, h = c31 & 15;
    const LAS half_t* kt = ktl + h * 16 + 8 * hi;
    const LAS unsigned char* bp = ul + (q & 1) * 32768 + c31 * 32 + hi * 16;
    f32x16 acc[4];
#pragma unroll
    for (int j = 0; j < 4; ++j) acc[j] = (f32x16){0.f, 0.f, 0.f, 0.f, 0.f, 0.f, 0.f, 0.f, 0.f, 0.f, 0.f, 0.f, 0.f, 0.f, 0.f, 0.f};
#pragma unroll 16
    for (int ks = 0; ks < 32; ++ks) {
        const f16x8 b = *(const LAS f16x8*)(bp + ks * 1024);
#pragma unroll
        for (int j = 0; j < 4; ++j) {
            int lag = 2 * cbs[j] + tl - ks; lag = lag < -1 ? -1 : lag;
            const f16x8 a = *(const LAS f16x8*)(kt + (lag + 1) * 256);
            acc[j] = __builtin_amdgcn_mfma_f32_32x32x16_f16(a, b, acc[j], 0, 0, 0);
        }
    }
    SSTAMP(51);
    const half_t* xp = tb.xin + ((size_t)g * NCH + q * 32 + c31) * 128 + 8 * hi;
#pragma unroll
    for (int kk = 0; kk < 8; ++kk) {
        const f16x8 b = *(const f16x8*)(xp + 16 * kk);
#pragma unroll
        for (int j = 0; j < 4; ++j) {
            const f16x8 a = *(const f16x8*)(tb.ft + ((size_t)g * 512 + cbs[j] * 32 + c31) * 128 + 16 * kk + 8 * hi);
            acc[j] = __builtin_amdgcn_mfma_f32_32x32x16_f16(a, b, acc[j], 0, 0, 0);
        }
    }
    SSTAMP(52);
    const float dt = expf(log_dt[g]);
    half_t* yp = YSG16 + (size_t)((q * 32 + c31) * SL) * SSMW + g * SG;
#pragma unroll
    for (int j = 0; j < 4; ++j)
#pragma unroll
        for (int rg = 0; rg < 4; ++rg) {
            const int t = 2 * cbs[j] + (rg >> 1), hh = 8 * (rg & 1) + 4 * hi;
            u32x2 o; o.x = pk_h2(fast_gelu(dt * acc[j][4 * rg]), fast_gelu(dt * acc[j][4 * rg + 1])); o.y = pk_h2(fast_gelu(dt * acc[j][4 * rg + 2]), fast_gelu(dt * acc[j][4 * rg + 3]));
            *(u32x2*)(yp + (size_t)t * SSMW + hh) = o;
        }
}

constexpr int MOE_TILES_OFF = RING_BYTES + 4096, MOE_MAXTILES = 192, MOE_NT_OFF = MOE_TILES_OFF + MOE_MAXTILES * 16, MOE_RIDX_OFF = MOE_NT_OFF + 256, MOE_RIDX_CAP = 8;
typedef int i32x4 __attribute__((ext_vector_type(4)));
struct RouteBufs { int* eid; float* ew; int* posOf; float* rsT; float* rsrow; int* wghist; const half_t* wrt_hi; const half_t* wrt_lo; };

__device__ __forceinline__ void route_block(LAS unsigned char* lds, const half_t* __restrict__ H16, const RouteBufs& rb, const float* b_group, const float* b_router, int tb, int tid, int wave, int lane) {
    asm volatile("" : "+v"(tid), "+v"(lane));
    LAS float* part = (LAS float*)(lds + 81920);
    LAS float* lg   = (LAS float*)(lds + 106496);
    LAS float* rsl  = (LAS float*)(lds + 126976);
    LAS float* ssp  = (LAS float*)(lds + 127232);
    LAS int*   hist = (LAS int*)(lds + 127488);
    if (tid < 64) hist[tid] = 0;
    const int it = wave >> 1, kh = wave & 1, fr = lane & 15, fq = lane >> 4;
    const int tok0 = tb * 64 + it * 16;
    constexpr int RT_OFF = 0, RT_BUF = 40960, RT_LO = 20480;
    const half_t* hp = H16 + (size_t)(tok0 + fr) * DM + kh * 64 + 8 * fq;
    f32x4 acc[5];
#pragma unroll
    for (int nb = 0; nb < 5; ++nb) acc[nb] = (f32x4){0.f, 0.f, 0.f, 0.f};
    float ss = 0.f;
    u32x4 stg[5];
#define RT_LOAD(s) do { _Pragma("unroll") for (int _i = 0; _i < 5; ++_i) { const int idx = _i * 512 + tid, hl = idx >= 1280, r = hl ? idx - 1280 : idx, n = r >> 4, c = r & 15; \
        stg[_i] = *(const u32x4*)((hl ? rb.wrt_lo : rb.wrt_hi) + (size_t)n * DM + (s) * 128 + c * 8); } } while (0)
#define RT_STORE(buf) do { _Pragma("unroll") for (int _i = 0; _i < 5; ++_i) { const int idx = _i * 512 + tid, hl = idx >= 1280, r = hl ? idx - 1280 : idx, n = r >> 4, c = r & 15; \
        *(LAS u32x4*)(lds + RT_OFF + (buf) * RT_BUF + hl * RT_LO + n * 256 + ((c ^ (n & 15)) << 4)) = stg[_i]; } } while (0)
    RT_LOAD(0); RT_STORE(0);
    __syncthreads();
#pragma unroll 1
    for (int s = 0; s < 8; ++s) {
        if (s + 1 < 8) RT_LOAD(s + 1);
        const LAS unsigned char* tbuf = lds + RT_OFF + (s & 1) * RT_BUF;
#pragma unroll
        for (int kk = 0; kk < 2; ++kk) {
            const f16x8 xh = *(const f16x8*)(hp + s * 128 + kk * 32);
#pragma unroll
            for (int j = 0; j < 8; ++j) { const float f = (float)xh[j]; ss += f * f; }
            const int ch = (kh * 2 + kk) * 4 + fq;
#pragma unroll
            for (int nb = 0; nb < 5; ++nb) {
                const int n = nb * 16 + fr;
                const f16x8 bh = *(const LAS f16x8*)(tbuf + n * 256 + ((ch ^ (n & 15)) << 4)), bl = *(const LAS f16x8*)(tbuf + RT_LO + n * 256 + ((ch ^ (n & 15)) << 4));
                acc[nb] = __builtin_amdgcn_mfma_f32_16x16x32_f16(xh, bh, acc[nb], 0, 0, 0);
                acc[nb] = __builtin_amdgcn_mfma_f32_16x16x32_f16(xh, bl, acc[nb], 0, 0, 0);
            }
        }
        if (s + 1 < 8) RT_STORE((s + 1) & 1);
        __syncthreads();
    }
#undef RT_LOAD
#undef RT_STORE
    ss += __shfl_xor(ss, 16); ss += __shfl_xor(ss, 32);
    if (kh == 1) {
        LAS float* pp = part + (it * 64 + lane) * 24;
#pragma unroll
        for (int nb = 0; nb < 5; ++nb) *(LAS f32x4*)(pp + 4 * nb) = acc[nb];
        if (fq == 0) ssp[it * 16 + fr] = ss;
    }
    __syncthreads();
    if (kh == 0) {
        const LAS float* pp = part + (it * 64 + lane) * 24;
#pragma unroll
        for (int nb = 0; nb < 5; ++nb) acc[nb] += *(const LAS f32x4*)(pp + 4 * nb);
        if (fq == 0) { const float tot = ss + ssp[it * 16 + fr]; const float rs = 1.0f / sqrtf(tot * (1.f / 1024.f) + EPS); rsl[it * 16 + fr] = rs; rb.rsT[tok0 + fr] = rs; }
        LDS_WAIT();
#pragma unroll
        for (int nb = 0; nb < 5; ++nb) {
            const int n = nb * 16 + fr;
            const float bias = (n < 64) ? b_router[n] : ((n < 72) ? b_group[n - 64] : 0.f);
#pragma unroll
            for (int r = 0; r < 4; ++r) { const int tk = 4 * fq + r; lg[(it * 16 + tk) * 80 + n] = acc[nb][r] * rsl[it * 16 + tk] * (1.f / 64.f) + bias; }
        }
        LDS_WAIT();
        if (lane < 16) {
            const LAS float* l = lg + (it * 16 + lane) * 80;
            int gi = 0; float gm = l[64];
#pragma unroll
            for (int g = 1; g < 8; ++g) { const float v = l[64 + g]; if (v > gm) { gm = v; gi = g; } }
            float den = 0.f;
#pragma unroll
            for (int g = 0; g < 8; ++g) den += expf(l[64 + g] - gm);
            const float gw = 1.f / den;
            const LAS float* el = l + gi * 8;
            int i0 = 0; float v0 = el[0];
#pragma unroll
            for (int e = 1; e < 8; ++e) { const float v = el[e]; if (v > v0) { v0 = v; i0 = e; } }
            int i1 = -1; float v1 = -3.0e38f;
#pragma unroll
            for (int e = 0; e < 8; ++e) { const float v = el[e]; if (e != i0 && v > v1) { v1 = v; i1 = e; } }
            const float w0 = 1.f / (1.f + expf(v1 - v0)), w1 = 1.f - w0;
            const int e0 = gi * 8 + i0, e1 = gi * 8 + i1, tok = tok0 + lane;
            rb.eid[tok * 2] = e0; rb.eid[tok * 2 + 1] = e1;
            rb.ew[tok * 2] = gw * w0; rb.ew[tok * 2 + 1] = gw * w1;
            __hip_atomic_fetch_add(&hist[e0], 1, __ATOMIC_RELAXED, __HIP_MEMORY_SCOPE_WORKGROUP); __hip_atomic_fetch_add(&hist[e1], 1, __ATOMIC_RELAXED, __HIP_MEMORY_SCOPE_WORKGROUP);
        }
    }
    __syncthreads();
    if (tid < 64) rb.wghist[tb * 64 + tid] = hist[tid];
    __syncthreads();
}

__device__ __forceinline__ void gather_block(LAS unsigned char* lds, const RouteBufs& rb, int* srcTok, int tb, bool do_rows, int tid, int wave, int lane) {
    asm volatile("" : "+v"(tid), "+v"(lane));
    LAS int* psumA = (LAS int*)lds;
    LAS int* psumP = psumA + 512;
    LAS int* base  = psumP + 512;
    LAS int* lcur  = base + 64;
    LAS i32x4* tiles = (LAS i32x4*)(lds + MOE_TILES_OFF);
    LAS int* ntl = (LAS int*)(lds + MOE_NT_OFF);
    {
        const int e = tid & 63, part = tid >> 6; int sa = 0, sp = 0;
#pragma unroll 4
        for (int w = part * 32; w < part * 32 + 32; ++w) { const int v = rb.wghist[w * 64 + e]; sa += v; sp += (w < tb) ? v : 0; }
        psumA[part * 64 + e] = sa; psumP[part * 64 + e] = sp;
    }
    __syncthreads();
    if (wave == 0) {
        int tot = 0, pre = 0;
#pragma unroll
        for (int p = 0; p < 8; ++p) { tot += psumA[p * 64 + lane]; pre += psumP[p * 64 + lane]; }
        const int nfull = tot >> 8, rem = tot & 255;
        int rs_incl = tot, fs_incl = nfull;
#pragma unroll
        for (int o = 1; o < 64; o <<= 1) { const int a = __shfl_up(rs_incl, o), b = __shfl_up(fs_incl, o); if (lane >= o) { rs_incl += a; fs_incl += b; } }
        const int rstart = rs_incl - tot, fstart = fs_incl - nfull;
        const int totfull = __shfl(fs_incl, 63);
        int rank = 0, npart = 0;
        for (int e2 = 0; e2 < 64; ++e2) { const int r2 = __shfl(rem, e2); npart += (r2 > 0) ? 1 : 0; rank += (r2 > rem || (r2 == rem && e2 < lane)) ? 1 : 0; }
        base[lane] = rstart + pre; lcur[lane] = 0;
        for (int j = 0; j < nfull; ++j) if (fstart + j < MOE_MAXTILES) tiles[fstart + j] = (i32x4){lane, rstart + 256 * j, 256, 0};
        if (rem > 0 && totfull + rank < MOE_MAXTILES) tiles[totfull + rank] = (i32x4){lane, rstart + 256 * nfull, rem, 0};
        const int ts_incl = totfull + npart;
        if (lane == 63) ntl[0] = ts_incl < MOE_MAXTILES ? ts_incl : MOE_MAXTILES;
    }
    __syncthreads();
    if (do_rows) {
        if (lane < 16) {
            const int a = wave * 16 + lane, t = tb * 64 + (a >> 1), k = a & 1;
            const int e = rb.eid[t * 2 + k];
            const int pos = base[e] + __hip_atomic_fetch_add(&lcur[e], 1, __ATOMIC_RELAXED, __HIP_MEMORY_SCOPE_WORKGROUP);
            rb.posOf[t * 2 + k] = pos; rb.rsrow[pos] = rb.rsT[t]; srcTok[pos] = t;
        }
    }
    __syncthreads();
}

template <int NT>
__device__ __forceinline__ void final_tokens(const half_t* __restrict__ H16, const half_t* __restrict__ YS16, const RouteBufs& rb, const float* g_final, float* out, int tok0, int stride, int lane) {
    f32x4 hv[NT][4]; f16x4 hh[NT][4], av[NT][4], bv[NT][4]; float w0[NT], w1[NT];
#pragma unroll
    for (int i = 0; i < NT; ++i) {
        const int tok = tok0 + i * stride;
        const int p0 = rb.posOf[tok * 2], p1 = rb.posOf[tok * 2 + 1];
        w0[i] = rb.ew[tok * 2]; w1[i] = rb.ew[tok * 2 + 1];
#pragma unroll
        for (int j = 0; j < 4; ++j) { const int c = 4 * lane + 256 * j;
            hh[i][j] = *(const f16x4*)(H16 + (size_t)tok * DM + c);
            av[i][j] = *(const f16x4*)(YS16 + (size_t)p0 * DM + c); bv[i][j] = *(const f16x4*)(YS16 + (size_t)p1 * DM + c); }
    }
#pragma unroll
    for (int i = 0; i < NT; ++i) {
        const int tok = tok0 + i * stride; float s = 0.f;
#pragma unroll
        for (int j = 0; j < 4; ++j)
#pragma unroll
            for (int q = 0; q < 4; ++q) { hv[i][j][q] = (float)hh[i][j][q] + (w0[i] * (float)av[i][j][q] + w1[i] * (float)bv[i][j][q]); s += hv[i][j][q] * hv[i][j][q]; }
        const float rs = 1.0f / sqrtf(wave_sum(s) * (1.f / 1024.f) + EPS);
#pragma unroll
        for (int j = 0; j < 4; ++j) { const int c = 4 * lane + 256 * j; const f32x4 g = *(const f32x4*)(g_final + c); *(f32x4*)(out + (size_t)tok * DM + c) = hv[i][j] * rs * g; }
    }
}

namespace pg {
__device__ __forceinline__ bool moe_unit(int i, int G, int c, int ntiles, int& tile, int& pn) {
    if ((G & 31) == 0) { const int per = G >> 3, x = c & 7, slot = c >> 3; tile = i * (G >> 2) + x * (per >> 2) + (slot >> 2); pn = slot & 3; }
    else { const int L = i * G + c; tile = L >> 2; pn = L & 3; }
    return tile < ntiles;
}
struct OrderMoe {
    const LAS i32x4* tiles; int ntiles, G, c; const char* A; size_t rowA; const char* B; size_t expB, tileB; bool gather;
    int only;
    __device__ bool next(int i, Unit& u) const {
        if (only >= 0) { if (i > 0) return false; i = only; }
        int tile, pn; if (!moe_unit(i, G, c, ntiles, tile, pn)) return false;
        const i32x4 t = tiles[tile];
        u.pm = t.y; u.pn = pn; u.aux = t.z; u.tile = tile;
        u.A = A + (size_t)(gather ? 0 : t.y) * rowA; u.B = B + (size_t)t.x * expB + (size_t)pn * tileB; return true;
    }
};
struct EpiUp {
    static constexpr bool PERM = true;
    half_t* O; const float* rsrow;
    __device__ __forceinline__ void operator()(const f32x4 (&acc)[2][2][4][2], const Unit& u, int wr, int wc, int fr, int fq) const {
        const int col0 = u.pn * HALF + wc * 32 + 8 * fq;
#pragma unroll
        for (int ai = 0; ai < 2; ++ai)
#pragma unroll
            for (int m = 0; m < 4; ++m) {
                const int rl = ai * HALF + wr * 64 + m * 16 + fr;
                if (rl < u.aux) {
                    const float rs = rsrow[u.pm + rl];
                    const f32x4 a0 = acc[ai][0][m][0] * rs, a1 = acc[ai][0][m][1] * rs, b0 = acc[ai][1][m][0] * rs, b1 = acc[ai][1][m][1] * rs;
                    u32x4 w; w.x = pk_h2(a0[0] * fast_sigmoid(a0[0]) * b0[0], a0[1] * fast_sigmoid(a0[1]) * b0[1]); w.y = pk_h2(a0[2] * fast_sigmoid(a0[2]) * b0[2], a0[3] * fast_sigmoid(a0[3]) * b0[3]);
                    w.z = pk_h2(a1[0] * fast_sigmoid(a1[0]) * b1[0], a1[1] * fast_sigmoid(a1[1]) * b1[1]); w.w = pk_h2(a1[2] * fast_sigmoid(a1[2]) * b1[2], a1[3] * fast_sigmoid(a1[3]) * b1[3]);
                    *(u32x4*)(O + (size_t)(u.pm + rl) * DFF + col0) = w; } }
    }
};
struct EpiDown {
    static constexpr bool PERM = true;
    half_t* O;
    __device__ __forceinline__ void operator()(const f32x4 (&acc)[2][2][4][2], const Unit& u, int wr, int wc, int fr, int fq) const {
        const int col0 = u.pn * BM + wc * 32 + 8 * fq;
#pragma unroll
        for (int ai = 0; ai < 2; ++ai)
#pragma unroll
            for (int m = 0; m < 4; ++m) {
                const int rl = ai * HALF + wr * 64 + m * 16 + fr;
                if (rl < u.aux) {
#pragma unroll
                    for (int bj = 0; bj < 2; ++bj) { const f32x4 v0 = acc[ai][bj][m][0], v1 = acc[ai][bj][m][1];
                        u32x4 w; w.x = pk_h2(v0[0], v0[1]); w.y = pk_h2(v0[2], v0[3]); w.z = pk_h2(v1[0], v1[1]); w.w = pk_h2(v1[2], v1[3]);
                        *(u32x4*)(O + (size_t)(u.pm + rl) * DM + col0 + bj * HALF) = w; } } }
    }
};
}

constexpr size_t MiB = 1u << 20;
constexpr int CW_BAR = 4096;
constexpr int CW_TILECNT = 12288;
constexpr size_t WS_CTL = 0, CTL_ZERO_BYTES = 64 * 1024;
constexpr size_t WS_K16 = 1 * MiB, WS_VT16 = 2 * MiB, WS_KTAB = 3 * MiB;
constexpr size_t WS_ROUTE = 4 * MiB;
constexpr size_t WS_WRT = 5 * MiB;
constexpr size_t WS_VSQ = 5 * MiB + 384 * 1024, WS_WSP16 = 5 * MiB + 896 * 1024;
constexpr size_t WS_MEMN16 = 6 * MiB;
constexpr size_t WS_ET = 8 * MiB, WS_FT = 12 * MiB, WS_XEND = 16 * MiB, WS_XIN = 24 * MiB;
constexpr size_t WS_WINT = 28 * MiB, WS_WGATET = 32 * MiB, WS_WGLUT = 38 * MiB, WS_WKVT = 39 * MiB, WS_WBRT = 41 * MiB, WS_WOUTT = 44 * MiB;
constexpr size_t WS_W13T = 46 * MiB, WS_W2T = 174 * MiB;
constexpr size_t WS_PROJ16 = 238 * MiB, WS_XS16 = 238 * MiB;
constexpr size_t WS_G16 = 303 * MiB, WS_YS16 = 303 * MiB;
constexpr size_t WS_N16 = 399 * MiB, WS_H16 = 399 * MiB;
constexpr size_t WS_MERGED16 = 335 * MiB;
constexpr size_t WS_CAT16 = 432 * MiB, WS_YSG16 = 480 * MiB, WS_HT16 = 432 * MiB;
constexpr size_t WS_END = 496 * MiB;

struct Args { const float* in[32]; float* out; unsigned char* ws; int ph_lo, ph_hi, li, pad; };
struct Frame { LAS unsigned char* lds; volatile LAS unsigned* MISC; unsigned* ctl; int tid, lane, wave, vcu, G; };

__device__ __forceinline__ SsmTabs make_tabs(unsigned char* ws) { SsmTabs t; t.ktab = (half_t*)(ws + WS_KTAB); t.et = (half_t*)(ws + WS_ET); t.ft = (half_t*)(ws + WS_FT); t.xend = (float*)(ws + WS_XEND); t.xin = (half_t*)(ws + WS_XIN); return t; }
__device__ __forceinline__ RouteBufs make_route(unsigned char* ws) {
    RouteBufs r; unsigned char* b = ws + WS_ROUTE;
    r.eid = (int*)b; r.ew = (float*)(b + 131072); r.posOf = (int*)(b + 262144); r.rsT = (float*)(b + 393216); r.rsrow = (float*)(b + 458752); r.wghist = (int*)(b + 655360);
    r.wrt_hi = (const half_t*)(ws + WS_WRT); r.wrt_lo = (const half_t*)(ws + WS_WRT + 163840); return r;
}

#ifdef PROBE_PHASE
#define P0STAMP(k) do { if (blockIdx.x == 0 && F.tid == 0) ((volatile LAS unsigned long long*)(F.lds + LDSCTL_OFF + 512))[k] = __builtin_amdgcn_s_memrealtime(); } while (0)
#else
#define P0STAMP(k) do { } while (0)
#endif
__device__ __forceinline__ void p0_prologue(const Frame& F, const Args& a) {
    P0STAMP(30);
    { const SsmTabs tb = make_tabs(a.ws);
#ifndef P0_REP_TAB
#define P0_REP_TAB 1
#endif
      for (int rr = 0; rr < P0_REP_TAB; ++rr) for (int wi = F.vcu; wi < NG * 8; wi += F.G) ssm_tables_item(F.lds, a.in[7], a.in[8], a.in[9], a.in[10], a.in[11], a.in[12], a.in[13], a.in[14], tb, wi >> 3, wi & 7, F.tid); }
    P0STAMP(31);
    LAS float* scr = (LAS float*)(F.lds + RING_OFF + F.wave * 16384);
    const int gw = F.vcu * NWAVES + F.wave, NGW = F.G * NWAVES;
    {
        half_t* whi = (half_t*)(a.ws + WS_WRT); half_t* wlo = (half_t*)(a.ws + WS_WRT + 163840);
        for (int idx = ((gw % 12 == 0 && NGW >= 1920) ? (gw / 12) : (NGW >= 1920 ? 1 << 30 : gw)) * 64 + F.lane; idx < 80 * (DM / 8); idx += NGW * 64) {
            const int k8 = idx / 80, n = idx - k8 * 80;
            u32x4 ph, pl; unsigned hh[4], ll[4];
#pragma unroll
            for (int j = 0; j < 4; ++j) {
                float w2[2];
#pragma unroll
                for (int q = 0; q < 2; ++q) { const int kk = k8 * 8 + 2 * j + q; float w = 0.f;
                    if (n < 64) w = a.in[26][kk * NE + n]; else if (n < 72) w = a.in[24][kk * NGRP + (n - 64)];
                    w2[q] = w * 64.f * a.in[23][kk]; }
                const _Float16 h0 = (_Float16)w2[0], h1 = (_Float16)w2[1];
                f16x2 hv; hv.x = h0; hv.y = h1; hh[j] = __builtin_bit_cast(unsigned, hv);
                ll[j] = pk_h2(w2[0] - (float)h0, w2[1] - (float)h1);
            }
            ph.x = hh[0]; ph.y = hh[1]; ph.z = hh[2]; ph.w = hh[3]; pl.x = ll[0]; pl.y = ll[1]; pl.z = ll[2]; pl.w = ll[3];
            *(u32x4*)(whi + (size_t)n * DM + k8 * 8) = ph; *(u32x4*)(wlo + (size_t)n * DM + k8 * 8) = pl;
        }
    }
    { half_t* wsp = (half_t*)(a.ws + WS_WSP16);
      for (int idx = gw * 64 + F.lane; idx < SH * CHUNK * CHUNK; idx += NGW * 64) { const int s = idx & 127, t = (idx >> 7) & 127; wsp[idx] = (_Float16)(s <= t ? a.in[18][idx] : 0.f); } }
    P0STAMP(32);
    half_t* MEMN16 = (half_t*)(a.ws + WS_MEMN16);
    for (int m = gw; m < MROWS; m += NGW) rms_row_to_f16(a.in[1] + (size_t)m * DM, a.in[3], MEMN16 + (size_t)m * DM, F.lane);
    for (int m = gw; m < T; m += 4 * NGW) {
        if (m + 3 * NGW < T) rms_rows_to_f16<4>(a.in[0], a.in[2], (half_t*)(a.ws + WS_N16), m, NGW, F.lane);
        else for (int m2 = m; m2 < T; m2 += NGW) rms_rows_to_f16<1>(a.in[0], a.in[2], (half_t*)(a.ws + WS_N16), m2, NGW, F.lane);
    }
    P0STAMP(33);
    {
        half_t* W13T = (half_t*)(a.ws + WS_W13T); half_t* W2T = (half_t*)(a.ws + WS_W2T);
        constexpr int NSMALL = 4608;
#pragma unroll 1
        for (int it0 = gw; it0 < NSMALL + NE * 768; it0 += NGW) {
            if (it0 < NSMALL) {
                const float* W; int ldw, K, N, mode = 0, it = it0; half_t* WT;
                if (it < 1024)      { W = a.in[4];  ldw = INC;  K = DM;  N = INC;  WT = (half_t*)(a.ws + WS_WINT); }
                else if (it < 1536) { it -= 1024; W = a.in[20]; ldw = 1024; K = DM;  N = 1024; WT = (half_t*)(a.ws + WS_WKVT); }
                else if (it < 3072) { it -= 1536; W = a.in[5];  ldw = 3072; K = DM;  N = 3072; WT = (half_t*)(a.ws + WS_WGATET); }
                else if (it < 3328) { it -= 3072; W = a.in[15]; ldw = 1024; K = 512; N = 1024; WT = (half_t*)(a.ws + WS_WGLUT); mode = 1; }
                else if (it < 4096) { it -= 3328; const int bi = it >> 8; it &= 255; W = a.in[21] + (size_t)bi * 512 * 1024; ldw = 1024; K = 512; N = 1024; WT = (half_t*)(a.ws + WS_WBRT) + (size_t)bi * 1024 * 512; }
                else                { it -= 4096; W = a.in[22]; ldw = 1024; K = DM; N = 1024; WT = (half_t*)(a.ws + WS_WOUTT); }
                const int nblk = N / 32, kb = it / nblk, nb = it % nblk, n0 = nb * 32;
                int drow = n0;
                if (mode == 1) { const int half = n0 >> 9, jj = n0 & 511; drow = (jj >> 7) * 256 + half * 128 + (jj & 127); }
                transpose_item(W, ldw, kb * 64, n0, WT, K, drow, scr, F.lane);
                continue;
            }
            const int it = it0 - NSMALL;
            const int e = it / 768, r = it % 768, which = r >> 8, q = r & 255;
            if (which < 2) {
                const int kb = q >> 4, nb = q & 15, n0 = nb * 32;
                const float* W = (which == 0 ? a.in[28] : a.in[29]) + (size_t)e * DM * DFF;
                transpose_item(W, DFF, kb * 64, n0, W13T + (size_t)e * 1024 * 1024, 1024, (n0 >> 7) * 256 + which * 128 + (n0 & 127), scr, F.lane, a.in[23]);
            } else {
                const int kb = q >> 5, nb = q & 31, n0 = nb * 32;
                transpose_item(a.in[30] + (size_t)e * DFF * DM, DM, kb * 64, n0, W2T + (size_t)e * 1024 * 512, 512, n0, scr, F.lane);
            }
        }
    }
    P0STAMP(34);
}

__global__ void __launch_bounds__(NWAVES * 64, 2) mk_fwd(Args args) {
    extern __shared__ __attribute__((aligned(16))) unsigned char lds[];
#ifdef PROBE_ENTRY
    const unsigned long long t_entry = __builtin_amdgcn_s_memrealtime();
#endif
    Frame F;
    F.lds = (LAS unsigned char*)lds;
    F.MISC = (volatile LAS unsigned*)(F.lds + MISC_OFF);
    F.tid = threadIdx.x; F.lane = F.tid & 63; F.wave = __builtin_amdgcn_readfirstlane(F.tid >> 6);
    F.G = gridDim.x; { const int bx = blockIdx.x; F.vcu = (F.G % 8 == 0) ? (bx % 8) * (F.G / 8) + bx / 8 : bx; }
    F.ctl = (unsigned*)(args.ws + WS_CTL);
    for (int u = F.tid; u < (LDS_BYTES - LDSCTL_OFF) / 4; u += NWAVES * 64) ((LAS unsigned*)(F.lds + LDSCTL_OFF))[u] = 0u;
    __syncthreads();
    XcdBarrier bar = xcd_barrier_post(F.ctl + CW_BAR + args.li * XCD_BAR_WORDS, F.MISC + 8);
    const int lo = args.ph_lo, hi = args.ph_hi;
    unsigned char* ws = args.ws;
    const int gw = F.vcu * NWAVES + F.wave, NGW = F.G * NWAVES;
#ifdef PROBE_PHASE
    volatile LAS unsigned long long* tsl = (volatile LAS unsigned long long*)(F.lds + LDSCTL_OFF + 512);
#define STAMP(k) do { if (blockIdx.x == 0 && F.tid == 0) tsl[k] = __builtin_amdgcn_s_memrealtime(); } while (0)
#else
#define STAMP(k) do { } while (0)
#endif
    STAMP(0);
#ifdef PROBE_ENTRY
    if (blockIdx.x == 0 && F.tid == 0) tsl[15] = t_entry;
#endif
#define IN(k) (lo <= (k) && (k) < hi)
#define BOTH(k) (IN(k) && IN((k) + 1))
    if (IN(0)) { p0_prologue(F, args); if (BOTH(0)) xcd_barrier(bar); }
    STAMP(1);
    if (IN(1)) {
        pg::OrderMN S; S.init(T, INC, F.G, (int)blockIdx.x, ws + WS_N16, DM, ws + WS_WINT, DM);
        pg::EpiProj E{(half_t*)(ws + WS_PROJ16), INC, (float*)(ws + WS_VSQ)};
        pg::gemm_phase<pg::EpiProj, pg::OrderMN, true, false>(F.lds + RING_OFF, DM, DM, DM / 64, S, E);
        P0STAMP(35);
        for (int t = F.vcu; t < 256; t += F.G) kv_tile(F.lds, (const half_t*)(ws + WS_MEMN16), (const half_t*)(ws + WS_WKVT), (half_t*)(ws + WS_K16), (half_t*)(ws + WS_VT16), t, F.tid, F.wave, F.lane);
        P0STAMP(36);
        if (BOTH(1)) xcd_barrier(bar);
        P0STAMP(37);
    }
    STAMP(2);
    if (IN(2)) {
        const SsmTabs tb = make_tabs(ws);
        for (int wgi = F.vcu; wgi < 256; wgi += F.G) {
            ssm_stage_u(F.lds, (const half_t*)(ws + WS_PROJ16), wgi >> 3, 2 * (wgi & 7), F.tid);
            __syncthreads();
            const int gwi = wgi * 8 + F.wave;
            ssm_pass1_item(F.lds, tb, gwi >> 6, (gwi >> 2) & 15, gwi & 3, F.lane);
            __syncthreads();
        }
        if (BOTH(2)) xcd_barrier(bar);
    }
    STAMP(3);
    if (IN(3)) {
        P0STAMP(40);
        { const SsmTabs tb = make_tabs(ws);
          for (int bg = (F.G - 1 - F.vcu); bg < BATCH * NG; bg += F.G) ssm_scan_wg(F.lds, args.in[7], args.in[8], args.in[9], tb, bg, F.tid); }
        P0STAMP(41);
#ifndef P3_REP_ATT
#define P3_REP_ATT 1
#endif
#ifndef P3_REP_SP
#define P3_REP_SP 1
#endif
        for (int rr = 0; rr < P3_REP_ATT; ++rr) for (int u = F.vcu; u < 256; u += F.G)
            attn_unit(F.lds, (const half_t*)(ws + WS_PROJ16), (const half_t*)(ws + WS_K16), (const half_t*)(ws + WS_VT16), (half_t*)(ws + WS_CAT16), (u >> 4) >> 2, (u >> 4) & 3, u & 15, F.tid, F.wave, F.lane);
        P0STAMP(42);
        for (int rr = 0; rr < P3_REP_SP; ++rr) for (int u = F.vcu; u < 512; u += F.G)
            spatial_unit(F.lds, (const half_t*)(ws + WS_PROJ16), (const float*)(ws + WS_VSQ), (const half_t*)(ws + WS_WSP16), args.in[19], args.in[17], (half_t*)(ws + WS_CAT16), u >> 2, u & 3, F.tid, F.wave, F.lane);
        P0STAMP(43);
        if (BOTH(3)) xcd_barrier(bar);
        P0STAMP(44);
    }
    STAMP(4);
    if (IN(4)) {
        P0STAMP(49);
        const SsmTabs tb = make_tabs(ws);
        for (int wgi = F.vcu; wgi < 256; wgi += F.G) {
            const int g = wgi >> 3;
            for (int i = F.tid; i < 33 * 256 / 8; i += NWAVES * 64) *(LAS u32x4*)(F.lds + 65536 + i * 16) = *(const u32x4*)(tb.ktab + (size_t)g * 33 * 256 + i * 8);
            ssm_stage_u(F.lds, (const half_t*)(ws + WS_PROJ16), g, 2 * (wgi & 7), F.tid);
            __syncthreads();
            P0STAMP(50);
            const int gwi = wgi * 8 + F.wave;
            ssm_pass2_item((const LAS half_t*)(F.lds + 65536), F.lds, tb, args.in[9], (half_t*)(ws + WS_YSG16), gwi >> 6, (gwi >> 2) & 15, gwi & 3, F.lane);
            __syncthreads();
        }
        P0STAMP(53);
        if (BOTH(4)) xcd_barrier(bar);
        P0STAMP(54);
    }
    STAMP(5);
    if (IN(5)) {
        { pg::OrderMN S; S.init(T, 1024, F.G, (int)blockIdx.x, ws + WS_YSG16, 512, ws + WS_WGLUT, 512);
          pg::EpiGlu E{(half_t*)(ws + WS_CAT16), 512, args.in[16]};
          pg::gemm_phase<pg::EpiGlu, pg::OrderMN, true, false>(F.lds + RING_OFF, 512, 512, 8, S, E); }
        if (BOTH(5)) xcd_barrier(bar);
    }
    STAMP(6);
    if (IN(6)) {
        pg::OrderGB128 S; S.init(F.G, (int)blockIdx.x, ws + WS_N16, ws + WS_WGATET, ws + WS_CAT16, ws + WS_WBRT);
        pg::gemm_phase_gb128(F.lds + RING_OFF, S, args.in[6], (half_t*)(ws + WS_MERGED16));
        if (BOTH(6)) xcd_barrier(bar);
    }
    STAMP(7);
    if (IN(7)) {
        pg::OrderMN S; S.init(T, 1024, F.G, (int)blockIdx.x, ws + WS_MERGED16, DM, ws + WS_WOUTT, DM);
        pg::EpiOut E{(half_t*)(ws + WS_HT16), args.in[0], DM};
        pg::gemm_phase<pg::EpiOut, pg::OrderMN, true, false>(F.lds + RING_OFF, DM, DM, 16, S, E);
        if (BOTH(7)) xcd_barrier(bar);
    }
    STAMP(8);
    if (IN(8)) {
        const RouteBufs rb = make_route(ws);
        for (int tb = F.vcu; tb < 256; tb += F.G) route_block(F.lds, (const half_t*)(ws + WS_HT16), rb, args.in[25], args.in[27], tb, F.tid, F.wave, F.lane);
        if (BOTH(8)) xcd_barrier(bar);
    }
    STAMP(9);
    if (IN(9)) {
        const RouteBufs rb = make_route(ws);
        bool any = false;
        for (int tb = F.vcu; tb < 256; tb += F.G) { gather_block(F.lds, rb, (int*)(ws + WS_ROUTE + 786432), tb, true, F.tid, F.wave, F.lane); any = true; }
        if (!any) gather_block(F.lds, rb, (int*)(ws + WS_ROUTE + 786432), 0, false, F.tid, F.wave, F.lane);
        if (BOTH(9)) xcd_barrier(bar);
    }
    STAMP(10);
    if (IN(10)) {
        const RouteBufs rb = make_route(ws);
        const int ntiles = *(const LAS int*)(F.lds + MOE_NT_OFF);
        const LAS i32x4* tiles = (const LAS i32x4*)(F.lds + MOE_TILES_OFF);
        LAS int* ridxc = (LAS int*)(F.lds + MOE_RIDX_OFF);
        { const int* srcTok = (const int*)(ws + WS_ROUTE + 786432);
          for (int j = 0; j < MOE_RIDX_CAP; ++j) { int tile, pn; if (!pg::moe_unit(j, F.G, (int)blockIdx.x, ntiles, tile, pn)) break;
              const i32x4 t = tiles[tile]; if (F.tid < 256) ridxc[j * 256 + F.tid] = srcTok[t.y + (F.tid < t.z ? F.tid : 0)]; }
          __syncthreads(); }
        pg::OrderMoe S{tiles, ntiles, F.G, (int)blockIdx.x, (const char*)(ws + WS_HT16), (size_t)DM * 2, (const char*)(ws + WS_W13T), (size_t)1024 * 1024 * 2, (size_t)256 * 1024 * 2, true, -1};
        pg::EpiUp E{(half_t*)(ws + WS_H16), rb.rsrow};
        pg::gemm_phase<pg::EpiUp, pg::OrderMoe, true, true, true>(F.lds + RING_OFF, DM, DM, 16, S, E, ridxc);
        if (BOTH(10)) xcd_barrier(bar);
    }
    STAMP(11);
    if (IN(11)) {
        pg::OrderMoe S{(const LAS i32x4*)(F.lds + MOE_TILES_OFF), *(const LAS int*)(F.lds + MOE_NT_OFF), F.G, (int)blockIdx.x, (const char*)(ws + WS_H16), (size_t)DFF * 2, (const char*)(ws + WS_W2T), (size_t)1024 * 512 * 2, (size_t)256 * 512 * 2, false, -1};
        pg::EpiDown E{(half_t*)(ws + WS_YS16)};
        pg::gemm_phase<pg::EpiDown, pg::OrderMoe, true, false, true>(F.lds + RING_OFF, DFF, DFF, 8, S, E);
        if (BOTH(11)) xcd_barrier(bar);
    }
    STAMP(12);
    if (IN(12)) {
        const RouteBufs rb = make_route(ws);
        for (int tok = gw; tok < T; tok += 4 * NGW) {
            if (tok + 3 * NGW < T) final_tokens<4>((const half_t*)(ws + WS_HT16), (const half_t*)(ws + WS_YS16), rb, args.in[31], args.out, tok, NGW, F.lane);
            else for (int t2 = tok; t2 < T; t2 += NGW) final_tokens<1>((const half_t*)(ws + WS_HT16), (const half_t*)(ws + WS_YS16), rb, args.in[31], args.out, t2, NGW, F.lane);
        }
    }
#ifdef PROBE_ENDBAR
    xcd_barrier(bar);
#endif
    STAMP(13);
#ifdef PROBE_PHASE
    if (blockIdx.x == 0 && F.tid == 0) { const unsigned long long d =
#ifdef PROBE_ENTRY
        10 * (tsl[0] - tsl[15]),
#elif defined(PROBE_GIDX)
        10 * (tsl[PROBE_GIDX + 1] - tsl[PROBE_GIDX]),
#else
        tsl[PROBE_PHASE + 1] - tsl[PROBE_PHASE],
#endif
 t0 = __builtin_amdgcn_s_memrealtime(); while (__builtin_amdgcn_s_memrealtime() - t0 < d) __builtin_amdgcn_s_sleep(8); }
#endif
#undef IN
#undef BOTH
}

extern "C" void kernel_launch(void* const* d_in, const int* in_sizes, int n_in, void* d_out, int out_size, void* d_ws, size_t ws_size, hipStream_t stream) {
    static int grid = 0;
    if (grid == 0) {
        if (n_in != 32 || ws_size < WS_END) { fprintf(stderr, "kernel_launch: unexpected inputs (n_in %d, ws %zu)\n", n_in, ws_size); grid = -1; return; }
        int dev = 0, cus = 0;
        if (hipGetDevice(&dev) != hipSuccess || hipDeviceGetAttribute(&cus, hipDeviceAttributeMultiprocessorCount, dev) != hipSuccess) { grid = -1; return; }
        if (hipFuncSetAttribute((const void*)mk_fwd, hipFuncAttributeMaxDynamicSharedMemorySize, LDS_BYTES) != hipSuccess) { grid = -1; return; }
        int per_cu = 0;
        (void)hipOccupancyMaxActiveBlocksPerMultiprocessor(&per_cu, (const void*)mk_fwd, NWAVES * 64, LDS_BYTES);
        (void)hipGetLastError();
        grid = cus;
    }
    if (grid < 0) return;
    (void)hipMemsetAsync((char*)d_ws + WS_CTL, 0, CTL_ZERO_BYTES, stream);
#ifdef PROBE_MEMSET2
    (void)hipMemsetAsync((char*)d_ws + WS_CTL + 512 * 1024, 0, CTL_ZERO_BYTES, stream);
#endif
    Args a{};
    for (int i = 0; i < 32; ++i) a.in[i] = (const float*)d_in[i];
    a.out = (float*)d_out; a.ws = (unsigned char*)d_ws; a.ph_lo = 0; a.ph_hi = 13; a.li = 0;
#ifdef SPLIT_A_HI
    a.ph_hi = SPLIT_A_HI;
    hipLaunchKernelGGL(mk_fwd, dim3(grid), dim3(NWAVES * 64), LDS_BYTES, stream, a);
    a.ph_lo = SPLIT_B_LO; a.ph_hi = 13; a.li = 1;
#endif
    hipLaunchKernelGGL(mk_fwd, dim3(grid), dim3(NWAVES * 64), LDS_BYTES, stream, a);
}
```
